# Optimizing an MI355X kernel written in HIP

```python
import math
import jax, jax.numpy as jnp
from jax import lax
import numpy as np

D_MODEL = 1024
BATCH = 4
SEQ = 8192
DEPTH = 2

CHUNK = 64
Q_BLOCK = 128
D_SSM = 512
SSM_GROUP = 16
N_GROUPS = D_SSM // SSM_GROUP
STATE = 64
N_HEADS = 8
HEAD_DIM = 64
D_ATTN = N_HEADS * HEAD_DIM
IDX_HEADS = 8
IDX_DIM = 32
TOPK_MAX = 256
IDX_SCALE = (IDX_HEADS ** -0.5) * (IDX_DIM ** -0.5)
ATTN_SCALE = HEAD_DIM ** -0.5
N_BUCKETS = 32
MAX_DIST = 128
D_FF = 2816
N_BRANCH = 2
IN_SIZES = (D_SSM, D_ATTN, D_ATTN, D_ATTN, IDX_HEADS * IDX_DIM, IDX_DIM, IDX_HEADS, D_MODEL, D_MODEL)
D_IN = sum(IN_SIZES)
ALPHA = (2 * DEPTH) ** 0.25
BETA = (8 * DEPTH) ** -0.25
LN_EPS = 1e-5

kernel_name = "hybrid_s5_dsa_macaron_deepnorm"


def layer_norm(x, g, b):
    x32 = x.astype(jnp.float32)
    mu = jnp.mean(x32, axis=-1, keepdims=True)
    var = jnp.mean(jnp.square(x32 - mu), axis=-1, keepdims=True)
    y = (x32 - mu) * lax.rsqrt(var + LN_EPS) * g.astype(jnp.float32) + b.astype(jnp.float32)
    return y.astype(x.dtype)


def swiglu_ffn(x, w_up, w_down):
    gate, up = jnp.split(x @ w_up, 2, axis=-1)
    return (jax.nn.silu(gate) * up) @ w_down


def t5_bucket(rel):
    half = N_BUCKETS // 2
    max_exact = half // 2
    ret = jnp.where(rel > 0, half, 0)
    n = jnp.abs(rel)
    n_f = jnp.maximum(n, 1).astype(jnp.float32)
    large = max_exact + (jnp.log(n_f / max_exact) / math.log(MAX_DIST / max_exact)
                         * (half - max_exact)).astype(jnp.int32)
    large = jnp.minimum(large, half - 1)
    return ret + jnp.where(n < max_exact, n, large)


def ssm_branch(u, lam_re, lam_im, log_dt, b_re, b_im, c_re, c_im, d_skip, w_glu):
    bsz, seq_len, _ = u.shape
    f32 = jnp.float32
    u32 = u.astype(f32).reshape(bsz, seq_len, N_GROUPS, SSM_GROUP)
    lam = lax.complex(jnp.minimum(lam_re.astype(f32), -1e-4), lam_im.astype(f32))
    dt = jnp.exp(log_dt.astype(f32))[:, None]
    a_bar = jnp.exp(lam * dt)
    b_bar = ((a_bar - 1.0) / lam)[:, :, None] * lax.complex(b_re.astype(f32), b_im.astype(f32))
    c_mat = lax.complex(c_re.astype(f32), c_im.astype(f32))
    bu = jnp.einsum('blgh,gph->blgp', u32.astype(jnp.complex64), b_bar)
    a_seq = jnp.broadcast_to(a_bar[None, None], (1, seq_len, N_GROUPS, STATE))

    def combine(e1, e2):
        a1, b1 = e1
        a2, b2 = e2
        return a1 * a2, a2 * b1 + b2

    _, states = lax.associative_scan(combine, (a_seq, bu), axis=1)
    y = jnp.einsum('blgp,ghp->blgh', states, c_mat).real \
        + d_skip.astype(f32).reshape(N_GROUPS, SSM_GROUP) * u32
    y = jax.nn.gelu(y.reshape(bsz, seq_len, D_SSM)).astype(u.dtype)
    return y * jax.nn.sigmoid(y @ w_glu)


def dsa_branch(q, k, v, q_idx, k_idx, w_idx, rel_bias):
    bsz, seq_len = q.shape[:2]
    n_sel = min(TOPK_MAX, seq_len // 4)
    nb = seq_len // Q_BLOCK
    key_chunk = jnp.arange(seq_len) // CHUNK
    k_idx32 = k_idx.astype(jnp.float32)
    bias_tab = rel_bias.astype(jnp.float32)

    def to_blocks(a):
        return a.reshape(bsz, nb, Q_BLOCK, *a.shape[2:]).swapaxes(0, 1)

    def block(args):
        qb, qib, wb, blk = args
        qpos = blk * Q_BLOCK + jnp.arange(Q_BLOCK)
        q_chunk = qpos // CHUNK
        admissible = key_chunk[None, :] <= q_chunk[:, None]
        s = jnp.einsum('bqhd,bsd->bqhs', qib.astype(jnp.float32), k_idx32)
        score = jnp.einsum('bqh,bqhs->bqs', wb.astype(jnp.float32), jax.nn.relu(s)) * IDX_SCALE
        score = jnp.where(admissible[None], score, -jnp.inf)
        _, sel = lax.top_k(score, n_sel)
        valid = (sel // CHUNK) <= q_chunk[None, :, None]
        k_sel = jax.vmap(lambda a, i: a[i])(k, sel)
        v_sel = jax.vmap(lambda a, i: a[i])(v, sel)
        logits = jnp.einsum('bqhd,bqkhd->bqkh', qb, k_sel).astype(jnp.float32) * ATTN_SCALE
        logits = logits + bias_tab[t5_bucket(sel - qpos[None, :, None])]
        logits = jnp.where(valid[..., None], logits, -1e30)
        p = jax.nn.softmax(logits, axis=2).astype(v.dtype)
        return jnp.einsum('bqkh,bqkhd->bqhd', p, v_sel)

    out = lax.map(block, (to_blocks(q), to_blocks(q_idx), to_blocks(w_idx), jnp.arange(nb)))
    return out.swapaxes(0, 1).reshape(bsz, seq_len, D_ATTN)


def hybrid_mixer(x, w_in, lam_re, lam_im, log_dt, b_re, b_im, c_re, c_im, d_skip, w_glu,
                 w_branch, w_out, rel_bias):
    bsz, seq_len, _ = x.shape
    splits = [int(s) for s in np.cumsum(IN_SIZES)[:-1]]
    u, q, k, v, qi, ki, wi, g_ssm, g_attn = jnp.split(x @ w_in, splits, axis=-1)
    heads = lambda a: a.reshape(bsz, seq_len, N_HEADS, HEAD_DIM)
    y_ssm = ssm_branch(u, lam_re, lam_im, log_dt, b_re, b_im, c_re, c_im, d_skip, w_glu)
    y_attn = dsa_branch(heads(q), heads(k), heads(v),
                        qi.reshape(bsz, seq_len, IDX_HEADS, IDX_DIM), ki, wi, rel_bias)
    merged = jax.nn.sigmoid(g_ssm) * (y_ssm @ w_branch[0]) \
        + jax.nn.sigmoid(g_attn) * (y_attn @ w_branch[1])
    return merged @ w_out


def setup_inputs(seed: int = 0) -> dict:
    key = jax.random.key(seed)
    ks = jax.random.split(key, 24)
    nrm = lambda k, shape, scale: jax.random.normal(k, shape, jnp.float32) * scale
    L_ = DEPTH
    lam_im0 = jnp.pi * jnp.arange(STATE, dtype=jnp.float32)
    return {
        "x": nrm(ks[0], (BATCH, SEQ, D_MODEL), 1.0),
        "ffn1_w_up": nrm(ks[1], (L_, D_MODEL, 2 * D_FF), D_MODEL ** -0.5),
        "ffn1_w_down": nrm(ks[2], (L_, D_FF, D_MODEL), BETA * D_FF ** -0.5),
        "ln1_g": 1.0 + nrm(ks[3], (L_, D_MODEL), 0.02),
        "ln1_b": nrm(ks[4], (L_, D_MODEL), 0.02),
        "w_in": nrm(ks[5], (L_, D_MODEL, D_IN), D_MODEL ** -0.5),
        "ssm_lam_re": -0.5 + nrm(ks[6], (L_, N_GROUPS, STATE), 0.01),
        "ssm_lam_im": lam_im0 + nrm(ks[7], (L_, N_GROUPS, STATE), 0.01),
        "ssm_log_dt": jax.random.uniform(ks[8], (L_, N_GROUPS), jnp.float32,
                                         math.log(1e-3), math.log(1e-1)),
        "ssm_b_re": nrm(ks[9], (L_, N_GROUPS, STATE, SSM_GROUP), (2 * SSM_GROUP) ** -0.5),
        "ssm_b_im": nrm(ks[10], (L_, N_GROUPS, STATE, SSM_GROUP), (2 * SSM_GROUP) ** -0.5),
        "ssm_c_re": nrm(ks[11], (L_, N_GROUPS, SSM_GROUP, STATE), STATE ** -0.5),
        "ssm_c_im": nrm(ks[12], (L_, N_GROUPS, SSM_GROUP, STATE), STATE ** -0.5),
        "ssm_d": nrm(ks[13], (L_, D_SSM), 1.0),
        "ssm_w_glu": nrm(ks[14], (L_, D_SSM, D_SSM), D_SSM ** -0.5),
        "w_branch": nrm(ks[15], (L_, N_BRANCH, D_SSM, D_MODEL), BETA * D_SSM ** -0.5),
        "w_out": nrm(ks[16], (L_, D_MODEL, D_MODEL), BETA * D_MODEL ** -0.5),
        "ln2_g": 1.0 + nrm(ks[17], (L_, D_MODEL), 0.02),
        "ln2_b": nrm(ks[18], (L_, D_MODEL), 0.02),
        "ffn2_w_up": nrm(ks[19], (L_, D_MODEL, 2 * D_FF), D_MODEL ** -0.5),
        "ffn2_w_down": nrm(ks[20], (L_, D_FF, D_MODEL), BETA * D_FF ** -0.5),
        "ln3_g": 1.0 + nrm(ks[21], (L_, D_MODEL), 0.02),
        "ln3_b": nrm(ks[22], (L_, D_MODEL), 0.02),
        "rel_bias": nrm(ks[23], (N_BUCKETS, N_HEADS), 0.5),
    }


def reference(x, ffn1_w_up, ffn1_w_down, ln1_g, ln1_b, w_in, ssm_lam_re, ssm_lam_im, ssm_log_dt,
              ssm_b_re, ssm_b_im, ssm_c_re, ssm_c_im, ssm_d, ssm_w_glu, w_branch, w_out,
              ln2_g, ln2_b, ffn2_w_up, ffn2_w_down, ln3_g, ln3_b, rel_bias):
    for l in range(DEPTH):
        x = layer_norm(ALPHA * x + 0.5 * swiglu_ffn(x, ffn1_w_up[l], ffn1_w_down[l]), ln1_g[l], ln1_b[l])
        mix = hybrid_mixer(x, w_in[l], ssm_lam_re[l], ssm_lam_im[l], ssm_log_dt[l], ssm_b_re[l],
                           ssm_b_im[l], ssm_c_re[l], ssm_c_im[l], ssm_d[l], ssm_w_glu[l],
                           w_branch[l], w_out[l], rel_bias)
        x = layer_norm(ALPHA * x + mix, ln2_g[l], ln2_b[l])
        x = layer_norm(ALPHA * x + 0.5 * swiglu_ffn(x, ffn2_w_up[l], ffn2_w_down[l]), ln3_g[l], ln3_b[l])
    return x
```

```cpp
#include <hip/hip_runtime.h>
#include <hip/hip_cooperative_groups.h>
#include <cstdio>
namespace cg = cooperative_groups;
#ifndef ONE_LAUNCH
#define ONE_LAUNCH 0
#endif
namespace pg8 {
#define PG8_LAS __attribute__((address_space(3)))
typedef unsigned short bf16_t;
typedef short bf16x8 __attribute__((ext_vector_type(8)));
typedef float f32x4 __attribute__((ext_vector_type(4)));
typedef unsigned u32x4 __attribute__((ext_vector_type(4)));
constexpr int BM = 256, BK = 64, HALF = 128, HTB = HALF * BK * 2  , STAGE_BYTES = 8 * HTB, NXCD = 8, WGM = 8;

__host__ __device__ __forceinline__ int lds_byte(int r, int c) { const int st = (r >> 4) * 2 + (c >> 5), rr = r & 15, cc = c & 31, ob = rr * 64 + cc * 2; return st * 1024 + (ob ^ (((ob >> 9) & 1) << 5)); }
__host__ __device__ __forceinline__ void stage_rc(int b, int& R, int& C) { const int st = b / 1024, sb = b % 1024, swz = sb ^ (((sb >> 9) & 1) << 5); R = (st >> 1) * 16 + swz / 64; C = (st & 1) * 32 + (swz % 64) / 2; }
__host__ __device__ __forceinline__ int perm32(int rho) { const int n = rho >> 4, i = rho & 15; return 8 * (i >> 2) + 4 * n + (i & 3); }

struct Unit { int pm, pn; };
struct Gemm { const bf16_t* A; const bf16_t* Bt; int M, N, K; };

struct StaticOrder {
    int nM, nN, nwg, G, c;
    __host__ __device__ void init(int M, int N, int G_, int c_) { nM = M / BM; nN = N / BM; nwg = nM * nN; G = G_; c = c_; }
    __host__ __device__ bool next(int i, Unit& u) const {
        const long L = (long)i * G + c; if (L >= nwg) return false;
        int wgid = (int)L; { const int q = nwg / NXCD, r = nwg % NXCD, xcd = wgid % NXCD, off = wgid / NXCD; wgid = (xcd < r ? xcd * (q + 1) : r * (q + 1) + (xcd - r) * q) + off; }
        const int nig = WGM * nN, gid = wgid / nig, fm = gid * WGM, gsz = (nM - fm) < WGM ? (nM - fm) : WGM;
        u.pm = fm + ((wgid % nig) % gsz); u.pn = (wgid % nig) / gsz; return true;
    }
    __device__ __forceinline__ void a_ready(const Unit&) const {}
    __device__ __forceinline__ void done(const Unit&) const {}
};
__device__ __forceinline__ unsigned cvt_pk_bf16(float lo, float hi) { unsigned r; asm volatile("v_cvt_pk_bf16_f32 %0, %1, %2" : "=v"(r) : "v"(lo), "v"(hi)); return r; }
template <class Epi, class Sched, bool STAMP = false>
__device__ __forceinline__ void gemm_phase(PG8_LAS unsigned char* lds, const Gemm g, const Sched& S, const Epi& E, unsigned long long* stamps) {
    const int tid = threadIdx.x, wid = __builtin_amdgcn_readfirstlane(tid >> 6), lane = tid & 63, wr = wid >> 2, wc = wid & 3, fr = lane & 15, fq = lane >> 4;
    const int K = g.K, nt = K / BK;
    int ts_lo = 0, ts_hi = 0, nts = 0; const unsigned long long rt_entry = STAMP ? (unsigned long long)wall_clock64() : 0ull;
#define PG8_STAMP() do { if (STAMP && wid == 0 && nts < 64) { const unsigned long long _c = (unsigned long long)clock64(); \
        ts_lo = (lane == nts) ? (int)(unsigned)_c : ts_lo; ts_hi = (lane == nts) ? (int)(unsigned)(_c >> 32) : ts_hi; ++nts; } } while (0)
    PG8_STAMP();
    unsigned voffA[2], voffB[2];
#pragma unroll
    for (int i = 0; i < 2; ++i) { int R, C; stage_rc(tid * 16 + i * 8192, R, C); const int Rb = Epi::PERM ? ((R & ~31) + perm32(R & 31)) : R;
        voffA[i] = (unsigned)(R * K + C) * 2u; voffB[i] = (unsigned)(Rb * K + C) * 2u; }
    const size_t kstep = (size_t)(BK * 2);
    const size_t hstep = (size_t)HALF * K * 2;
    const size_t tstep = 2 * hstep;
    const unsigned ldsw = (unsigned)wid * 1024u;
    const int aoff = lds_byte(wr * 64 + fr, fq * 8), boff = lds_byte(wc * 32 + fr, fq * 8);
#define PG8_SA(b, h) (((b) * 2 + (h)) * HTB)
#define PG8_SB(b, h) ((4 + (b) * 2 + (h)) * HTB)
#define PG8_STAGE(bufoff, gbase, voff) do { _Pragma("unroll") for (int _i = 0; _i < 2; ++_i) \
        __builtin_amdgcn_global_load_lds((const unsigned*)((const char*)(gbase) + (voff)[_i]), (PG8_LAS unsigned*)(lds + (bufoff) + ldsw + _i * 8192), 16, 0, 0); } while (0)
#define PG8_LDA(dst, b, h) do { _Pragma("unroll") for (int m = 0; m < 4; ++m) _Pragma("unroll") for (int k = 0; k < 2; ++k) dst[m][k] = *(const PG8_LAS bf16x8*)(lds + PG8_SA(b, h) + aoff + m * 2048 + k * 1024); } while (0)
#define PG8_LDB(dst, b, h) do { _Pragma("unroll") for (int n = 0; n < 2; ++n) _Pragma("unroll") for (int k = 0; k < 2; ++k) dst[n][k] = *(const PG8_LAS bf16x8*)(lds + PG8_SB(b, h) + boff + n * 2048 + k * 1024); } while (0)
#define PG8_MMA(ai, bj, At, Bt) do { __builtin_amdgcn_s_setprio(1); _Pragma("unroll") for (int m = 0; m < 4; ++m) _Pragma("unroll") for (int n = 0; n < 2; ++n) _Pragma("unroll") for (int k = 0; k < 2; ++k) \
        acc[ai][bj][m][n] = __builtin_amdgcn_mfma_f32_16x16x32_bf16(Bt[n][k], At[m][k], acc[ai][bj][m][n], 0, 0, 0); __builtin_amdgcn_s_setprio(0); } while (0)
#define PG8_WAIT_V(n) asm volatile("s_waitcnt vmcnt(" #n ")" ::: "memory")
#define PG8_WAIT_L(n) asm volatile("s_waitcnt lgkmcnt(" #n ")" ::: "memory")
#define PG8_BAR __builtin_amdgcn_s_barrier()
#define PG8_SCHED __builtin_amdgcn_sched_barrier(0)
    Unit cur, nxt; int ui = 0;
    if (!S.next(0, cur)) return;
    f32x4 acc[2][2][4][2];
#pragma unroll
    for (int a = 0; a < 2; ++a)
#pragma unroll
        for (int b = 0; b < 2; ++b)
#pragma unroll
            for (int m = 0; m < 4; ++m)
#pragma unroll
                for (int n = 0; n < 2; ++n) acc[a][b][m][n] = (f32x4){0.f, 0.f, 0.f, 0.f};
    bf16x8 At[4][2], B0[2][2], B1[2][2];
    const char* cA = (const char*)g.A + (size_t)cur.pm * tstep; const char* cB = (const char*)g.Bt + (size_t)cur.pn * tstep;
    S.a_ready(cur);
    PG8_STAGE(PG8_SB(0, 0), cB, voffB); PG8_STAGE(PG8_SA(0, 0), cA, voffA); PG8_STAGE(PG8_SB(0, 1), cB + hstep, voffB); PG8_STAGE(PG8_SA(0, 1), cA + hstep, voffA);
    if (wr == 1) PG8_BAR;
    PG8_WAIT_V(4); PG8_BAR;
    PG8_STAGE(PG8_SB(1, 0), cB + kstep, voffB); PG8_STAGE(PG8_SA(1, 0), cA + kstep, voffA); PG8_STAGE(PG8_SB(1, 1), cB + hstep + kstep, voffB);
    PG8_WAIT_V(6); PG8_BAR;
    PG8_STAMP();
    for (;;) {
        const bool has_next = S.next(ui + 1, nxt);
        const char* nA = has_next ? (const char*)g.A + (size_t)nxt.pm * tstep : cA; const char* nB = has_next ? (const char*)g.Bt + (size_t)nxt.pn * tstep : cB;
        for (int t = 0; t < nt; t += 2) {
            const bool last = (t == nt - 2);
            const char* a1 = cA + (size_t)(t + 1) * kstep;
            const char* a2 = last ? nA : cA + (size_t)(t + 2) * kstep; const char* b2 = last ? nB : cB + (size_t)(t + 2) * kstep;
            const char* a3 = a2 + kstep; const char* b3 = b2 + kstep;
            if (last && has_next) S.a_ready(nxt);
            PG8_LDB(B0, 0, 0); PG8_SCHED; PG8_LDA(At, 0, 0); PG8_STAGE(PG8_SA(1, 1), a1 + hstep, voffA);
            PG8_WAIT_L(8); PG8_BAR; PG8_WAIT_L(0); PG8_MMA(0, 0, At, B0); PG8_BAR; PG8_SCHED;
            PG8_LDB(B1, 0, 1); PG8_STAGE(PG8_SB(0, 0), b2, voffB);
            PG8_BAR; PG8_WAIT_L(0); PG8_MMA(0, 1, At, B1); PG8_BAR;
            PG8_LDA(At, 0, 1); PG8_STAGE(PG8_SA(0, 0), a2, voffA);
            PG8_BAR; PG8_WAIT_L(0); PG8_MMA(1, 0, At, B0); PG8_BAR; PG8_SCHED;
            PG8_STAGE(PG8_SB(0, 1), b2 + hstep, voffB);
            PG8_WAIT_V(6); PG8_BAR; PG8_MMA(1, 1, At, B1); PG8_BAR;
            PG8_LDB(B0, 1, 0); PG8_SCHED; PG8_LDA(At, 1, 0); PG8_STAGE(PG8_SA(0, 1), a2 + hstep, voffA);
            PG8_WAIT_L(8); PG8_BAR; PG8_WAIT_L(0); PG8_MMA(0, 0, At, B0); PG8_BAR; PG8_SCHED;
            PG8_LDB(B1, 1, 1); PG8_STAGE(PG8_SB(1, 0), b3, voffB);
            PG8_BAR; PG8_WAIT_L(0); PG8_MMA(0, 1, At, B1); PG8_BAR;
            PG8_LDA(At, 1, 1); PG8_STAGE(PG8_SA(1, 0), a3, voffA);
            PG8_BAR; PG8_WAIT_L(0); PG8_MMA(1, 0, At, B0); PG8_BAR; PG8_SCHED;
            PG8_STAGE(PG8_SB(1, 1), b3 + hstep, voffB);
            PG8_WAIT_V(6); PG8_BAR; PG8_MMA(1, 1, At, B1); PG8_BAR;
        }
        PG8_STAMP();
        if constexpr (!Epi::AFTER_DRAIN) { E(acc, cur, wr, wc, fr, fq); S.done(cur); }
        PG8_STAMP();
        if (!has_next) break;
#pragma unroll
        for (int a = 0; a < 2; ++a)
#pragma unroll
            for (int b = 0; b < 2; ++b)
#pragma unroll
                for (int m = 0; m < 4; ++m)
#pragma unroll
                    for (int n = 0; n < 2; ++n) acc[a][b][m][n] = (f32x4){0.f, 0.f, 0.f, 0.f};
        cur = nxt; cA = nA; cB = nB; ++ui;
    }
    PG8_WAIT_V(0);
    if (wr == 0) PG8_BAR;
    PG8_BAR;
    if constexpr (Epi::AFTER_DRAIN) { E.fused(acc, cur, wr, wc, fr, fq, lds, wid, lane); S.done(cur); }
    PG8_STAMP();
    if (STAMP && wid == 0) { stamps[lane] = lane < nts ? (((unsigned long long)(unsigned)ts_hi << 32) | (unsigned)ts_lo) : 0ull;
        if (lane == 62) stamps[62] = rt_entry; if (lane == 63) stamps[63] = (unsigned long long)wall_clock64(); }
#undef PG8_STAMP
#undef PG8_SA
#undef PG8_SB
#undef PG8_STAGE
#undef PG8_LDA
#undef PG8_LDB
#undef PG8_MMA
#undef PG8_WAIT_V
#undef PG8_WAIT_L
#undef PG8_BAR
#undef PG8_SCHED
}
}

using pg8::bf16x8; using pg8::f32x4; using pg8::u32x4;
typedef __bf16 bf16x2_t __attribute__((ext_vector_type(2)));
typedef float f32x2_t __attribute__((ext_vector_type(2)));
__device__ __forceinline__ unsigned cvt_pk_bf16(float lo, float hi) { f32x2_t f = {lo, hi}; bf16x2_t b = __builtin_convertvector(f, bf16x2_t); return __builtin_bit_cast(unsigned, b); }
typedef unsigned short u16;
typedef unsigned long long u64;
typedef unsigned u32x2 __attribute__((ext_vector_type(2)));
#define LAS __attribute__((address_space(3)))
#define DI __device__ __forceinline__

constexpr int T_ = 32768, D_ = 1024, DFF = 2816, NUP = 5632, NIN = 4608, SEQ = 8192;
constexpr float ALPHA = 1.41421356237309515f, LN_EPS = 1e-5f, LOG2E = 1.44269504088896f;
constexpr int NTHR = 512;
constexpr int LDS_BYTES = 155648;

constexpr size_t SZ_WUP = (size_t)NUP * D_ * 2, SZ_WDN = (size_t)D_ * DFF * 2, SZ_WIN = (size_t)NIN * D_ * 2, SZ_WGLU = 512 * 512 * 2, SZ_WB = (size_t)1024 * 512 * 2, SZ_WOUT = (size_t)1024 * 1024 * 2;
constexpr size_t OFF_UP1 = 0, OFF_DN1 = OFF_UP1 + SZ_WUP, OFF_WIN = OFF_DN1 + SZ_WDN, OFF_GLU = OFF_WIN + SZ_WIN, OFF_WB0 = OFF_GLU + SZ_WGLU, OFF_WB1 = OFF_WB0 + SZ_WB,
                 OFF_WOUT = OFF_WB1 + SZ_WB, OFF_UP2 = OFF_WOUT + SZ_WOUT, OFF_DN2 = OFF_UP2 + SZ_WUP, SZ_LAYERW = OFF_DN2 + SZ_WDN;
constexpr size_t MiB = 1048576;
constexpr size_t SZ_TABL = 512 * 1024;
constexpr size_t TAB_A1 = 0, TAB_A64 = 16384, TAB_BB = 32768, TAB_CT = 32768 + 262144;
constexpr size_t WS_W = 0, WS_TAB = 2 * SZ_LAYERW, WS_XB = WS_TAB + 2 * SZ_TABL, WS_H = WS_XB + 64 * MiB, WS_GS = WS_H + 176 * MiB, WS_GA = WS_GS + 64 * MiB, WS_END = WS_GA + 64 * MiB;
constexpr size_t H_U = 0, H_Q = 32 * MiB, H_K = 64 * MiB, H_V = 96 * MiB, H_QI = 128 * MiB, H_KIB = 144 * MiB, H_WI = 146 * MiB, H_SLOC = 147 * MiB, H_MASK = 155 * MiB;
constexpr int MASK_PER_B = 33024;

struct Args { const float* in[24]; float* out; unsigned char* ws; int lo, hi; };

struct Frame {
    const float* const* in; float* out; unsigned char* ws;
    int tid, lane, wave;
};
#define FP(F, T, off) ((T*)((F).ws + (off)))
#define F_XB(F) FP(F, u16, WS_XB)
#define F_H(F) FP(F, u16, WS_H)
#define F_U(F) FP(F, u16, WS_H + H_U)
#define F_Q(F) FP(F, u16, WS_H + H_Q)
#define F_K(F) FP(F, u16, WS_H + H_K)
#define F_V(F) FP(F, u16, WS_H + H_V)
#define F_QI(F) FP(F, u16, WS_H + H_QI)
#define F_KIB(F) FP(F, u16, WS_H + H_KIB)
#define F_WI(F) FP(F, float, WS_H + H_WI)
#define F_SLOC(F) FP(F, float, WS_H + H_SLOC)
#define F_MASK(F) FP(F, u16, WS_H + H_MASK)
#define F_GS(F) FP(F, u16, WS_GS)
#define F_GA(F) FP(F, u16, WS_GA)
#define F_YS(F) FP(F, u16, WS_XB)
#define F_VT(F) FP(F, u16, WS_XB + 32 * MiB)

DI float bf_lo(unsigned u) { return __uint_as_float(u << 16); }
DI float bf_hi(unsigned u) { return __uint_as_float(u & 0xffff0000u); }
DI float fsigmoid(float x) { return __builtin_amdgcn_rcpf(1.0f + __expf(-x)); }
DI u32x4 pack8(const f32x4& a, const f32x4& b) { u32x4 w; w.x = cvt_pk_bf16(a[0], a[1]); w.y = cvt_pk_bf16(a[2], a[3]); w.z = cvt_pk_bf16(b[0], b[1]); w.w = cvt_pk_bf16(b[2], b[3]); return w; }
DI void unpack8(const u32x4& w, f32x4& a, f32x4& b) { a[0] = bf_lo(w.x); a[1] = bf_hi(w.x); a[2] = bf_lo(w.y); a[3] = bf_hi(w.y); b[0] = bf_lo(w.z); b[1] = bf_hi(w.z); b[2] = bf_lo(w.w); b[3] = bf_hi(w.w); }

struct EpiUp {
    static constexpr bool PERM = true, AFTER_DRAIN = false;
    u16* H;
    DI void operator()(const f32x4 (&acc)[2][2][4][2], const pg8::Unit& u, int wr, int wc, int fr, int fq) const {
        const int row0 = u.pm * 256 + wr * 64 + fr, col0 = u.pn * 128 + wc * 32 + 8 * fq;
#pragma unroll
        for (int ai = 0; ai < 2; ++ai)
#pragma unroll
            for (int m = 0; m < 4; ++m) {
                f32x4 o0, o1;
#pragma unroll
                for (int j = 0; j < 4; ++j) { const float g0 = acc[ai][0][m][0][j], g1 = acc[ai][0][m][1][j]; o0[j] = g0 * fsigmoid(g0) * acc[ai][1][m][0][j]; o1[j] = g1 * fsigmoid(g1) * acc[ai][1][m][1][j]; }
                *(u32x4*)(H + (size_t)(row0 + ai * 128 + m * 16) * DFF + col0) = pack8(o0, o1);
            }
    }
};
struct EpiRes {
    static constexpr bool PERM = false, AFTER_DRAIN = false;
    const float* R; float* Y; float sc;
    DI void operator()(const f32x4 (&acc)[2][2][4][2], const pg8::Unit& u, int wr, int wc, int fr, int fq) const {
        const int row0 = u.pm * 256 + wr * 64 + fr, col0 = u.pn * 256 + wc * 32 + 4 * fq;
#pragma unroll
        for (int ai = 0; ai < 2; ++ai)
#pragma unroll
            for (int m = 0; m < 4; ++m) { const size_t off = (size_t)(row0 + ai * 128 + m * 16) * D_ + col0;
#pragma unroll
                for (int bj = 0; bj < 2; ++bj)
#pragma unroll
                    for (int n = 0; n < 2; ++n) { const f32x4 r = *(const f32x4*)(R + off + bj * 128 + n * 16); *(f32x4*)(Y + off + bj * 128 + n * 16) = r * ALPHA + acc[ai][bj][m][n] * sc; } }
    }
};
struct EpiIn {
    static constexpr bool PERM = true, AFTER_DRAIN = false;
    unsigned char* ws;
    DI void operator()(const f32x4 (&acc)[2][2][4][2], const pg8::Unit& u, int wr, int wc, int fr, int fq) const {
        const int row0 = u.pm * 256 + wr * 64 + fr, cl = wc * 32 + 8 * fq, pn = u.pn;
        size_t boff; int ld, c0;
        if (pn < 8) { boff = WS_H + (size_t)(pn >> 1) * (32 * MiB); ld = 512; c0 = (pn & 1) * 256; }
        else if (pn == 8) { boff = WS_H + H_QI; ld = 256; c0 = 0; }
        else if (pn == 9) { boff = WS_H + H_KIB; ld = 32; c0 = 0; }
        else { boff = WS_GS + (size_t)((pn - 10) >> 2) * (64 * MiB); ld = 1024; c0 = ((pn - 10) & 3) * 256; }
        u16* base = (u16*)(ws + boff); float* WI = (float*)(ws + WS_H + H_WI);
#pragma unroll
        for (int ai = 0; ai < 2; ++ai)
#pragma unroll
            for (int m = 0; m < 4; ++m) { const size_t row = (size_t)(row0 + ai * 128 + m * 16);
#pragma unroll
                for (int bj = 0; bj < 2; ++bj) { const int c = bj * 128 + cl; f32x4 v0 = acc[ai][bj][m][0], v1 = acc[ai][bj][m][1];
                    if (pn == 9) { if (c < 32) *(u32x4*)(base + row * 32 + c) = pack8(v0, v1); else if (c == 32) { *(f32x4*)(WI + row * 8) = v0; *(f32x4*)(WI + row * 8 + 4) = v1; } }
                    else { if (pn >= 10) {
#pragma unroll
                            for (int j = 0; j < 4; ++j) { v0[j] = fsigmoid(v0[j]); v1[j] = fsigmoid(v1[j]); } }
                        *(u32x4*)(base + row * ld + c0 + c) = pack8(v0, v1); } } }
    }
};
template <int MODE> struct EpiMix {
    static constexpr bool PERM = true, AFTER_DRAIN = false;
    const u16* A; const u16* Bsrc; u16* O; int ldc;
    DI void operator()(const f32x4 (&acc)[2][2][4][2], const pg8::Unit& u, int wr, int wc, int fr, int fq) const {
        const int row0 = u.pm * 256 + wr * 64 + fr, col0 = u.pn * 256 + wc * 32 + 8 * fq;
#pragma unroll
        for (int ai = 0; ai < 2; ++ai)
#pragma unroll
            for (int m = 0; m < 4; ++m) { const size_t off = (size_t)(row0 + ai * 128 + m * 16) * ldc + col0;
#pragma unroll
                for (int bj = 0; bj < 2; ++bj) { f32x4 v0 = acc[ai][bj][m][0], v1 = acc[ai][bj][m][1], a0, a1;
                    const u32x4 aw = *(const u32x4*)(A + off + bj * 128); unpack8(aw, a0, a1);
                    if (MODE == 0) {
#pragma unroll
                        for (int j = 0; j < 4; ++j) { v0[j] = a0[j] * fsigmoid(v0[j]); v1[j] = a1[j] * fsigmoid(v1[j]); } }
                    else if (MODE == 1) { v0 = a0 * v0; v1 = a1 * v1; }
                    else { f32x4 b0, b1; const u32x4 bw = *(const u32x4*)(Bsrc + off + bj * 128); unpack8(bw, b0, b1); v0 = b0 + a0 * v0; v1 = b1 + a1 * v1; }
                    *(u32x4*)(O + off + bj * 128) = pack8(v0, v1); } }
    }
};

template <class Epi> DI void run_gemm(LAS unsigned char* lds, const u16* A, const u16* Bt, int N, int K, const Epi& E) {
    pg8::Gemm g{A, Bt, T_, N, K}; pg8::StaticOrder S; S.init(T_, N, (int)gridDim.x, (int)blockIdx.x);
    pg8::gemm_phase<Epi, pg8::StaticOrder, false>(lds, g, S, E, nullptr);
    __syncthreads();
}

DI int srccol(int map, int n) {
    if (map == 0) return n;
    if (map == 1) { const int pn = n >> 8, r = n & 255; return r < 128 ? 128 * pn + r : DFF + 128 * pn + (r - 128); }
    return n < 2344 ? n : (n < 2560 ? -1 : n - 216);
}
DI void tconv(LAS float* tl  , const float* src, int Nsrc, int K, u16* dst, int Np, int map, int tid) {
    const int tilesN = Np >> 6, tilesK = K >> 6, ntile = tilesN * tilesK;
    for (int tile = blockIdx.x; tile < ntile; tile += gridDim.x) {
        const int tn = tile % tilesN, tk = tile / tilesN;
        { const int c = tid & 63, r0 = tid >> 6; const int sc = srccol(map, tn * 64 + c);
#pragma unroll
          for (int rr = 0; rr < 8; ++rr) { const int r = r0 + 8 * rr; tl[r * 65 + c] = sc >= 0 ? src[(size_t)(tk * 64 + r) * Nsrc + sc] : 0.f; } }
        __syncthreads();
        { const int kk2 = (tid & 31) * 2, n0 = tid >> 5;
#pragma unroll
          for (int rr = 0; rr < 4; ++rr) { const int n = n0 + 16 * rr; *(unsigned*)(dst + (size_t)(tn * 64 + n) * K + tk * 64 + kk2) = cvt_pk_bf16(tl[kk2 * 65 + n], tl[(kk2 + 1) * 65 + n]); } }
        __syncthreads();
    }
}
DI void ssm_tables(const Frame& F, int l, int g, int p) {
    unsigned char* tab = F.ws + WS_TAB + (size_t)l * SZ_TABL;
    const int lg = l * 32 + g;
    const double lr = fmin((double)F.in[6][lg * 64 + p], -1e-4), li = (double)F.in[7][lg * 64 + p], dt = exp((double)F.in[8][lg]);
    const double zr = lr * dt, zi = li * dt, ea = exp(zr);
    double ar = ea * cos(zi), ai = ea * sin(zi);
    const double nr = ar - 1.0, ni = ai, den = lr * lr + li * li, fr_ = (nr * lr + ni * li) / den, fi_ = (ni * lr - nr * li) / den;
    ((float*)(tab + TAB_A1))[(g * 64 + p) * 2] = (float)ar; ((float*)(tab + TAB_A1))[(g * 64 + p) * 2 + 1] = (float)ai;
    double pr = ar, pi = ai;
#pragma unroll 1
    for (int s = 0; s < 6; ++s) { const double t = pr * pr - pi * pi; pi = 2.0 * pr * pi; pr = t; }
    ((float*)(tab + TAB_A64))[(g * 64 + p) * 2] = (float)pr; ((float*)(tab + TAB_A64))[(g * 64 + p) * 2 + 1] = (float)pi;
    float* BB = (float*)(tab + TAB_BB) + (size_t)g * 32 * 64;
    const float* bre = F.in[9] + ((size_t)lg * 64 + p) * 16; const float* bim = F.in[10] + ((size_t)lg * 64 + p) * 16;
#pragma unroll 1
    for (int h = 0; h < 16; ++h) { const double br = bre[h], bi = bim[h]; BB[(2 * h) * 64 + p] = (float)(fr_ * br - fi_ * bi); BB[(2 * h + 1) * 64 + p] = (float)(fr_ * bi + fi_ * br); }
    u16* CT = (u16*)(tab + TAB_CT) + (size_t)g * 16 * 128;
    const float* cre = F.in[11] + (size_t)lg * 16 * 64; const float* cim = F.in[12] + (size_t)lg * 16 * 64;
#pragma unroll 1
    for (int h = 0; h < 16; ++h) { *(unsigned*)(CT + h * 128 + 2 * p) = cvt_pk_bf16(cre[h * 64 + p], -cim[h * 64 + p]); }
}
DI void p0_phase(const Frame& F, LAS unsigned char* lds) {
    LAS float* tl = (LAS float*)lds;
    for (int l = 0; l < 2; ++l) {
        unsigned char* wl = F.ws + WS_W + (size_t)l * SZ_LAYERW;
        tconv(tl, F.in[1] + (size_t)l * D_ * NUP, NUP, D_, (u16*)(wl + OFF_UP1), NUP, 1, F.tid);
        tconv(tl, F.in[2] + (size_t)l * DFF * D_, D_, DFF, (u16*)(wl + OFF_DN1), D_, 0, F.tid);
        tconv(tl, F.in[5] + (size_t)l * D_ * 4392, 4392, D_, (u16*)(wl + OFF_WIN), NIN, 2, F.tid);
        tconv(tl, F.in[14] + (size_t)l * 512 * 512, 512, 512, (u16*)(wl + OFF_GLU), 512, 0, F.tid);
        tconv(tl, F.in[15] + (size_t)(l * 2 + 0) * 512 * 1024, 1024, 512, (u16*)(wl + OFF_WB0), 1024, 0, F.tid);
        tconv(tl, F.in[15] + (size_t)(l * 2 + 1) * 512 * 1024, 1024, 512, (u16*)(wl + OFF_WB1), 1024, 0, F.tid);
        tconv(tl, F.in[16] + (size_t)l * 1024 * 1024, 1024, 1024, (u16*)(wl + OFF_WOUT), 1024, 0, F.tid);
        tconv(tl, F.in[19] + (size_t)l * D_ * NUP, NUP, D_, (u16*)(wl + OFF_UP2), NUP, 1, F.tid);
        tconv(tl, F.in[20] + (size_t)l * DFF * D_, D_, DFF, (u16*)(wl + OFF_DN2), D_, 0, F.tid);
    }
    { const size_t n4 = (size_t)T_ * D_ / 4; const f32x4* x4 = (const f32x4*)F.in[0]; u32x2* o = (u32x2*)F_XB(F);
      for (size_t i = (size_t)blockIdx.x * NTHR + F.tid; i < n4; i += (size_t)gridDim.x * NTHR) { const f32x4 v = x4[i]; u32x2 w; w.x = cvt_pk_bf16(v[0], v[1]); w.y = cvt_pk_bf16(v[2], v[3]); o[i] = w; } }
    { const int gw = blockIdx.x * 8 + F.wave; if (gw < 64) ssm_tables(F, gw >> 5, gw & 31, F.lane); }
}

DI float wave_sum(float v) {
#pragma unroll
    for (int o = 32; o >= 1; o >>= 1) v += __shfl_xor(v, o);
    return v;
}
DI void ln_phase(const Frame& F, const float* g, const float* b) {
    const int lane = F.lane; f32x4 gv[4], bv[4];
#pragma unroll
    for (int i = 0; i < 4; ++i) { gv[i] = *(const f32x4*)(g + i * 256 + lane * 4); bv[i] = *(const f32x4*)(b + i * 256 + lane * 4); }
    for (int row = blockIdx.x * 8 + F.wave; row < T_; row += gridDim.x * 8) {
        float* p = F.out + (size_t)row * D_; f32x4 v[4]; float s = 0.f;
#pragma unroll
        for (int i = 0; i < 4; ++i) { v[i] = *(const f32x4*)(p + i * 256 + lane * 4); s += (v[i][0] + v[i][1]) + (v[i][2] + v[i][3]); }
        const float mean = wave_sum(s) * (1.0f / 1024.0f); float q = 0.f;
#pragma unroll
        for (int i = 0; i < 4; ++i) { v[i] = v[i] - mean; q += (v[i][0] * v[i][0] + v[i][1] * v[i][1]) + (v[i][2] * v[i][2] + v[i][3] * v[i][3]); }
        const float rstd = rsqrtf(wave_sum(q) * (1.0f / 1024.0f) + LN_EPS);
#pragma unroll
        for (int i = 0; i < 4; ++i) { const f32x4 y = v[i] * rstd * gv[i] + bv[i]; *(f32x4*)(p + i * 256 + lane * 4) = y;
            u32x2 w; w.x = cvt_pk_bf16(y[0], y[1]); w.y = cvt_pk_bf16(y[2], y[3]); *(u32x2*)(F_XB(F) + (size_t)row * D_ + i * 256 + lane * 4) = w; }
    }
}

DI void wave_lds_fence() { asm volatile("s_waitcnt lgkmcnt(0)" ::: "memory"); __builtin_amdgcn_wave_barrier(); }
DI float gelu_tanh(float x) { const float z = 0.7978845608028654f * (x + 0.044715f * x * x * x); return x * __builtin_amdgcn_rcpf(1.0f + __expf(-2.0f * z)); }

DI void vt_tile(const Frame& F, LAS unsigned char* wl, int tile) {
    LAS u16* tb = (LAS u16*)wl;
    const int tt = tile >> 3, hb = tile & 7, lane = F.lane; const int t0 = tt * 64;
    const u16* src = F_V(F) + (size_t)(t0 + lane) * 512 + hb * 64;
#pragma unroll
    for (int c = 0; c < 8; ++c) *(LAS u32x4*)(tb + lane * 72 + c * 8) = *(const u32x4*)(src + c * 8);
    wave_lds_fence();
    const int b = t0 >> 13, tl = t0 & 8191;
    u16* dst = F_VT(F) + ((size_t)(b * 512 + hb * 64 + lane)) * SEQ + tl;
#pragma unroll
    for (int c = 0; c < 8; ++c) { u32x4 w; unsigned e[8];
#pragma unroll
        for (int j = 0; j < 8; ++j) e[j] = tb[(c * 8 + j) * 72 + lane];
        w.x = e[0] | (e[1] << 16); w.y = e[2] | (e[3] << 16); w.z = e[4] | (e[5] << 16); w.w = e[6] | (e[7] << 16);
        *(u32x4*)(dst + c * 8) = w; }
    wave_lds_fence();
}
DI void ssmA_item(const Frame& F, const unsigned char* tab, LAS unsigned char* wl, int item) {
    LAS u16* ut = (LAS u16*)wl;
    const int chunk = item >> 5, g = item & 31, lane = F.lane; const int t0 = chunk * 64;
    { const u16* up = F_U(F) + (size_t)(t0 + lane) * 512 + g * 16; const u32x4 a = *(const u32x4*)up, b = *(const u32x4*)(up + 8);
      *(LAS u32x4*)(ut + lane * 16) = a; *(LAS u32x4*)(ut + lane * 16 + 8) = b; }
    const float ar = ((const float*)(tab + TAB_A1))[(g * 64 + lane) * 2], ai = ((const float*)(tab + TAB_A1))[(g * 64 + lane) * 2 + 1];
    float bb[32]; const float* BB = (const float*)(tab + TAB_BB) + (size_t)g * 32 * 64 + lane;
#pragma unroll
    for (int k = 0; k < 32; ++k) bb[k] = BB[k * 64];
    wave_lds_fence();
    float sr = 0.f, si = 0.f;
#pragma unroll 2
    for (int j = 0; j < 64; ++j) {
        const u32x4 x0 = *(LAS u32x4*)(ut + j * 16), x1 = *(LAS u32x4*)(ut + j * 16 + 8);
        const unsigned xs[8] = {x0.x, x0.y, x0.z, x0.w, x1.x, x1.y, x1.z, x1.w};
        float br = 0.f, bi = 0.f;
#pragma unroll
        for (int k = 0; k < 8; ++k) { const float u0 = bf_lo(xs[k]), u1 = bf_hi(xs[k]); br += bb[4 * k] * u0 + bb[4 * k + 2] * u1; bi += bb[4 * k + 1] * u0 + bb[4 * k + 3] * u1; }
        const float nr = ar * sr - ai * si + br, ni = ar * si + ai * sr + bi; sr = nr; si = ni;
    }
    *(float2*)(F_SLOC(F) + ((size_t)item * 64 + lane) * 2) = make_float2(sr, si);
    wave_lds_fence();
}
DI void ssmC_item(const Frame& F, const unsigned char* tab, const float* dskip, LAS unsigned char* wl, int item) {
    LAS u16* ut = (LAS u16*)wl;
    LAS unsigned* st = (LAS unsigned*)(wl + 2048);
    const int chunk = item >> 5, g = item & 31, lane = F.lane, lq = lane & 15, g4 = lane >> 4; const int t0 = chunk * 64;
    { const u16* up = F_U(F) + (size_t)(t0 + lane) * 512 + g * 16; const u32x4 a = *(const u32x4*)up, b = *(const u32x4*)(up + 8);
      *(LAS u32x4*)(ut + lane * 16) = a; *(LAS u32x4*)(ut + lane * 16 + 8) = b; }
    const float ar = ((const float*)(tab + TAB_A1))[(g * 64 + lane) * 2], ai = ((const float*)(tab + TAB_A1))[(g * 64 + lane) * 2 + 1];
    const float cr = ((const float*)(tab + TAB_A64))[(g * 64 + lane) * 2], ci = ((const float*)(tab + TAB_A64))[(g * 64 + lane) * 2 + 1];
    float sr = 0.f, si = 0.f;
    { const int cin = chunk & 127, c0 = chunk - cin; const float2* sl = (const float2*)F_SLOC(F) + ((size_t)c0 * 32 + g) * 64 + lane;
#pragma unroll 4
      for (int c = 0; c < cin; ++c) { const float2 v = sl[(size_t)c * 32 * 64]; const float nr = cr * sr - ci * si + v.x, ni = cr * si + ci * sr + v.y; sr = nr; si = ni; } }
    float bb[32]; const float* BB = (const float*)(tab + TAB_BB) + (size_t)g * 32 * 64 + lane;
#pragma unroll
    for (int k = 0; k < 32; ++k) bb[k] = BB[k * 64];
    wave_lds_fence();
#pragma unroll 2
    for (int j = 0; j < 64; ++j) {
        const u32x4 x0 = *(LAS u32x4*)(ut + j * 16), x1 = *(LAS u32x4*)(ut + j * 16 + 8);
        const unsigned xs[8] = {x0.x, x0.y, x0.z, x0.w, x1.x, x1.y, x1.z, x1.w};
        float br = 0.f, bi = 0.f;
#pragma unroll
        for (int k = 0; k < 8; ++k) { const float u0 = bf_lo(xs[k]), u1 = bf_hi(xs[k]); br += bb[4 * k] * u0 + bb[4 * k + 2] * u1; bi += bb[4 * k + 1] * u0 + bb[4 * k + 3] * u1; }
        const float nr = ar * sr - ai * si + br, ni = ar * si + ai * sr + bi; sr = nr; si = ni;
        st[j * 68 + lane] = cvt_pk_bf16(sr, si);
    }
    wave_lds_fence();
    const u16* CT = (const u16*)(tab + TAB_CT) + (size_t)g * 16 * 128;
    bf16x8 cf[4];
#pragma unroll
    for (int ks = 0; ks < 4; ++ks) cf[ks] = *(const bf16x8*)(CT + lq * 128 + ks * 32 + g4 * 8);
    const f32x4 dv = *(const f32x4*)(dskip + g * 16 + g4 * 4);
#pragma unroll
    for (int mt = 0; mt < 4; ++mt) {
        f32x4 acc = {0.f, 0.f, 0.f, 0.f};
#pragma unroll
        for (int ks = 0; ks < 4; ++ks) { const bf16x8 sf = *(LAS bf16x8*)(st + (mt * 16 + lq) * 68 + ks * 16 + g4 * 4); acc = __builtin_amdgcn_mfma_f32_16x16x32_bf16(cf[ks], sf, acc, 0, 0, 0); }
        const int l = mt * 16 + lq; const u32x2 uw = *(LAS u32x2*)(ut + l * 16 + g4 * 4);
        const float u0 = bf_lo(uw.x), u1 = bf_hi(uw.x), u2 = bf_lo(uw.y), u3 = bf_hi(uw.y);
        u32x2 o; o.x = cvt_pk_bf16(gelu_tanh(acc[0] + dv[0] * u0), gelu_tanh(acc[1] + dv[1] * u1)); o.y = cvt_pk_bf16(gelu_tanh(acc[2] + dv[2] * u2), gelu_tanh(acc[3] + dv[3] * u3));
        *(u32x2*)(F_U(F) + (size_t)(t0 + l) * 512 + g * 16 + g4 * 4) = o;
    }
    wave_lds_fence();
}

DI unsigned fkey(float x) { const unsigned u = __float_as_uint(x + 0.0f); return (u & 0x80000000u) ? ~u : (u | 0x80000000u); }
DI f32x4 idx_scores(const u16* kib, int key0, int lq, int g4, const bf16x8 (&qf)[8], const float (&w)[8]) {
    const bf16x8 af = *(const bf16x8*)(kib + (size_t)(key0 + lq) * 32 + g4 * 8);
    f32x4 sc = {0.f, 0.f, 0.f, 0.f};
#pragma unroll
    for (int h = 0; h < 8; ++h) { const f32x4 z = {0.f, 0.f, 0.f, 0.f}; const f32x4 a = __builtin_amdgcn_mfma_f32_16x16x32_bf16(af, qf[h], z, 0, 0, 0);
#pragma unroll
        for (int i = 0; i < 4; ++i) sc[i] += w[h] * fmaxf(a[i], 0.f); }
    return sc;
}
DI void idx_phase(const Frame& F, LAS unsigned char* lds) {
    LAS unsigned* hist = (LAS unsigned*)lds;
    LAS unsigned* rpre = (LAS unsigned*)(lds + 65536);
    LAS unsigned* rneed = rpre + 64; LAS unsigned* rcut = rpre + 128; LAS unsigned* flags = rpre + 192;
    const int tid = F.tid, lane = F.lane, wave = F.wave, lq = lane & 15, g4 = lane >> 4, rg = wave & 3, kp = wave >> 2, rl = rg * 16 + lq;
    for (int pair = blockIdx.x; pair < 256; pair += gridDim.x) {
        const int b = pair >> 6, jj = pair & 63;
        for (int which = 0; which < 2; ++which) {
            const int tile = which ? 127 - jj : jj, nkb = tile + 1;
            const size_t tq = (size_t)b * SEQ + tile * 64 + rl;
            bf16x8 qf[8]; float w[8];
#pragma unroll
            for (int h = 0; h < 8; ++h) qf[h] = *(const bf16x8*)(F_QI(F) + tq * 256 + h * 32 + g4 * 8);
            { const f32x4 w0 = *(const f32x4*)(F_WI(F) + tq * 8), w1 = *(const f32x4*)(F_WI(F) + tq * 8 + 4);
#pragma unroll
              for (int i = 0; i < 4; ++i) { w[i] = w0[i]; w[4 + i] = w1[i]; } }
            const u16* kib = F_KIB(F) + (size_t)b * SEQ * 32;
            unsigned thr = 0u, cut = 0x7fffffffu;
            if (nkb > 4) {
                if (tid < 64) { rpre[tid] = 0u; rneed[tid] = 256u; rcut[tid] = 0x7fffffffu; }
                if (tid == 0) flags[0] = 0u;
                for (int i = tid; i < 4096; i += NTHR) ((LAS u32x4*)hist)[i] = (u32x4){0u, 0u, 0u, 0u};
                __syncthreads();
#pragma unroll 1
                for (int pass = 0; pass < 4; ++pass) {
                    const int shift = 24 - 8 * pass; const unsigned pre = rpre[rl];
#pragma unroll 1
                    for (int kb = kp; kb < nkb; kb += 2)
#pragma unroll 1
                        for (int st = 0; st < 4; ++st) {
                            const f32x4 sc = idx_scores(kib, kb * 64 + st * 16, lq, g4, qf, w);
#pragma unroll
                            for (int i = 0; i < 4; ++i) { const unsigned key = fkey(sc[i]); const bool ok = (pass == 0) || ((key >> ((shift + 8) & 31)) == pre);
                                if (ok) __hip_atomic_fetch_add(hist + rl * 256 + ((key >> shift) & 255u), 1u, __ATOMIC_RELAXED, __HIP_MEMORY_SCOPE_WORKGROUP); }
                        }
                    __syncthreads();
#pragma unroll 1
                    for (int rr = 0; rr < 8; ++rr) {
                        const int row = wave * 8 + rr; const u32x4 c4 = *(LAS u32x4*)(hist + row * 256 + lane * 4); const unsigned c = c4.x + c4.y + c4.z + c4.w;
                        unsigned s = c;
#pragma unroll
                        for (int off = 1; off < 64; off <<= 1) { const unsigned t = __shfl_down(s, off); if (lane + off < 64) s += t; }
                        const unsigned need = rneed[row]; const u64 bal = __ballot(s >= need); const int L = 63 - __clzll(bal);
                        if (lane == L) { unsigned cum = s - c, d, ne;
                            if (cum + c4.w >= need) { d = 3; ne = c4.w; } else { cum += c4.w; if (cum + c4.z >= need) { d = 2; ne = c4.z; } else { cum += c4.z; if (cum + c4.y >= need) { d = 1; ne = c4.y; } else { cum += c4.y; d = 0; ne = c4.x; } } }
                            const unsigned nn = need - cum; rpre[row] = (rpre[row] << 8) | (unsigned)(L * 4 + d); rneed[row] = nn;
                            if (pass == 3 && nn < ne) { flags[0] = 1u; rcut[row] = 0xffffffffu; } }
                    }
                    __syncthreads();
                    if (pass < 3) { for (int i = tid; i < 4096; i += NTHR) ((LAS u32x4*)hist)[i] = (u32x4){0u, 0u, 0u, 0u}; }
                    __syncthreads();
                }
                thr = rpre[rl];
                if (flags[0] != 0u) {
                    if (kp == 0) {
                        const bool need_res = rcut[rl] == 0xffffffffu; unsigned rem = rneed[rl], mycut = 0x7fffffffu;
#pragma unroll 1
                        for (int kb = 0; kb < nkb; ++kb)
#pragma unroll 1
                            for (int st = 0; st < 4; ++st) {
                                const f32x4 sc = idx_scores(kib, kb * 64 + st * 16, lq, g4, qf, w);
                                int tie[4]; int any = 0;
#pragma unroll
                                for (int i = 0; i < 4; ++i) { tie[i] = (need_res && fkey(sc[i]) == thr) ? 1 : 0; any |= tie[i]; }
                                if (__any(any)) {
#pragma unroll
                                    for (int gg = 0; gg < 4; ++gg)
#pragma unroll
                                        for (int i = 0; i < 4; ++i) { const int f = (g4 == gg) ? tie[i] : 0; const int c = __shfl(f, gg * 16 + lq);
                                            if (c && rem > 0u) { --rem; if (rem == 0u) mycut = (unsigned)(kb * 64 + st * 16 + gg * 4 + i); } }
                                }
                            }
                        if (need_res && g4 == 0) rcut[rl] = mycut;
                    }
                    __syncthreads();
                }
                cut = rcut[rl];
            }
            const size_t mbase = (size_t)b * MASK_PER_B + (size_t)(tile + 1) * (2 * tile + rg);
#pragma unroll 1
            for (int kb = kp; kb < nkb; kb += 2) {
                unsigned bits = 0xffffu;
                if (nkb > 4) { bits = 0u;
#pragma unroll 1
                    for (int st = 0; st < 4; ++st) {
                        const f32x4 sc = idx_scores(kib, kb * 64 + st * 16, lq, g4, qf, w);
#pragma unroll
                        for (int i = 0; i < 4; ++i) { const unsigned key = fkey(sc[i]); const unsigned idx = (unsigned)(kb * 64 + st * 16 + g4 * 4 + i);
                            const bool take = key > thr || (key == thr && idx <= cut); bits |= (take ? 1u : 0u) << (st * 4 + i); }
                    } }
                F_MASK(F)[(mbase + kb) * 64 + lane] = (u16)bits;
            }
            __syncthreads();
        }
    }
}

DI int t5_bucket(int rel) {
    const int n = rel < 0 ? -rel : rel;
    const int lg = 8 + (n >= 12) + (n >= 16) + (n >= 23) + (n >= 32) + (n >= 46) + (n >= 64) + (n >= 91);
    return (rel > 0 ? 16 : 0) + (n < 8 ? n : lg);
}
DI u32x4 ldg16(const void* sbase, unsigned voff) { return *(const u32x4*)((const char*)sbase + voff); }
constexpr int NH = 2;
constexpr int KP = NH * 64 + 8, VP = 72;
template <bool NEAR>
DI void att_tile(LAS u16* Kb, LAS u16* Vb, LAS float* bl, unsigned bits, int kt, int rowl, int lq, int g4, const bf16x8 (&qf)[NH][2], f32x4 (&O)[NH][4], float (&m)[NH], float (&l)[NH]) {
    unsigned boff[4] = {0u, 0u, 0u, 0u};
    if (NEAR) {
#pragma unroll
        for (int nt = 0; nt < 4; ++nt)
#pragma unroll
            for (int i = 0; i < 4; ++i) boff[nt] |= (unsigned)t5_bucket(kt * 64 + nt * 16 + g4 * 4 + i - (rowl + lq)) << (8 * i);
    }
#pragma unroll
    for (int hl = 0; hl < NH; ++hl) {
        f32x4 s[4];
#pragma unroll
        for (int nt = 0; nt < 4; ++nt) { f32x4 acc = {0.f, 0.f, 0.f, 0.f};
#pragma unroll
            for (int ks = 0; ks < 2; ++ks) { const bf16x8 a = *(LAS bf16x8*)(Kb + (nt * 16 + lq) * KP + hl * 64 + ks * 32 + g4 * 8); acc = __builtin_amdgcn_mfma_f32_16x16x32_bf16(a, qf[hl][ks], acc, 0, 0, 0); }
            s[nt] = acc; }
        __builtin_amdgcn_sched_barrier(0);
        const float bfar = bl[15 * 4 + hl]; float mx = -INFINITY;
#pragma unroll
        for (int nt = 0; nt < 4; ++nt)
#pragma unroll
            for (int i = 0; i < 4; ++i) { const float bias = NEAR ? bl[((boff[nt] >> (8 * i)) & 255u) * 4 + hl] : bfar; const float x = ((bits >> (nt * 4 + i)) & 1u) ? s[nt][i] * (0.125f * LOG2E) + bias : -INFINITY; s[nt][i] = x; mx = fmaxf(mx, x); }
        mx = fmaxf(mx, __shfl_xor(mx, 16)); mx = fmaxf(mx, __shfl_xor(mx, 32));
        const float mnew = fmaxf(m[hl], mx), msafe = (mnew == -INFINITY) ? 0.f : mnew, alpha = __builtin_amdgcn_exp2f(m[hl] - msafe); m[hl] = mnew;
        float ls = 0.f;
#pragma unroll
        for (int nt = 0; nt < 4; ++nt)
#pragma unroll
            for (int i = 0; i < 4; ++i) { const float p = __builtin_amdgcn_exp2f(s[nt][i] - msafe); s[nt][i] = p; ls += p; }
        l[hl] = l[hl] * alpha + ls;
#pragma unroll
        for (int dt = 0; dt < 4; ++dt) O[hl][dt] = O[hl][dt] * alpha;
#pragma unroll
        for (int kk = 0; kk < 2; ++kk) { const u32x4 pw = pack8(s[2 * kk], s[2 * kk + 1]); const bf16x8 pb = __builtin_bit_cast(bf16x8, pw);
#pragma unroll
            for (int dt = 0; dt < 4; ++dt) { LAS u16* vp = Vb + (hl * 64 + dt * 16 + lq) * VP + kk * 32 + g4 * 4; const u32x2 v0 = *(LAS u32x2*)vp, v1 = *(LAS u32x2*)(vp + 16);
                u32x4 vw; vw.x = v0.x; vw.y = v0.y; vw.z = v1.x; vw.w = v1.y;
                O[hl][dt] = __builtin_amdgcn_mfma_f32_16x16x32_bf16(__builtin_bit_cast(bf16x8, vw), pb, O[hl][dt], 0, 0, 0); } }
        __builtin_amdgcn_sched_barrier(0);
    }
}
DI void att_phase(const Frame& F, LAS unsigned char* lds) {
    constexpr int KT = 64 * KP, VTS = NH * 64 * VP;
    LAS u16* Kbuf = (LAS u16*)lds;
    LAS u16* Vbuf = (LAS u16*)(lds + 2 * KT * 2);
    LAS float* bl = (LAS float*)(lds + 2 * KT * 2 + 2 * VTS * 2);
    const int tid = F.tid, lane = F.lane, wave = F.wave, lq = lane & 15, g4 = lane >> 4;
    constexpr int NQ = 8 / NH;
    for (int pp = blockIdx.x; pp < 128 * NQ; pp += gridDim.x) {
        const int x = pp & 7, y = pp >> 3, b = x >> 1, hq = (x & 1) * (NQ / 2) + (y % (NQ / 2)), ii = y / (NQ / 2);
        __syncthreads();
        if (tid < 128) bl[tid] = ((tid & 3) < NH) ? F.in[23][(tid >> 2) * 8 + hq * NH + (tid & 3)] * LOG2E : 0.f;
        __syncthreads();
        for (int which = 0; which < 2; ++which) {
            const int i = which ? 63 - ii : ii, ntile = 2 * i + 2, my_ntile = (wave < 4) ? 2 * i + 1 : 2 * i + 2, rowl = i * 128 + wave * 16;
            const size_t tq = (size_t)b * SEQ + rowl + lq;
            u16* qrow = F_Q(F) + tq * 512 + hq * (NH * 64) + g4 * 4;
            bf16x8 qf[NH][2];
#pragma unroll
            for (int hl = 0; hl < NH; ++hl)
#pragma unroll
                for (int ks = 0; ks < 2; ++ks) qf[hl][ks] = *(const bf16x8*)(qrow + g4 * 4 + hl * 64 + ks * 32);
            f32x4 O[NH][4]; float m[NH], l[NH];
#pragma unroll
            for (int hl = 0; hl < NH; ++hl) { m[hl] = -INFINITY; l[hl] = 0.f;
#pragma unroll
                for (int dt = 0; dt < 4; ++dt) O[hl][dt] = (f32x4){0.f, 0.f, 0.f, 0.f}; }
            const int c = 2 * i + (wave >> 2); const size_t mbase = (size_t)b * MASK_PER_B + (size_t)(c + 1) * (2 * c + (wave & 3));
            const u16* kg = F_K(F) + ((size_t)b * SEQ) * 512 + hq * (NH * 64); const u16* vg = F_VT(F) + ((size_t)(b * 512 + hq * (NH * 64))) * SEQ;
            constexpr int NE = NH / 2 * 2 / 2 * 2 > 0 ? NH : NH;
            u32x4 kr[NE], vr[NE];
            constexpr int KCH = NH * 8;
            const unsigned voffK = (unsigned)(((tid / KCH) * 512 + (tid % KCH) * 8) * 2), voffV = (unsigned)(((tid >> 3) * SEQ + (tid & 7) * 8) * 2);
            const int krow = tid / KCH, kck = tid % KCH, vrow = tid >> 3, vck = tid & 7;
#pragma unroll
            for (int e = 0; e < NE; ++e) { kr[e] = ldg16(kg + (size_t)e * (512 / KCH) * 512, voffK); vr[e] = ldg16(vg + (size_t)e * 64 * SEQ, voffV); }
#pragma unroll
            for (int e = 0; e < NE; ++e) { *(LAS u32x4*)(Kbuf + (krow + e * (512 / KCH)) * KP + kck * 8) = kr[e]; *(LAS u32x4*)(Vbuf + (vrow + e * 64) * VP + vck * 8) = vr[e]; }
            __syncthreads();
#pragma unroll 1
            for (int kt = 0; kt < ntile; ++kt) {
                const bool more = kt + 1 < ntile;
                if (kt < my_ntile) {
                    const unsigned bits = *(const u16*)((const char*)(F_MASK(F) + (mbase + kt) * 64) + (unsigned)(lane * 2));
                    LAS u16* Kb = Kbuf + (kt & 1) * KT; LAS u16* Vb = Vbuf + (kt & 1) * VTS;
                    if (kt * 64 + 63 - rowl <= -91) att_tile<false>(Kb, Vb, bl, bits, kt, rowl, lq, g4, qf, O, m, l);
                    else att_tile<true>(Kb, Vb, bl, bits, kt, rowl, lq, g4, qf, O, m, l);
                }
                if (more) { LAS u16* Kb = Kbuf + ((kt + 1) & 1) * KT; LAS u16* Vb = Vbuf + ((kt + 1) & 1) * VTS;
#pragma unroll
                    for (int e = 0; e < NE; ++e) { kr[e] = ldg16(kg + (size_t)((kt + 1) * 64 + e * (512 / KCH)) * 512, voffK); vr[e] = ldg16(vg + (size_t)e * 64 * SEQ + (kt + 1) * 64, voffV); }
#pragma unroll
                    for (int e = 0; e < NE; ++e) { *(LAS u32x4*)(Kb + (krow + e * (512 / KCH)) * KP + kck * 8) = kr[e]; *(LAS u32x4*)(Vb + (vrow + e * 64) * VP + vck * 8) = vr[e]; } }
                __syncthreads();
            }
#pragma unroll
            for (int hl = 0; hl < NH; ++hl) { float lt = l[hl]; lt += __shfl_xor(lt, 16); lt += __shfl_xor(lt, 32); const float inv = 1.0f / lt;
#pragma unroll
                for (int dt = 0; dt < 4; ++dt) { const f32x4 o = O[hl][dt] * inv; u32x2 w; w.x = cvt_pk_bf16(o[0], o[1]); w.y = cvt_pk_bf16(o[2], o[3]);
                    *(u32x2*)(qrow + hl * 64 + dt * 16) = w; } }
        }
    }
}

constexpr int NPH = 33;
#define PHON(k) ((PHM >> (k)) & 1)
template <int PHM>
__global__ void __launch_bounds__(NTHR, 2) mega(Args args) {
    extern __shared__ __attribute__((aligned(16))) unsigned char lds_raw[];
    LAS unsigned char* lds = (LAS unsigned char*)lds_raw;
    Frame F;
    F.in = args.in; F.out = args.out; F.ws = args.ws;
    cg::grid_group grid = cg::this_grid();
#pragma unroll 1
    for (int ph = args.lo; ph < args.hi; ++ph) {
        { int t = threadIdx.x; asm volatile("" : "+v"(t)); F.tid = t; F.lane = t & 63; F.wave = __builtin_amdgcn_readfirstlane(t >> 6);
          int z = 0; asm volatile("" : "+s"(z)); F.in = args.in + z;
          unsigned char* w = args.ws; asm volatile("" : "+s"(w)); F.ws = w; float* o = args.out; asm volatile("" : "+s"(o)); F.out = o; }
        unsigned char* ws = F.ws;
        if (ph == 0) { if (PHON(16)) p0_phase(F, lds); }
        else {
            const int l = (ph - 1) >> 4, sp = (ph - 1) & 15;
            unsigned char* wl = ws + WS_W + (size_t)l * SZ_LAYERW; const unsigned char* tab = ws + WS_TAB + (size_t)l * SZ_TABL;
            LAS unsigned char* wlds = lds + F.wave * 19456;
            switch (sp) {
            case 0: if (PHON(0)) { EpiUp E{F_H(F)}; run_gemm(lds, F_XB(F), (const u16*)(wl + OFF_UP1), NUP, D_, E); } break;
            case 1: if (PHON(1)) { EpiRes E{l == 0 ? F.in[0] : (const float*)F.out, F.out, 0.5f}; run_gemm(lds, F_H(F), (const u16*)(wl + OFF_DN1), D_, DFF, E); } break;
            case 2: if (PHON(2)) ln_phase(F, F.in[3] + l * D_, F.in[4] + l * D_); break;
            case 3: if (PHON(3)) { EpiIn E{ws}; run_gemm(lds, F_XB(F), (const u16*)(wl + OFF_WIN), NIN, D_, E); } break;
            case 4: if (PHON(4)) { for (int t = blockIdx.x * 8 + F.wave; t < 4096; t += gridDim.x * 8) vt_tile(F, wlds, t);
                      for (int it = blockIdx.x * 8 + F.wave; it < 16384; it += gridDim.x * 8) ssmA_item(F, tab, wlds, it); } break;
            case 5: if (PHON(5)) { for (int it = blockIdx.x * 8 + F.wave; it < 16384; it += gridDim.x * 8) ssmC_item(F, tab, F.in[13] + l * 512, wlds, it); } break;
            case 6: if (PHON(6)) { EpiMix<0> E{F_U(F), nullptr, F_YS(F), 512}; run_gemm(lds, F_U(F), (const u16*)(wl + OFF_GLU), 512, 512, E); } break;
            case 7: if (PHON(7)) { EpiMix<1> E{F_GS(F), nullptr, F_GS(F), 1024}; run_gemm(lds, F_YS(F), (const u16*)(wl + OFF_WB0), D_, 512, E); } break;
            case 8: if (PHON(8)) idx_phase(F, lds); break;
            case 9: if (PHON(9)) att_phase(F, lds); break;
            case 10: if (PHON(10)) { EpiMix<2> E{F_GA(F), F_GS(F), F_GA(F), 1024}; run_gemm(lds, F_Q(F), (const u16*)(wl + OFF_WB1), D_, 512, E); } break;
            case 11: if (PHON(11)) { EpiRes E{(const float*)F.out, F.out, 1.0f}; run_gemm(lds, F_GA(F), (const u16*)(wl + OFF_WOUT), D_, D_, E); } break;
            case 12: if (PHON(12)) ln_phase(F, F.in[17] + l * D_, F.in[18] + l * D_); break;
            case 13: if (PHON(13)) { EpiUp E{F_H(F)}; run_gemm(lds, F_XB(F), (const u16*)(wl + OFF_UP2), NUP, D_, E); } break;
            case 14: if (PHON(14)) { EpiRes E{(const float*)F.out, F.out, 0.5f}; run_gemm(lds, F_H(F), (const u16*)(wl + OFF_DN2), D_, DFF, E); } break;
            default: if (PHON(15)) ln_phase(F, F.in[21] + l * D_, F.in[22] + l * D_); break;
            }
        }
        if (ph + 1 < args.hi) grid.sync();
    }
}

typedef void (*kern_t)(Args);
static kern_t phase_kernel(int ph) {
    if (ph == 0) return mega<(1 << 16)>;
    switch ((ph - 1) & 15) {
    case 0: return mega<(1 << 0)>; case 1: return mega<(1 << 1)>; case 2: return mega<(1 << 2)>; case 3: return mega<(1 << 3)>;
    case 4: return mega<(1 << 4)>; case 5: return mega<(1 << 5)>; case 6: return mega<(1 << 6)>; case 7: return mega<(1 << 7)>;
    case 8: return mega<(1 << 8)>; case 9: return mega<(1 << 9)>; case 10: return mega<(1 << 10)>; case 11: return mega<(1 << 11)>;
    case 12: return mega<(1 << 12)>; case 13: return mega<(1 << 13)>; case 14: return mega<(1 << 14)>; default: return mega<(1 << 15)>;
    }
}
extern "C" void kernel_launch(void* const* d_in, const int* in_sizes, int n_in, void* d_out, int out_size, void* d_ws, size_t ws_size, hipStream_t stream) {
    static int grid = 0;
    if (grid == 0) {
        int dev = 0, cus = 0;
        if (n_in != 24 || out_size != T_ * D_ || ws_size < WS_END) { fprintf(stderr, "kernel_launch: unexpected problem (n_in %d out %d ws %zu need %zu)\n", n_in, out_size, ws_size, (size_t)WS_END); grid = -1; return; }
        (void)hipGetDevice(&dev); (void)hipDeviceGetAttribute(&cus, hipDeviceAttributeMultiprocessorCount, dev);
#if ONE_LAUNCH
        if (hipFuncSetAttribute((const void*)mega<0x1ffff>, hipFuncAttributeMaxDynamicSharedMemorySize, LDS_BYTES) != hipSuccess) fprintf(stderr, "kernel_launch: hipFuncSetAttribute failed\n");
#else
        for (int ph = 0; ph < 17; ++ph) if (hipFuncSetAttribute((const void*)phase_kernel(ph), hipFuncAttributeMaxDynamicSharedMemorySize, LDS_BYTES) != hipSuccess) fprintf(stderr, "kernel_launch: hipFuncSetAttribute failed\n");
#endif
        (void)hipGetLastError();
        grid = cus > 0 ? cus : 256;
    }
    if (grid < 0) return;
    Args a{};
    for (int i = 0; i < 24; ++i) a.in[i] = (const float*)d_in[i];
    a.out = (float*)d_out; a.ws = (unsigned char*)d_ws;
#if ONE_LAUNCH
    a.lo = 0; a.hi = NPH;
    void* kargs[] = {&a};
    hipError_t e = hipLaunchCooperativeKernel((const void*)mega<0x1ffff>, dim3(grid), dim3(NTHR), kargs, LDS_BYTES, stream);
    if (e != hipSuccess) fprintf(stderr, "cooperative launch failed: %s (grid %d)\n", hipGetErrorString(e), grid);
#else
    for (int ph = 0; ph < NPH; ++ph) { a.lo = ph; a.hi = ph + 1; hipLaunchKernelGGL(phase_kernel(ph), dim3(grid), dim3(NTHR), LDS_BYTES, stream, a); }
#endif
}
```

```cpp
#include <hip/hip_runtime.h>
#include <hip/hip_cooperative_groups.h>
#include <cstdio>
namespace cg = cooperative_groups;
#ifndef ONE_LAUNCH
#define ONE_LAUNCH 1
#endif
namespace pg8 {
#define PG8_LAS __attribute__((address_space(3)))
typedef unsigned short bf16_t;
typedef short bf16x8 __attribute__((ext_vector_type(8)));
typedef float f32x4 __attribute__((ext_vector_type(4)));
typedef unsigned u32x4 __attribute__((ext_vector_type(4)));
constexpr int BM = 256, BK = 64, HALF = 128, HTB = HALF * BK * 2  , STAGE_BYTES = 8 * HTB, NXCD = 8, WGM = 8;

__host__ __device__ __forceinline__ int lds_byte(int r, int c) { const int st = (r >> 4) * 2 + (c >> 5), rr = r & 15, cc = c & 31, ob = rr * 64 + cc * 2; return st * 1024 + (ob ^ (((ob >> 9) & 1) << 5)); }
__host__ __device__ __forceinline__ void stage_rc(int b, int& R, int& C) { const int st = b / 1024, sb = b % 1024, swz = sb ^ (((sb >> 9) & 1) << 5); R = (st >> 1) * 16 + swz / 64; C = (st & 1) * 32 + (swz % 64) / 2; }
__host__ __device__ __forceinline__ int perm32(int rho) { const int n = rho >> 4, i = rho & 15; return 8 * (i >> 2) + 4 * n + (i & 3); }

struct Unit { int pm, pn; };
struct Gemm { const bf16_t* A; const bf16_t* Bt; int M, N, K; };

struct StaticOrder {
    int nM, nN, nwg, G, c;
    __host__ __device__ void init(int M, int N, int G_, int c_) { nM = M / BM; nN = N / BM; nwg = nM * nN; G = G_; c = c_; }
    __host__ __device__ bool next(int i, Unit& u) const {
        const long L = (long)i * G + c; if (L >= nwg) return false;
        int wgid = (int)L; { const int q = nwg / NXCD, r = nwg % NXCD, xcd = wgid % NXCD, off = wgid / NXCD; wgid = (xcd < r ? xcd * (q + 1) : r * (q + 1) + (xcd - r) * q) + off; }
        const int nig = WGM * nN, gid = wgid / nig, fm = gid * WGM, gsz = (nM - fm) < WGM ? (nM - fm) : WGM;
        u.pm = fm + ((wgid % nig) % gsz); u.pn = (wgid % nig) / gsz; return true;
    }
    __device__ __forceinline__ void a_ready(const Unit&) const {}
    __device__ __forceinline__ void done(const Unit&) const {}
};
__device__ __forceinline__ unsigned cvt_pk_bf16(float lo, float hi) { unsigned r; asm volatile("v_cvt_pk_bf16_f32 %0, %1, %2" : "=v"(r) : "v"(lo), "v"(hi)); return r; }
template <class Epi, class Sched, bool STAMP = false>
__device__ __forceinline__ void gemm_phase(PG8_LAS unsigned char* lds, const Gemm g, const Sched& S, const Epi& E, unsigned long long* stamps) {
    const int tid = threadIdx.x, wid = __builtin_amdgcn_readfirstlane(tid >> 6), lane = tid & 63, wr = wid >> 2, wc = wid & 3, fr = lane & 15, fq = lane >> 4;
    const int K = g.K, nt = K / BK;
    int ts_lo = 0, ts_hi = 0, nts = 0; const unsigned long long rt_entry = STAMP ? (unsigned long long)wall_clock64() : 0ull;
#define PG8_STAMP() do { if (STAMP && wid == 0 && nts < 64) { const unsigned long long _c = (unsigned long long)clock64(); \
        ts_lo = (lane == nts) ? (int)(unsigned)_c : ts_lo; ts_hi = (lane == nts) ? (int)(unsigned)(_c >> 32) : ts_hi; ++nts; } } while (0)
    PG8_STAMP();
    unsigned voffA[2], voffB[2];
#pragma unroll
    for (int i = 0; i < 2; ++i) { int R, C; stage_rc(tid * 16 + i * 8192, R, C); const int Rb = Epi::PERM ? ((R & ~31) + perm32(R & 31)) : R;
        voffA[i] = (unsigned)(R * K + C) * 2u; voffB[i] = (unsigned)(Rb * K + C) * 2u; }
    const size_t kstep = (size_t)(BK * 2);
    const size_t hstep = (size_t)HALF * K * 2;
    const size_t tstep = 2 * hstep;
    const unsigned ldsw = (unsigned)wid * 1024u;
    const int aoff = lds_byte(wr * 64 + fr, fq * 8), boff = lds_byte(wc * 32 + fr, fq * 8);
#define PG8_SA(b, h) (((b) * 2 + (h)) * HTB)
#define PG8_SB(b, h) ((4 + (b) * 2 + (h)) * HTB)
#define PG8_STAGE(bufoff, gbase, voff) do { _Pragma("unroll") for (int _i = 0; _i < 2; ++_i) \
        __builtin_amdgcn_global_load_lds((const unsigned*)((const char*)(gbase) + (voff)[_i]), (PG8_LAS unsigned*)(lds + (bufoff) + ldsw + _i * 8192), 16, 0, 0); } while (0)
#define PG8_LDA(dst, b, h) do { _Pragma("unroll") for (int m = 0; m < 4; ++m) _Pragma("unroll") for (int k = 0; k < 2; ++k) dst[m][k] = *(const PG8_LAS bf16x8*)(lds + PG8_SA(b, h) + aoff + m * 2048 + k * 1024); } while (0)
#define PG8_LDB(dst, b, h) do { _Pragma("unroll") for (int n = 0; n < 2; ++n) _Pragma("unroll") for (int k = 0; k < 2; ++k) dst[n][k] = *(const PG8_LAS bf16x8*)(lds + PG8_SB(b, h) + boff + n * 2048 + k * 1024); } while (0)
#define PG8_MMA(ai, bj, At, Bt) do { __builtin_amdgcn_s_setprio(1); _Pragma("unroll") for (int m = 0; m < 4; ++m) _Pragma("unroll") for (int n = 0; n < 2; ++n) _Pragma("unroll") for (int k = 0; k < 2; ++k) \
        acc[ai][bj][m][n] = __builtin_amdgcn_mfma_f32_16x16x32_bf16(Bt[n][k], At[m][k], acc[ai][bj][m][n], 0, 0, 0); __builtin_amdgcn_s_setprio(0); } while (0)
#define PG8_WAIT_V(n) asm volatile("s_waitcnt vmcnt(" #n ")" ::: "memory")
#define PG8_WAIT_L(n) asm volatile("s_waitcnt lgkmcnt(" #n ")" ::: "memory")
#define PG8_BAR __builtin_amdgcn_s_barrier()
#define PG8_SCHED __builtin_amdgcn_sched_barrier(0)
    Unit cur, nxt; int ui = 0;
    if (!S.next(0, cur)) return;
    f32x4 acc[2][2][4][2];
#pragma unroll
    for (int a = 0; a < 2; ++a)
#pragma unroll
        for (int b = 0; b < 2; ++b)
#pragma unroll
            for (int m = 0; m < 4; ++m)
#pragma unroll
                for (int n = 0; n < 2; ++n) acc[a][b][m][n] = (f32x4){0.f, 0.f, 0.f, 0.f};
    bf16x8 At[4][2], B0[2][2], B1[2][2];
    const char* cA = (const char*)g.A + (size_t)cur.pm * tstep; const char* cB = (const char*)g.Bt + (size_t)cur.pn * tstep;
    S.a_ready(cur);
    PG8_STAGE(PG8_SB(0, 0), cB, voffB); PG8_STAGE(PG8_SA(0, 0), cA, voffA); PG8_STAGE(PG8_SB(0, 1), cB + hstep, voffB); PG8_STAGE(PG8_SA(0, 1), cA + hstep, voffA);
    if (wr == 1) PG8_BAR;
    PG8_WAIT_V(4); PG8_BAR;
    PG8_STAGE(PG8_SB(1, 0), cB + kstep, voffB); PG8_STAGE(PG8_SA(1, 0), cA + kstep, voffA); PG8_STAGE(PG8_SB(1, 1), cB + hstep + kstep, voffB);
    PG8_WAIT_V(6); PG8_BAR;
    PG8_STAMP();
    for (;;) {
        const bool has_next = S.next(ui + 1, nxt);
        const char* nA = has_next ? (const char*)g.A + (size_t)nxt.pm * tstep : cA; const char* nB = has_next ? (const char*)g.Bt + (size_t)nxt.pn * tstep : cB;
        for (int t = 0; t < nt; t += 2) {
            const bool last = (t == nt - 2);
            const char* a1 = cA + (size_t)(t + 1) * kstep;
            const char* a2 = last ? nA : cA + (size_t)(t + 2) * kstep; const char* b2 = last ? nB : cB + (size_t)(t + 2) * kstep;
            const char* a3 = a2 + kstep; const char* b3 = b2 + kstep;
            if (last && has_next) S.a_ready(nxt);
            PG8_LDB(B0, 0, 0); PG8_SCHED; PG8_LDA(At, 0, 0); PG8_STAGE(PG8_SA(1, 1), a1 + hstep, voffA);
            PG8_WAIT_L(8); PG8_BAR; PG8_WAIT_L(0); PG8_MMA(0, 0, At, B0); PG8_BAR; PG8_SCHED;
            PG8_LDB(B1, 0, 1); PG8_STAGE(PG8_SB(0, 0), b2, voffB);
            PG8_BAR; PG8_WAIT_L(0); PG8_MMA(0, 1, At, B1); PG8_BAR;
            PG8_LDA(At, 0, 1); PG8_STAGE(PG8_SA(0, 0), a2, voffA);
            PG8_BAR; PG8_WAIT_L(0); PG8_MMA(1, 0, At, B0); PG8_BAR; PG8_SCHED;
            PG8_STAGE(PG8_SB(0, 1), b2 + hstep, voffB);
            PG8_WAIT_V(6); PG8_BAR; PG8_MMA(1, 1, At, B1); PG8_BAR;
            PG8_LDB(B0, 1, 0); PG8_SCHED; PG8_LDA(At, 1, 0); PG8_STAGE(PG8_SA(0, 1), a2 + hstep, voffA);
            PG8_WAIT_L(8); PG8_BAR; PG8_WAIT_L(0); PG8_MMA(0, 0, At, B0); PG8_BAR; PG8_SCHED;
            PG8_LDB(B1, 1, 1); PG8_STAGE(PG8_SB(1, 0), b3, voffB);
            PG8_BAR; PG8_WAIT_L(0); PG8_MMA(0, 1, At, B1); PG8_BAR;
            PG8_LDA(At, 1, 1); PG8_STAGE(PG8_SA(1, 0), a3, voffA);
            PG8_BAR; PG8_WAIT_L(0); PG8_MMA(1, 0, At, B0); PG8_BAR; PG8_SCHED;
            PG8_STAGE(PG8_SB(1, 1), b3 + hstep, voffB);
            PG8_WAIT_V(6); PG8_BAR; PG8_MMA(1, 1, At, B1); PG8_BAR;
        }
        PG8_STAMP();
        if constexpr (!Epi::AFTER_DRAIN) { E(acc, cur, wr, wc, fr, fq); S.done(cur); }
        PG8_STAMP();
        if (!has_next) break;
#pragma unroll
        for (int a = 0; a < 2; ++a)
#pragma unroll
            for (int b = 0; b < 2; ++b)
#pragma unroll
                for (int m = 0; m < 4; ++m)
#pragma unroll
                    for (int n = 0; n < 2; ++n) acc[a][b][m][n] = (f32x4){0.f, 0.f, 0.f, 0.f};
        cur = nxt; cA = nA; cB = nB; ++ui;
    }
    PG8_WAIT_V(0);
    if (wr == 0) PG8_BAR;
    PG8_BAR;
    if constexpr (Epi::AFTER_DRAIN) { E.fused(acc, cur, wr, wc, fr, fq, lds, wid, lane); S.done(cur); }
    PG8_STAMP();
    if (STAMP && wid == 0) { stamps[lane] = lane < nts ? (((unsigned long long)(unsigned)ts_hi << 32) | (unsigned)ts_lo) : 0ull;
        if (lane == 62) stamps[62] = rt_entry; if (lane == 63) stamps[63] = (unsigned long long)wall_clock64(); }
#undef PG8_STAMP
#undef PG8_SA
#undef PG8_SB
#undef PG8_STAGE
#undef PG8_LDA
#undef PG8_LDB
#undef PG8_MMA
#undef PG8_WAIT_V
#undef PG8_WAIT_L
#undef PG8_BAR
#undef PG8_SCHED
}
}

using pg8::bf16x8; using pg8::f32x4; using pg8::u32x4;
typedef __bf16 bf16x2_t __attribute__((ext_vector_type(2)));
typedef float f32x2_t __attribute__((ext_vector_type(2)));
__device__ __forceinline__ unsigned cvt_pk_bf16(float lo, float hi) { f32x2_t f = {lo, hi}; bf16x2_t b = __builtin_convertvector(f, bf16x2_t); return __builtin_bit_cast(unsigned, b); }
typedef unsigned short u16;
typedef unsigned long long u64;
typedef unsigned u32x2 __attribute__((ext_vector_type(2)));
#define LAS __attribute__((address_space(3)))
#define DI __device__ __forceinline__

constexpr int T_ = 32768, D_ = 1024, DFF = 2816, NUP = 5632, NIN = 4608, SEQ = 8192;
constexpr float ALPHA = 1.41421356237309515f, LN_EPS = 1e-5f, LOG2E = 1.44269504088896f;
constexpr int NTHR = 512;
constexpr int LDS_MAIN = 155648, LDS_BYTES = LDS_MAIN + 16;

constexpr size_t SZ_WUP = (size_t)NUP * D_ * 2, SZ_WDN = (size_t)D_ * DFF * 2, SZ_WIN = (size_t)NIN * D_ * 2, SZ_WGLU = 512 * 512 * 2, SZ_WB = (size_t)1024 * 512 * 2, SZ_WOUT = (size_t)1024 * 1024 * 2;
constexpr size_t OFF_UP1 = 0, OFF_DN1 = OFF_UP1 + SZ_WUP, OFF_WIN = OFF_DN1 + SZ_WDN, OFF_GLU = OFF_WIN + SZ_WIN, OFF_WB0 = OFF_GLU + SZ_WGLU, OFF_WB1 = OFF_WB0 + SZ_WB,
                 OFF_WOUT = OFF_WB1 + SZ_WB, OFF_UP2 = OFF_WOUT + SZ_WOUT, OFF_DN2 = OFF_UP2 + SZ_WUP, SZ_LAYERW = OFF_DN2 + SZ_WDN;
constexpr size_t MiB = 1048576;
constexpr size_t SZ_TABL = 512 * 1024;
constexpr size_t TAB_A1 = 0, TAB_A64 = 16384, TAB_BB = 32768, TAB_CT = 32768 + 262144;
constexpr size_t WS_W = 0, WS_TAB = 2 * SZ_LAYERW, WS_XB = WS_TAB + 2 * SZ_TABL, WS_H = WS_XB + 64 * MiB, WS_GS = WS_H + 176 * MiB, WS_GA = WS_GS + 64 * MiB, WS_BAR = WS_GA + 64 * MiB, WS_STATS = WS_BAR + 65536, WS_END = WS_STATS + 262144;
constexpr size_t H_U = 0, H_Q = 32 * MiB, H_K = 64 * MiB, H_V = 96 * MiB, H_QI = 128 * MiB, H_KIB = 144 * MiB, H_WI = 146 * MiB, H_SLOC = 147 * MiB, H_MASK = 155 * MiB;
constexpr int MASK_PER_B = 33024;

struct Args { const float* in[24]; float* out; unsigned char* ws; int lo, hi; };

struct Frame {
    const float* const* in; float* out; unsigned char* ws;
    int tid, lane, wave;
};
#define FP(F, T, off) ((T*)((F).ws + (off)))
#define F_XB(F) FP(F, u16, WS_XB)
#define F_H(F) FP(F, u16, WS_H)
#define F_U(F) FP(F, u16, WS_H + H_U)
#define F_Q(F) FP(F, u16, WS_H + H_Q)
#define F_K(F) FP(F, u16, WS_H + H_K)
#define F_V(F) FP(F, u16, WS_H + H_V)
#define F_QI(F) FP(F, u16, WS_H + H_QI)
#define F_KIB(F) FP(F, u16, WS_H + H_KIB)
#define F_WI(F) FP(F, float, WS_H + H_WI)
#define F_SLOC(F) FP(F, float, WS_H + H_SLOC)
#define F_MASK(F) FP(F, u16, WS_H + H_MASK)
#define F_GS(F) FP(F, u16, WS_GS)
#define F_GA(F) FP(F, u16, WS_GA)
#define F_YS(F) FP(F, u16, WS_XB)
#define F_VT(F) FP(F, u16, WS_XB + 32 * MiB)

DI float bf_lo(unsigned u) { return __uint_as_float(u << 16); }
DI float bf_hi(unsigned u) { return __uint_as_float(u & 0xffff0000u); }
DI float fsigmoid(float x) { return __builtin_amdgcn_rcpf(1.0f + __expf(-x)); }
DI u32x4 pack8(const f32x4& a, const f32x4& b) { u32x4 w; w.x = cvt_pk_bf16(a[0], a[1]); w.y = cvt_pk_bf16(a[2], a[3]); w.z = cvt_pk_bf16(b[0], b[1]); w.w = cvt_pk_bf16(b[2], b[3]); return w; }
DI void unpack8(const u32x4& w, f32x4& a, f32x4& b) { a[0] = bf_lo(w.x); a[1] = bf_hi(w.x); a[2] = bf_lo(w.y); a[3] = bf_hi(w.y); b[0] = bf_lo(w.z); b[1] = bf_hi(w.z); b[2] = bf_lo(w.w); b[3] = bf_hi(w.w); }

struct EpiUp {
    static constexpr bool PERM = true, AFTER_DRAIN = false;
    u16* H;
    DI void operator()(const f32x4 (&acc)[2][2][4][2], const pg8::Unit& u, int wr, int wc, int fr, int fq) const {
        const int row0 = u.pm * 256 + wr * 64 + fr, col0 = u.pn * 128 + wc * 32 + 8 * fq;
#pragma unroll
        for (int ai = 0; ai < 2; ++ai)
#pragma unroll
            for (int m = 0; m < 4; ++m) {
                f32x4 o0, o1;
#pragma unroll
                for (int j = 0; j < 4; ++j) { const float g0 = acc[ai][0][m][0][j], g1 = acc[ai][0][m][1][j]; o0[j] = g0 * fsigmoid(g0) * acc[ai][1][m][0][j]; o1[j] = g1 * fsigmoid(g1) * acc[ai][1][m][1][j]; }
                *(u32x4*)(H + (size_t)(row0 + ai * 128 + m * 16) * DFF + col0) = pack8(o0, o1);
            }
    }
};
struct EpiRes {
    static constexpr bool PERM = false, AFTER_DRAIN = false;
    const float* R; float* Y; float sc; const f32x2_t* st; const float* g; const float* b;
    DI void operator()(const f32x4 (&acc)[2][2][4][2], const pg8::Unit& u, int wr, int wc, int fr, int fq) const {
        const int row0 = u.pm * 256 + wr * 64 + fr, col0 = u.pn * 256 + wc * 32 + 4 * fq;
#pragma unroll
        for (int ai = 0; ai < 2; ++ai)
#pragma unroll
            for (int m = 0; m < 4; ++m) { const int row = row0 + ai * 128 + m * 16; const size_t off = (size_t)row * D_ + col0;
                f32x2_t sr = {0.f, 1.f}; if (st) sr = st[row];
#pragma unroll
                for (int bj = 0; bj < 2; ++bj)
#pragma unroll
                    for (int n = 0; n < 2; ++n) { f32x4 r = *(const f32x4*)(R + off + bj * 128 + n * 16);
                        if (st) { const f32x4 gv = *(const f32x4*)(g + col0 + bj * 128 + n * 16), bv = *(const f32x4*)(b + col0 + bj * 128 + n * 16); r = (r - sr.x) * sr.y * gv + bv; }
                        *(f32x4*)(Y + off + bj * 128 + n * 16) = r * ALPHA + acc[ai][bj][m][n] * sc; }
                asm volatile("" ::: "memory"); }
    }
};
struct EpiIn {
    static constexpr bool PERM = true, AFTER_DRAIN = false;
    unsigned char* ws;
    DI void operator()(const f32x4 (&acc)[2][2][4][2], const pg8::Unit& u, int wr, int wc, int fr, int fq) const {
        const int row0 = u.pm * 256 + wr * 64 + fr, cl = wc * 32 + 8 * fq, pn = u.pn;
        size_t boff; int ld, c0;
        if (pn < 8) { boff = WS_H + (size_t)(pn >> 1) * (32 * MiB); ld = 512; c0 = (pn & 1) * 256; }
        else if (pn == 8) { boff = WS_H + H_QI; ld = 256; c0 = 0; }
        else if (pn == 9) { boff = WS_H + H_KIB; ld = 32; c0 = 0; }
        else { boff = WS_GS + (size_t)((pn - 10) >> 2) * (64 * MiB); ld = 1024; c0 = ((pn - 10) & 3) * 256; }
        u16* base = (u16*)(ws + boff); float* WI = (float*)(ws + WS_H + H_WI);
#pragma unroll
        for (int ai = 0; ai < 2; ++ai)
#pragma unroll
            for (int m = 0; m < 4; ++m) { const size_t row = (size_t)(row0 + ai * 128 + m * 16);
#pragma unroll
                for (int bj = 0; bj < 2; ++bj) { const int c = bj * 128 + cl; f32x4 v0 = acc[ai][bj][m][0], v1 = acc[ai][bj][m][1];
                    if (pn == 9) { if (c < 32) *(u32x4*)(base + row * 32 + c) = pack8(v0, v1); else if (c == 32) { *(f32x4*)(WI + row * 8) = v0; *(f32x4*)(WI + row * 8 + 4) = v1; } }
                    else { if (pn >= 10) {
#pragma unroll
                            for (int j = 0; j < 4; ++j) { v0[j] = fsigmoid(v0[j]); v1[j] = fsigmoid(v1[j]); } }
                        *(u32x4*)(base + row * ld + c0 + c) = pack8(v0, v1); } } }
    }
};
template <int MODE> struct EpiMix {
    static constexpr bool PERM = true, AFTER_DRAIN = false;
    const u16* A; const u16* Bsrc; u16* O; int ldc;
    DI void operator()(const f32x4 (&acc)[2][2][4][2], const pg8::Unit& u, int wr, int wc, int fr, int fq) const {
        const int row0 = u.pm * 256 + wr * 64 + fr, col0 = u.pn * 256 + wc * 32 + 8 * fq;
#pragma unroll
        for (int ai = 0; ai < 2; ++ai)
#pragma unroll
            for (int m = 0; m < 4; ++m) { const size_t off = (size_t)(row0 + ai * 128 + m * 16) * ldc + col0;
#pragma unroll
                for (int bj = 0; bj < 2; ++bj) { f32x4 v0 = acc[ai][bj][m][0], v1 = acc[ai][bj][m][1], a0, a1;
                    const u32x4 aw = *(const u32x4*)(A + off + bj * 128); unpack8(aw, a0, a1);
                    if (MODE == 0) {
#pragma unroll
                        for (int j = 0; j < 4; ++j) { v0[j] = a0[j] * fsigmoid(v0[j]); v1[j] = a1[j] * fsigmoid(v1[j]); } }
                    else if (MODE == 1) { v0 = a0 * v0; v1 = a1 * v1; }
                    else { f32x4 b0, b1; const u32x4 bw = *(const u32x4*)(Bsrc + off + bj * 128); unpack8(bw, b0, b1); v0 = b0 + a0 * v0; v1 = b1 + a1 * v1; }
                    *(u32x4*)(O + off + bj * 128) = pack8(v0, v1); } }
    }
};

template <class Epi> DI void run_gemm(LAS unsigned char* lds, const u16* A, const u16* Bt, int N, int K, const Epi& E) {
    pg8::Gemm g{A, Bt, T_, N, K}; pg8::StaticOrder S; S.init(T_, N, (int)gridDim.x, (int)blockIdx.x);
    pg8::gemm_phase<Epi, pg8::StaticOrder, false>(lds, g, S, E, nullptr);
    __syncthreads();
}

DI int srccol(int map, int n) {
    if (map == 0) return n;
    if (map == 1) { const int pn = n >> 8, r = n & 255; return r < 128 ? 128 * pn + r : DFF + 128 * pn + (r - 128); }
    return n < 2344 ? n : (n < 2560 ? -1 : n - 216);
}
DI void tconv(LAS float* tl  , const float* src, int Nsrc, int K, u16* dst, int Np, int map, int tid) {
    const int tilesN = Np >> 6, tilesK = K >> 6, ntile = tilesN * tilesK;
    for (int t0 = blockIdx.x * 2; t0 < ntile; t0 += gridDim.x * 2) {
        const bool hb = t0 + 1 < ntile; float va[8], vb[8];
        const int c = tid & 63, r0 = tid >> 6;
        { const int tn = t0 % tilesN, tk = t0 / tilesN; const int sc = srccol(map, tn * 64 + c);
#pragma unroll
          for (int rr = 0; rr < 8; ++rr) va[rr] = sc >= 0 ? src[(size_t)(tk * 64 + r0 + 8 * rr) * Nsrc + sc] : 0.f; }
        if (hb) { const int tn = (t0 + 1) % tilesN, tk = (t0 + 1) / tilesN; const int sc = srccol(map, tn * 64 + c);
#pragma unroll
          for (int rr = 0; rr < 8; ++rr) vb[rr] = sc >= 0 ? src[(size_t)(tk * 64 + r0 + 8 * rr) * Nsrc + sc] : 0.f; }
#pragma unroll
        for (int rr = 0; rr < 8; ++rr) { tl[(r0 + 8 * rr) * 65 + c] = va[rr]; if (hb) tl[64 * 65 + (r0 + 8 * rr) * 65 + c] = vb[rr]; }
        __syncthreads();
        { const int kk2 = (tid & 31) * 2, n0 = tid >> 5;
#pragma unroll
          for (int h = 0; h < 2; ++h) { if (h == 1 && !hb) break; const int t = t0 + h, tn = t % tilesN, tk = t / tilesN; LAS float* tt = tl + h * 64 * 65;
#pragma unroll
            for (int rr = 0; rr < 4; ++rr) { const int n = n0 + 16 * rr; *(unsigned*)(dst + (size_t)(tn * 64 + n) * K + tk * 64 + kk2) = cvt_pk_bf16(tt[kk2 * 65 + n], tt[(kk2 + 1) * 65 + n]); } } }
        __syncthreads();
    }
}
DI void ssm_tables(const Frame& F, int l, int g, int p) {
    unsigned char* tab = F.ws + WS_TAB + (size_t)l * SZ_TABL;
    const int lg = l * 32 + g;
    const double lr = fmin((double)F.in[6][lg * 64 + p], -1e-4), li = (double)F.in[7][lg * 64 + p], dt = exp((double)F.in[8][lg]);
    const double zr = lr * dt, zi = li * dt, ea = exp(zr);
    double ar = ea * cos(zi), ai = ea * sin(zi);
    const double nr = ar - 1.0, ni = ai, den = lr * lr + li * li, fr_ = (nr * lr + ni * li) / den, fi_ = (ni * lr - nr * li) / den;
    ((float*)(tab + TAB_A1))[(g * 64 + p) * 2] = (float)ar; ((float*)(tab + TAB_A1))[(g * 64 + p) * 2 + 1] = (float)ai;
    double pr = ar, pi = ai;
#pragma unroll 1
    for (int s = 0; s < 6; ++s) { const double t = pr * pr - pi * pi; pi = 2.0 * pr * pi; pr = t; }
    ((float*)(tab + TAB_A64))[(g * 64 + p) * 2] = (float)pr; ((float*)(tab + TAB_A64))[(g * 64 + p) * 2 + 1] = (float)pi;
    float* BB = (float*)(tab + TAB_BB) + (size_t)g * 32 * 64;
    const float* bre = F.in[9] + ((size_t)lg * 64 + p) * 16; const float* bim = F.in[10] + ((size_t)lg * 64 + p) * 16;
#pragma unroll 1
    for (int h = 0; h < 16; ++h) { const double br = bre[h], bi = bim[h]; BB[(2 * h) * 64 + p] = (float)(fr_ * br - fi_ * bi); BB[(2 * h + 1) * 64 + p] = (float)(fr_ * bi + fi_ * br); }
    u16* CT = (u16*)(tab + TAB_CT) + (size_t)g * 16 * 128;
    const float* cre = F.in[11] + (size_t)lg * 16 * 64; const float* cim = F.in[12] + (size_t)lg * 16 * 64;
#pragma unroll 1
    for (int h = 0; h < 16; ++h) { *(unsigned*)(CT + h * 128 + 2 * p) = cvt_pk_bf16(cre[h * 64 + p], -cim[h * 64 + p]); }
}
DI void p0_phase(const Frame& F, LAS unsigned char* lds) {
    LAS float* tl = (LAS float*)lds;
    for (int l = 0; l < 2; ++l) {
        unsigned char* wl = F.ws + WS_W + (size_t)l * SZ_LAYERW;
        tconv(tl, F.in[1] + (size_t)l * D_ * NUP, NUP, D_, (u16*)(wl + OFF_UP1), NUP, 1, F.tid);
        tconv(tl, F.in[2] + (size_t)l * DFF * D_, D_, DFF, (u16*)(wl + OFF_DN1), D_, 0, F.tid);
        tconv(tl, F.in[5] + (size_t)l * D_ * 4392, 4392, D_, (u16*)(wl + OFF_WIN), NIN, 2, F.tid);
        tconv(tl, F.in[14] + (size_t)l * 512 * 512, 512, 512, (u16*)(wl + OFF_GLU), 512, 0, F.tid);
        tconv(tl, F.in[15] + (size_t)(l * 2 + 0) * 512 * 1024, 1024, 512, (u16*)(wl + OFF_WB0), 1024, 0, F.tid);
        tconv(tl, F.in[15] + (size_t)(l * 2 + 1) * 512 * 1024, 1024, 512, (u16*)(wl + OFF_WB1), 1024, 0, F.tid);
        tconv(tl, F.in[16] + (size_t)l * 1024 * 1024, 1024, 1024, (u16*)(wl + OFF_WOUT), 1024, 0, F.tid);
        tconv(tl, F.in[19] + (size_t)l * D_ * NUP, NUP, D_, (u16*)(wl + OFF_UP2), NUP, 1, F.tid);
        tconv(tl, F.in[20] + (size_t)l * DFF * D_, D_, DFF, (u16*)(wl + OFF_DN2), D_, 0, F.tid);
    }
    { const size_t n4 = (size_t)T_ * D_ / 4, step = (size_t)gridDim.x * NTHR; const f32x4* x4 = (const f32x4*)F.in[0]; u32x2* o = (u32x2*)F_XB(F);
      for (size_t i = (size_t)blockIdx.x * NTHR + F.tid; i < n4; i += 4 * step) { f32x4 v[4];
#pragma unroll
          for (int j = 0; j < 4; ++j) if (i + j * step < n4) v[j] = x4[i + j * step];
#pragma unroll
          for (int j = 0; j < 4; ++j) if (i + j * step < n4) { u32x2 w; w.x = cvt_pk_bf16(v[j][0], v[j][1]); w.y = cvt_pk_bf16(v[j][2], v[j][3]); o[i + j * step] = w; } } }
    { const int gw = blockIdx.x * 8 + F.wave; if (gw < 64) ssm_tables(F, gw >> 5, gw & 31, F.lane); }
}

DI float wave_sum(float v) {
#pragma unroll
    for (int o = 32; o >= 1; o >>= 1) v += __shfl_xor(v, o);
    return v;
}
DI void ln_phase(const Frame& F, const float* g, const float* b, bool final) {
    const int lane = F.lane; f32x4 gv[4], bv[4];
#pragma unroll
    for (int i = 0; i < 4; ++i) { gv[i] = *(const f32x4*)(g + i * 256 + lane * 4); bv[i] = *(const f32x4*)(b + i * 256 + lane * 4); }
    const int stride = gridDim.x * 8; f32x2_t* stats = (f32x2_t*)(F.ws + WS_STATS);
    for (int row0 = blockIdx.x * 8 + F.wave; row0 < T_; row0 += 2 * stride) {
        const int row1 = row0 + stride < T_ ? row0 + stride : row0;
        float* p0 = F.out + (size_t)row0 * D_; float* p1 = F.out + (size_t)row1 * D_; f32x4 v[4], u[4]; float s0 = 0.f, s1 = 0.f;
#pragma unroll
        for (int i = 0; i < 4; ++i) { v[i] = *(const f32x4*)(p0 + i * 256 + lane * 4); u[i] = *(const f32x4*)(p1 + i * 256 + lane * 4); }
#pragma unroll
        for (int i = 0; i < 4; ++i) { s0 += (v[i][0] + v[i][1]) + (v[i][2] + v[i][3]); s1 += (u[i][0] + u[i][1]) + (u[i][2] + u[i][3]); }
        const float mean0 = wave_sum(s0) * (1.0f / 1024.0f), mean1 = wave_sum(s1) * (1.0f / 1024.0f); float q0 = 0.f, q1 = 0.f;
#pragma unroll
        for (int i = 0; i < 4; ++i) { v[i] = v[i] - mean0; u[i] = u[i] - mean1; q0 += (v[i][0] * v[i][0] + v[i][1] * v[i][1]) + (v[i][2] * v[i][2] + v[i][3] * v[i][3]); q1 += (u[i][0] * u[i][0] + u[i][1] * u[i][1]) + (u[i][2] * u[i][2] + u[i][3] * u[i][3]); }
        const float rstd0 = rsqrtf(wave_sum(q0) * (1.0f / 1024.0f) + LN_EPS), rstd1 = rsqrtf(wave_sum(q1) * (1.0f / 1024.0f) + LN_EPS);
        if (!final && lane == 0) { stats[row0] = (f32x2_t){mean0, rstd0}; if (row1 != row0) stats[row1] = (f32x2_t){mean1, rstd1}; }
#pragma unroll
        for (int i = 0; i < 4; ++i) { const f32x4 y = v[i] * rstd0 * gv[i] + bv[i]; if (final) *(f32x4*)(p0 + i * 256 + lane * 4) = y;
            else { u32x2 w; w.x = cvt_pk_bf16(y[0], y[1]); w.y = cvt_pk_bf16(y[2], y[3]); *(u32x2*)(F_XB(F) + (size_t)row0 * D_ + i * 256 + lane * 4) = w; } }
        if (row1 != row0) {
#pragma unroll
            for (int i = 0; i < 4; ++i) { const f32x4 y = u[i] * rstd1 * gv[i] + bv[i]; if (final) *(f32x4*)(p1 + i * 256 + lane * 4) = y;
                else { u32x2 w; w.x = cvt_pk_bf16(y[0], y[1]); w.y = cvt_pk_bf16(y[2], y[3]); *(u32x2*)(F_XB(F) + (size_t)row1 * D_ + i * 256 + lane * 4) = w; } } }
    }
}

DI void wave_lds_fence() { asm volatile("s_waitcnt lgkmcnt(0)" ::: "memory"); __builtin_amdgcn_wave_barrier(); }
DI float gelu_tanh(float x) { const float z = 0.7978845608028654f * (x + 0.044715f * x * x * x); return x * __builtin_amdgcn_rcpf(1.0f + __expf(-2.0f * z)); }

DI void vt_tile(const Frame& F, LAS unsigned char* wl, int tile) {
    LAS u16* tb = (LAS u16*)wl;
    const int tt = tile >> 3, hb = tile & 7, lane = F.lane; const int t0 = tt * 64;
    const u16* src = F_V(F) + (size_t)(t0 + lane) * 512 + hb * 64;
#pragma unroll
    for (int c = 0; c < 8; ++c) *(LAS u32x4*)(tb + lane * 72 + c * 8) = *(const u32x4*)(src + c * 8);
    wave_lds_fence();
    const int b = t0 >> 13, tl = t0 & 8191;
    u16* dst = F_VT(F) + ((size_t)(b * 512 + hb * 64 + lane)) * SEQ + tl;
#pragma unroll
    for (int c = 0; c < 8; ++c) { u32x4 w; unsigned e[8];
#pragma unroll
        for (int j = 0; j < 8; ++j) e[j] = tb[(c * 8 + j) * 72 + lane];
        w.x = e[0] | (e[1] << 16); w.y = e[2] | (e[3] << 16); w.z = e[4] | (e[5] << 16); w.w = e[6] | (e[7] << 16);
        *(u32x4*)(dst + c * 8) = w; }
    wave_lds_fence();
}
struct SsmP { float ar, ai, cr, ci; };
DI void ssm_load_g(const unsigned char* tab, const float* dskip, int g, int lane, float& ar, float& ai, float& cr, float& ci, float (&bb)[32], bf16x8 (&cf)[4], f32x4& dv) {
    ar = ((const float*)(tab + TAB_A1))[(g * 64 + lane) * 2]; ai = ((const float*)(tab + TAB_A1))[(g * 64 + lane) * 2 + 1];
    cr = ((const float*)(tab + TAB_A64))[(g * 64 + lane) * 2]; ci = ((const float*)(tab + TAB_A64))[(g * 64 + lane) * 2 + 1];
    const float* BB = (const float*)(tab + TAB_BB) + (size_t)g * 32 * 64 + lane;
#pragma unroll
    for (int k = 0; k < 32; ++k) bb[k] = BB[k * 64];
    const u16* CT = (const u16*)(tab + TAB_CT) + (size_t)g * 16 * 128; const int lq = lane & 15, g4 = lane >> 4;
#pragma unroll
    for (int ks = 0; ks < 4; ++ks) cf[ks] = *(const bf16x8*)(CT + lq * 128 + ks * 32 + g4 * 8);
    dv = *(const f32x4*)(dskip + g * 16 + g4 * 4);
}
DI void ssmA_item(const Frame& F, LAS unsigned char* wl, int item, const float ar, const float ai, const float (&bb)[32]) {
    LAS float* uf = (LAS float*)wl;
    const int chunk = item >> 5, g = item & 31, lane = F.lane; const int t0 = chunk * 64;
    { const u16* up = F_U(F) + (size_t)(t0 + lane) * 512 + g * 16; const u32x4 a = *(const u32x4*)up, b = *(const u32x4*)(up + 8);
      const unsigned xs[8] = {a.x, a.y, a.z, a.w, b.x, b.y, b.z, b.w};
#pragma unroll
      for (int k = 0; k < 4; ++k) { f32x4 v; v[0] = bf_lo(xs[2 * k]); v[1] = bf_hi(xs[2 * k]); v[2] = bf_lo(xs[2 * k + 1]); v[3] = bf_hi(xs[2 * k + 1]); *(LAS f32x4*)(uf + lane * 16 + k * 4) = v; } }
    wave_lds_fence();
    float sr = 0.f, si = 0.f;
#pragma unroll 4
    for (int j = 0; j < 64; ++j) {
        f32x4 uv[4];
#pragma unroll
        for (int k = 0; k < 4; ++k) uv[k] = *(LAS f32x4*)(uf + j * 16 + k * 4);
        f32x2_t bacc = {0.f, 0.f}, bacc2 = {0.f, 0.f};
#pragma unroll
        for (int k = 0; k < 8; ++k) { const float u0 = uv[k >> 1][(k & 1) * 2], u1 = uv[k >> 1][(k & 1) * 2 + 1];
            bacc = __builtin_elementwise_fma((f32x2_t){bb[4 * k], bb[4 * k + 1]}, (f32x2_t){u0, u0}, bacc); bacc2 = __builtin_elementwise_fma((f32x2_t){bb[4 * k + 2], bb[4 * k + 3]}, (f32x2_t){u1, u1}, bacc2); }
        const float br = bacc[0] + bacc2[0], bi = bacc[1] + bacc2[1];
        const float nr = ar * sr - ai * si + br, ni = ar * si + ai * sr + bi; sr = nr; si = ni;
    }
    *(float2*)(F_SLOC(F) + ((size_t)item * 64 + lane) * 2) = make_float2(sr, si);
    wave_lds_fence();
}
DI void ssmC_item(const Frame& F, LAS unsigned char* wl, int item, const float ar, const float ai, const float cr, const float ci, const float (&bb)[32], const bf16x8 (&cf)[4], const f32x4 dv) {
    LAS u16* ut = (LAS u16*)wl;
    LAS unsigned* st = (LAS unsigned*)(wl + 2048);
    const int chunk = item >> 5, g = item & 31, lane = F.lane, lq = lane & 15, g4 = lane >> 4; const int t0 = chunk * 64;
    { const u16* up = F_U(F) + (size_t)(t0 + lane) * 512 + g * 16; const u32x4 a = *(const u32x4*)up, b = *(const u32x4*)(up + 8);
      *(LAS u32x4*)(ut + lane * 16) = a; *(LAS u32x4*)(ut + lane * 16 + 8) = b; }
    float sr = 0.f, si = 0.f;
    { const int cin = chunk & 127, c0 = chunk - cin; const float2* sl = (const float2*)F_SLOC(F) + ((size_t)c0 * 32 + g) * 64 + lane;
#pragma unroll 8
      for (int c = 0; c < cin; ++c) { const float2 v = sl[(size_t)c * 32 * 64]; const float nr = cr * sr - ci * si + v.x, ni = cr * si + ci * sr + v.y; sr = nr; si = ni; } }
    wave_lds_fence();
#pragma unroll 4
    for (int j = 0; j < 64; ++j) {
        const u32x4 x0 = *(LAS u32x4*)(ut + j * 16), x1 = *(LAS u32x4*)(ut + j * 16 + 8);
        const unsigned xs[8] = {x0.x, x0.y, x0.z, x0.w, x1.x, x1.y, x1.z, x1.w};
        f32x2_t bacc = {0.f, 0.f}, bacc2 = {0.f, 0.f};
#pragma unroll
        for (int k = 0; k < 8; ++k) { const float u0 = bf_lo(xs[k]), u1 = bf_hi(xs[k]);
            bacc = __builtin_elementwise_fma((f32x2_t){bb[4 * k], bb[4 * k + 1]}, (f32x2_t){u0, u0}, bacc); bacc2 = __builtin_elementwise_fma((f32x2_t){bb[4 * k + 2], bb[4 * k + 3]}, (f32x2_t){u1, u1}, bacc2); }
        const float br = bacc[0] + bacc2[0], bi = bacc[1] + bacc2[1];
        const float nr = ar * sr - ai * si + br, ni = ar * si + ai * sr + bi; sr = nr; si = ni;
        st[j * 68 + lane] = cvt_pk_bf16(sr, si);
    }
    wave_lds_fence();
#pragma unroll
    for (int mt = 0; mt < 4; ++mt) {
        f32x4 acc = {0.f, 0.f, 0.f, 0.f};
#pragma unroll
        for (int ks = 0; ks < 4; ++ks) { const bf16x8 sf = *(LAS bf16x8*)(st + (mt * 16 + lq) * 68 + ks * 16 + g4 * 4); acc = __builtin_amdgcn_mfma_f32_16x16x32_bf16(cf[ks], sf, acc, 0, 0, 0); }
        const int l = mt * 16 + lq; const u32x2 uw = *(LAS u32x2*)(ut + l * 16 + g4 * 4);
        const float u0 = bf_lo(uw.x), u1 = bf_hi(uw.x), u2 = bf_lo(uw.y), u3 = bf_hi(uw.y);
        u32x2 o; o.x = cvt_pk_bf16(gelu_tanh(acc[0] + dv[0] * u0), gelu_tanh(acc[1] + dv[1] * u1)); o.y = cvt_pk_bf16(gelu_tanh(acc[2] + dv[2] * u2), gelu_tanh(acc[3] + dv[3] * u3));
        *(u32x2*)(F_U(F) + (size_t)(t0 + l) * 512 + g * 16 + g4 * 4) = o;
    }
    wave_lds_fence();
}

DI unsigned fkey(float x) { const int u = __float_as_int(x + 0.0f); return (unsigned)u ^ ((unsigned)(u >> 31) | 0x80000000u); }
DI f32x4 idx_scores(const bf16x8 af, const bf16x8 (&qf)[8], const float (&w)[8]) {
    f32x4 a[8];
#pragma unroll
    for (int h = 0; h < 8; ++h) { const f32x4 z = {0.f, 0.f, 0.f, 0.f}; a[h] = __builtin_amdgcn_mfma_f32_16x16x32_bf16(af, qf[h], z, 0, 0, 0); }
    f32x2_t s01 = {0.f, 0.f}, s23 = {0.f, 0.f};
#pragma unroll
    for (int h = 0; h < 8; ++h) {
        const float r0 = __int_as_float(max(__float_as_int(a[h][0]), 0)), r1 = __int_as_float(max(__float_as_int(a[h][1]), 0));
        const float r2 = __int_as_float(max(__float_as_int(a[h][2]), 0)), r3 = __int_as_float(max(__float_as_int(a[h][3]), 0));
        const f32x2_t ww = {w[h], w[h]}; s01 = __builtin_elementwise_fma(ww, (f32x2_t){r0, r1}, s01); s23 = __builtin_elementwise_fma(ww, (f32x2_t){r2, r3}, s23);
    }
    return (f32x4){s01[0], s01[1], s23[0], s23[1]};
}
DI void idx_load4(bf16x8 (&af)[4], const u16* kib, int kb, unsigned voff) {
    const char* p = (const char*)(kib + (size_t)kb * 64 * 32);
#pragma unroll
    for (int st = 0; st < 4; ++st) af[st] = __builtin_bit_cast(bf16x8, *(const u32x4*)(p + st * 1024 + voff));
}
DI unsigned wave_usum(unsigned v) {
#pragma unroll
    for (int o = 32; o >= 1; o >>= 1) v += (unsigned)__shfl_xor((int)v, o);
    return v;
}
DI unsigned wave_suffix(unsigned c, int lane) {
    unsigned s = c;
#pragma unroll
    for (int off = 1; off < 64; off <<= 1) { const unsigned t = __shfl_down(s, off); if (lane + off < 64) s += t; }
    return s;
}
constexpr int HS = 2052;
DI bool idx_select(LAS unsigned* hist, LAS unsigned* rpre, LAS unsigned* rneed, int row, int lane, int dbits, unsigned& ne_out) {
    LAS unsigned* h = hist + row * HS; unsigned c = 0;
#pragma unroll
    for (int j = 0; j < 8; ++j) { const u32x4 v = *(LAS u32x4*)(h + lane * 32 + j * 4); c += (v.x & 0xffffu) + (v.x >> 16) + (v.y & 0xffffu) + (v.y >> 16) + (v.z & 0xffffu) + (v.z >> 16) + (v.w & 0xffffu) + (v.w >> 16); }
    const unsigned s = wave_suffix(c, lane), need = rneed[row];
    const u64 bal = __ballot(s >= need); const int L = 63 - __clzll(bal);
    const unsigned cum_hi = __shfl(s - c, L);
    const unsigned v = ((LAS u16*)h)[L * 64 + lane];
    const unsigned s2 = wave_suffix(v, lane);
    const u64 bal2 = __ballot(cum_hi + s2 >= need); const int l2 = 63 - __clzll(bal2);
    const unsigned cum = __shfl(cum_hi + s2 - v, l2), ne = __shfl(v, l2), nn = need - cum;
    if (lane == 0) { rpre[row] = (rpre[row] << dbits) | (unsigned)(L * 64 + l2); rneed[row] = nn; }
    ne_out = ne;
    return nn < ne;
}
#ifndef REPM
#define REPM 0
#endif
DI void idx_phase(const Frame& F, LAS unsigned char* lds) {
    LAS unsigned* hist = (LAS unsigned*)lds;
    LAS unsigned* rpre = (LAS unsigned*)(lds + 16 * HS * 4);
    LAS unsigned* rneed = rpre + 16; LAS unsigned* rcut = rpre + 32; LAS unsigned* rp3 = rpre + 48; LAS unsigned* flags = rpre + 64;
    LAS unsigned* lcnt = rpre + 80; LAS unsigned* lkey = hist; LAS unsigned* lidx = hist + 4096;
    constexpr unsigned CAP6 = 512u; LAS unsigned* lkey6 = hist; LAS unsigned* lidx6 = hist + 8192; LAS u16* lmask = (LAS u16*)(hist + 16384);
    const int tid = F.tid, lane = F.lane, wave = F.wave, lq = lane & 15, g4 = lane >> 4;
    const unsigned voff = (unsigned)(lq * 64 + g4 * 16);
    for (int pair = blockIdx.x; pair < 256; pair += gridDim.x) {
        const int b = pair >> 6, jj = pair & 63;
        const u16* kib = F_KIB(F) + (size_t)b * SEQ * 32;
#pragma unroll 1
        for (int it = 0; it < 8; ++it) {
            const int which = it >> 2, sub = it & 3, tile = which ? 127 - jj : jj, nkb = tile + 1;
            const size_t tq = (size_t)b * SEQ + tile * 64 + sub * 16 + lq;
            bf16x8 qf[8]; float w[8];
#pragma unroll
            for (int h = 0; h < 8; ++h) qf[h] = *(const bf16x8*)(F_QI(F) + tq * 256 + h * 32 + g4 * 8);
            { const f32x4 w0 = *(const f32x4*)(F_WI(F) + tq * 8), w1 = *(const f32x4*)(F_WI(F) + tq * 8 + 4);
#pragma unroll
              for (int i = 0; i < 4; ++i) { w[i] = w0[i]; w[4 + i] = w1[i]; } }
            const size_t mbase = (size_t)b * MASK_PER_B + (size_t)(tile + 1) * (2 * tile + sub);
            if (tid < 16) { rpre[tid] = 0u; rneed[tid] = 256u; rcut[tid] = 0x7fffffffu; rp3[tid] = 0u; }
            if (tid == 0) { flags[0] = 0u; flags[1] = 0u; flags[2] = 0u; }
            int mode = nkb > 4 ? 1 : 4; bool rep_done = false; (void)rep_done;
#pragma unroll 1
            while (true) {
                if (mode < 3) { for (int i = tid; i < 4 * HS; i += NTHR) ((LAS u32x4*)hist)[i] = (u32x4){0u, 0u, 0u, 0u}; }
                if ((mode == 3 || mode == 6) && tid < 16) lcnt[tid] = 0u;
                __syncthreads();
                unsigned thr = 0u, cut = 0x7fffffffu, pre = rpre[lq], rem = rneed[lq], mycut = 0x7fffffffu; const bool p3 = rp3[lq] != 0u, need_res = rcut[lq] == 0xffffffffu;
                const unsigned st3 = rp3[lq]; unsigned tsh = 8u;
                if (mode == 4 && nkb > 4) { thr = pre; if (st3 != 0u) cut = rcut[lq]; if (st3 == 1u) tsh = 0u; }
                const u64 tcomp = ((u64)thr << 32) | (u64)(~cut);
                const int kb0 = mode == 5 ? 0 : wave, kstep = mode == 5 ? 1 : 8;
                const unsigned dsh = mode == 1 ? 20u : 8u, psh = mode == 1 ? 32u : 20u;
                if (kb0 < nkb && (mode != 5 || wave == 0)) {
                    bf16x8 af[4], nf[4];
                    idx_load4(af, kib, kb0, voff);
                    __builtin_amdgcn_s_waitcnt(0x0F70);
#pragma unroll 1
                    for (int kb = kb0; kb < nkb; kb += kstep) {
                        if (kb + kstep < nkb) idx_load4(nf, kib, kb + kstep, voff);
                        unsigned bits = 0u;
#pragma unroll
                        for (int st = 0; st < 4; ++st) {
                            const f32x4 sc = idx_scores(af[st], qf, w);
                            unsigned key[4];
#pragma unroll
                            for (int i = 0; i < 4; ++i) key[i] = fkey(sc[i]);
                            if (mode == 4) {
#pragma unroll
                                for (int i = 0; i < 4; ++i) { const unsigned idx = (unsigned)(kb * 64 + st * 16 + g4 * 4 + i); const u64 comp = ((u64)(key[i] >> tsh) << 32) | (u64)(~idx); bits |= (comp >= tcomp ? 1u : 0u) << (st * 4 + i); }
                            } else if (mode == 5) {
                                int tie[4]; int any = 0;
#pragma unroll
                                for (int i = 0; i < 4; ++i) { tie[i] = (need_res && (key[i] >> 8) == pre) ? 1 : 0; any |= tie[i]; }
                                if (__any(any)) {
#pragma unroll
                                    for (int gg = 0; gg < 4; ++gg)
#pragma unroll
                                        for (int i = 0; i < 4; ++i) { const int f = (g4 == gg) ? tie[i] : 0; const int c = __shfl(f, gg * 16 + lq);
                                            if (c && rem > 0u) { --rem; if (rem == 0u) mycut = (unsigned)(kb * 64 + st * 16 + gg * 4 + i); } }
                                }
                            } else if (mode == 6) {
                                int m4 = 0;
#pragma unroll
                                for (int i = 0; i < 4; ++i) { const unsigned k12 = key[i] >> 20; bits |= (k12 > pre ? 1u : 0u) << (st * 4 + i); m4 |= (k12 == pre) ? (1 << i) : 0; }
                                if (__any(m4)) {
#pragma unroll
                                    for (int i = 0; i < 4; ++i) if ((m4 >> i) & 1) { const unsigned slot = __hip_atomic_fetch_add(lcnt + lq, 1u, __ATOMIC_RELAXED, __HIP_MEMORY_SCOPE_WORKGROUP);
                                        if (slot < CAP6) { lkey6[lq * CAP6 + slot] = key[i]; lidx6[lq * CAP6 + slot] = (unsigned)(kb * 64 + st * 16 + g4 * 4 + i); } }
                                }
                            } else if (mode == 3) {
                                int m4 = 0;
#pragma unroll
                                for (int i = 0; i < 4; ++i) m4 |= (p3 && (key[i] >> 8) == pre) ? (1 << i) : 0;
                                if (__any(m4)) {
#pragma unroll
                                    for (int i = 0; i < 4; ++i) if ((m4 >> i) & 1) { const unsigned slot = __hip_atomic_fetch_add(lcnt + lq, 1u, __ATOMIC_RELAXED, __HIP_MEMORY_SCOPE_WORKGROUP);
                                        if (slot < 256u) { lkey[lq * 256 + slot] = key[i]; lidx[lq * 256 + slot] = (unsigned)(kb * 64 + st * 16 + g4 * 4 + i); } }
                                }
                            } else if (mode == 1) {
#pragma unroll
                                for (int i = 0; i < 4; ++i) { const unsigned digit = key[i] >> 20;
                                    __hip_atomic_fetch_add(hist + lq * HS + (digit >> 1), 1u << ((digit & 1u) * 16), __ATOMIC_RELAXED, __HIP_MEMORY_SCOPE_WORKGROUP); }
                            } else {
#pragma unroll
                                for (int i = 0; i < 4; ++i) { const unsigned digit = (key[i] >> dsh) & 4095u; const bool ok = (unsigned)((u64)key[i] >> psh) == pre;
                                    __hip_atomic_fetch_add(hist + lq * HS + (digit >> 1), ok ? (1u << ((digit & 1u) * 16)) : 0u, __ATOMIC_RELAXED, __HIP_MEMORY_SCOPE_WORKGROUP); }
                            }
                            __builtin_amdgcn_sched_barrier(0);
                        }
                        if (mode == 4) F_MASK(F)[(mbase + kb) * 64 + lane] = (u16)(nkb > 4 ? bits : 0xffffu);
                        if (mode == 6) lmask[kb * 64 + lane] = (u16)bits;
#pragma unroll
                        for (int st = 0; st < 4; ++st) af[st] = nf[st];
                    }
                    if (mode == 5 && need_res && g4 == 0) rcut[lq] = mycut;
                }
                __syncthreads();
#if REPM
                if (mode == REPM && !rep_done) { rep_done = true; continue; }
#endif
                if (mode == 6) {
#pragma unroll 1
                    for (int r = 0; r < 2; ++r) { const int row = wave * 2 + r; const unsigned n = lcnt[row], need = rneed[row];
                        unsigned low[8], xi[8];
#pragma unroll
                        for (int c = 0; c < 8; ++c) { const unsigned e = (unsigned)(c * 64 + lane); const bool valid = e < n; low[c] = valid ? (lkey6[row * CAP6 + e] & 0xfffffu) + 1u : 0u; xi[c] = valid ? lidx6[row * CAP6 + e] : 0xffffffffu; }
                        unsigned t20 = 0u;
#pragma unroll 1
                        for (int bb = 20; bb >= 0; --bb) { const unsigned t = t20 | (1u << bb); unsigned cnt = 0u;
#pragma unroll
                            for (int c = 0; c < 8; ++c) cnt += (unsigned)__popcll(__ballot(low[c] >= t));
                            if (cnt >= need) t20 = t; }
                        unsigned cgt = 0u, ceq = 0u;
#pragma unroll
                        for (int c = 0; c < 8; ++c) { cgt += (unsigned)__popcll(__ballot(low[c] > t20)); ceq += (unsigned)__popcll(__ballot(low[c] == t20)); }
                        const unsigned need_eq = need - cgt; unsigned cut6 = 0x7fffffffu;
                        if (ceq > need_eq) {
                            unsigned cc = 0u;
#pragma unroll 1
                            for (int bb = 12; bb >= 0; --bb) { const unsigned t = cc | (1u << bb); unsigned cnt = 0u;
#pragma unroll
                                for (int c = 0; c < 8; ++c) cnt += (unsigned)__popcll(__ballot(low[c] == t20 && xi[c] < t));
                                if (cnt < need_eq) cc = t; }
                            cut6 = cc; }
#pragma unroll
                        for (int c = 0; c < 8; ++c) { if (low[c] != 0u && (low[c] > t20 || (low[c] == t20 && xi[c] <= cut6))) { const unsigned idx = xi[c];
                                const unsigned hw = (idx >> 6) * 64u + ((idx >> 2) & 3u) * 16u + (unsigned)row, bit = ((idx >> 4) & 3u) * 4u + (idx & 3u);
                                __hip_atomic_fetch_or((LAS unsigned*)lmask + (hw >> 1), 1u << (16u * (hw & 1u) + bit), __ATOMIC_RELAXED, __HIP_MEMORY_SCOPE_WORKGROUP); } }
                    }
                    __syncthreads();
#pragma unroll 1
                    for (int kb = wave; kb < nkb; kb += 8) F_MASK(F)[(mbase + kb) * 64 + lane] = lmask[kb * 64 + lane];
                    __syncthreads();
                    break;
                }
                if (mode == 4) break;
                if (mode == 5) { mode = 4; continue; }
#pragma unroll 1
                for (int r = 0; r < 2; ++r) { const int row = wave * 2 + r;
                    if (mode == 3) {
                        if (rp3[row] == 0u) continue;
                        const unsigned n = lcnt[row];
                        if (n > 256u) { if (lane == 0) { rcut[row] = 0xffffffffu; rp3[row] = 2u; flags[1] = 1u; } continue; }
                        unsigned ki[4], xi[4], rank[4];
#pragma unroll
                        for (int c = 0; c < 4; ++c) { const unsigned e = (unsigned)(c * 64 + lane); ki[c] = e < n ? lkey[row * 256 + e] : 0u; xi[c] = e < n ? lidx[row * 256 + e] : 0xffffffffu; rank[c] = 0u; }
#pragma unroll 1
                        for (unsigned j = 0; j < n; ++j) { const unsigned kj = lkey[row * 256 + j], xj = lidx[row * 256 + j];
#pragma unroll
                            for (int c = 0; c < 4; ++c) rank[c] += (kj > ki[c] || (kj == ki[c] && xj < xi[c])) ? 1u : 0u; }
                        const unsigned want = rneed[row];
#pragma unroll
                        for (int c = 0; c < 4; ++c) if ((unsigned)(c * 64 + lane) < n && rank[c] + 1u == want) { rpre[row] = ki[c]; rcut[row] = xi[c]; }
                        continue;
                    }
                    unsigned ne; const bool over = idx_select(hist, rpre, rneed, row, lane, 12, ne);
                    if (mode == 1 && ne > CAP6 && lane == 0) flags[2] = 1u;
                    if (over && lane == 0 && mode == 2) { rp3[row] = 1u; flags[0] = 1u; } }
                __syncthreads();
                if (mode == 1) mode = flags[2] == 0u ? 6 : 2; else if (mode == 2) mode = flags[0] != 0u ? 3 : 4; else mode = flags[1] != 0u ? 5 : 4;
            }
        }
    }
}

DI int t5_bucket(int rel) {
    const int n = rel < 0 ? -rel : rel;
    const int lg = 8 + (n >= 12) + (n >= 16) + (n >= 23) + (n >= 32) + (n >= 46) + (n >= 64) + (n >= 91);
    return (rel > 0 ? 16 : 0) + (n < 8 ? n : lg);
}
DI u32x4 ldg16(const void* sbase, unsigned voff) { return *(const u32x4*)((const char*)sbase + voff); }
constexpr int NH = 1;
constexpr int RT = 2;
constexpr int KP = NH * 64 + 8, VP = 72;
template <bool NEAR>
DI void att_tile_old(LAS u16* Kb, LAS u16* Vb, LAS float* bl, const unsigned (&bits)[RT], int kt, int rowl, int lq, int g4, const bf16x8 (&qf)[RT][NH][2], f32x4 (&O)[RT][NH][4], float (&m)[RT][NH], float (&l)[RT][NH]) {
#pragma unroll
    for (int hl = 0; hl < NH; ++hl) {
        f32x4 s[RT][4];
#pragma unroll
        for (int nt = 0; nt < 4; ++nt) {
#pragma unroll
            for (int rt = 0; rt < RT; ++rt) s[rt][nt] = (f32x4){0.f, 0.f, 0.f, 0.f};
#pragma unroll
            for (int ks = 0; ks < 2; ++ks) { const bf16x8 a = *(LAS bf16x8*)(Kb + (nt * 16 + lq) * KP + hl * 64 + ks * 32 + g4 * 8);
#pragma unroll
                for (int rt = 0; rt < RT; ++rt) s[rt][nt] = __builtin_amdgcn_mfma_f32_16x16x32_bf16(a, qf[rt][hl][ks], s[rt][nt], 0, 0, 0); } }
        const float bfar = bl[15 * 4 + hl];
        bf16x8 pb[RT][2];
#pragma unroll
        for (int rt = 0; rt < RT; ++rt) {
            float mx = -INFINITY;
#pragma unroll
            for (int nt = 0; nt < 4; ++nt)
#pragma unroll
                for (int i = 0; i < 4; ++i) { float bias = bfar; if (NEAR) { int ri = kt * 64 + nt * 16 + g4 * 4 + i - (rowl + rt * 16 + lq) + 128; ri = ri < 0 ? 0 : (ri > 255 ? 255 : ri); bias = bl[128 + ri * NH + hl]; } const float x = ((bits[rt] >> (nt * 4 + i)) & 1u) ? s[rt][nt][i] * (0.125f * LOG2E) + bias : -INFINITY; s[rt][nt][i] = x; mx = fmaxf(mx, x); }
            mx = fmaxf(mx, __shfl_xor(mx, 16)); mx = fmaxf(mx, __shfl_xor(mx, 32));
            const float mnew = fmaxf(m[rt][hl], mx), msafe = (mnew == -INFINITY) ? 0.f : mnew, alpha = __builtin_amdgcn_exp2f(m[rt][hl] - msafe); m[rt][hl] = mnew;
            float ls = 0.f;
#pragma unroll
            for (int nt = 0; nt < 4; ++nt)
#pragma unroll
                for (int i = 0; i < 4; ++i) { const float p = __builtin_amdgcn_exp2f(s[rt][nt][i] - msafe); s[rt][nt][i] = p; ls += p; }
            l[rt][hl] = l[rt][hl] * alpha + ls;
#pragma unroll
            for (int dt = 0; dt < 4; ++dt) O[rt][hl][dt] = O[rt][hl][dt] * alpha;
#pragma unroll
            for (int kk = 0; kk < 2; ++kk) { const u32x4 pw = pack8(s[rt][2 * kk], s[rt][2 * kk + 1]); pb[rt][kk] = __builtin_bit_cast(bf16x8, pw); }
        }
#pragma unroll
        for (int kk = 0; kk < 2; ++kk)
#pragma unroll
            for (int dt = 0; dt < 4; ++dt) { LAS u16* vp = Vb + (hl * 64 + dt * 16 + lq) * VP + kk * 32 + g4 * 4; const u32x2 v0 = *(LAS u32x2*)vp, v1 = *(LAS u32x2*)(vp + 16);
                u32x4 vw; vw.x = v0.x; vw.y = v0.y; vw.z = v1.x; vw.w = v1.y; const bf16x8 vf = __builtin_bit_cast(bf16x8, vw);
#pragma unroll
                for (int rt = 0; rt < RT; ++rt) O[rt][hl][dt] = __builtin_amdgcn_mfma_f32_16x16x32_bf16(vf, pb[rt][kk], O[rt][hl][dt], 0, 0, 0); }
    }
}
DI void att_tile_far(LAS u16* Kb, LAS u16* Vb, LAS float* bl, const unsigned (&bits)[RT], const bf16x8 (&qf)[RT][NH][2], f32x4 (&O)[RT][NH][4], float (&m)[RT][NH], float (&l)[RT][NH], int lq, int g4) {
#pragma unroll
    for (int hl = 0; hl < NH; ++hl) {
        bf16x8 kf[4][2], vf[2][4];
#pragma unroll
        for (int nt = 0; nt < 4; ++nt)
#pragma unroll
            for (int ks = 0; ks < 2; ++ks) kf[nt][ks] = *(LAS bf16x8*)(Kb + (nt * 16 + lq) * KP + hl * 64 + ks * 32 + g4 * 8);
#pragma unroll
        for (int kk = 0; kk < 2; ++kk)
#pragma unroll
            for (int dt = 0; dt < 4; ++dt) { LAS u16* vp = Vb + (hl * 64 + dt * 16 + lq) * VP + kk * 32 + g4 * 4; const u32x2 v0 = *(LAS u32x2*)vp, v1 = *(LAS u32x2*)(vp + 16);
                u32x4 vw; vw.x = v0.x; vw.y = v0.y; vw.z = v1.x; vw.w = v1.y; vf[kk][dt] = __builtin_bit_cast(bf16x8, vw); }
        const float bfar = bl[15 * 4 + hl];
        f32x4 s[RT][4];
#pragma unroll
        for (int nt = 0; nt < 4; ++nt) {
#pragma unroll
            for (int rt = 0; rt < RT; ++rt) s[rt][nt] = (f32x4){0.f, 0.f, 0.f, 0.f};
#pragma unroll
            for (int ks = 0; ks < 2; ++ks)
#pragma unroll
                for (int rt = 0; rt < RT; ++rt) s[rt][nt] = __builtin_amdgcn_mfma_f32_16x16x32_bf16(kf[nt][ks], qf[rt][hl][ks], s[rt][nt], 0, 0, 0); }
        bf16x8 pb[RT][2];
#pragma unroll
        for (int rt = 0; rt < RT; ++rt) {
            float mx = -INFINITY;
#pragma unroll
            for (int nt = 0; nt < 4; ++nt)
#pragma unroll
                for (int i = 0; i < 4; ++i) { const int sel = __builtin_amdgcn_sbfe((int)bits[rt], nt * 4 + i, 1);
                    const float x = __int_as_float((__float_as_int(s[rt][nt][i]) & sel) | (int)(0xff800000u & ~(unsigned)sel)); s[rt][nt][i] = x; mx = fmaxf(mx, x); }
            mx = fmaxf(mx, __shfl_xor(mx, 16)); mx = fmaxf(mx, __shfl_xor(mx, 32));
            const float mxl = mx * (0.125f * LOG2E) + bfar;
            const float mnew = fmaxf(m[rt][hl], mxl), msafe = (mnew == -INFINITY) ? 0.f : mnew, alpha = __builtin_amdgcn_exp2f(m[rt][hl] - msafe); m[rt][hl] = mnew;
            const float boff = bfar - msafe; float ls = 0.f;
#pragma unroll
            for (int nt = 0; nt < 4; ++nt)
#pragma unroll
                for (int i = 0; i < 4; ++i) { const float p = __builtin_amdgcn_exp2f(s[rt][nt][i] * (0.125f * LOG2E) + boff); s[rt][nt][i] = p; ls += p; }
            l[rt][hl] = l[rt][hl] * alpha + ls;
#pragma unroll
            for (int dt = 0; dt < 4; ++dt) O[rt][hl][dt] = O[rt][hl][dt] * alpha;
#pragma unroll
            for (int kk = 0; kk < 2; ++kk) { const u32x4 pw = pack8(s[rt][2 * kk], s[rt][2 * kk + 1]); pb[rt][kk] = __builtin_bit_cast(bf16x8, pw); }
        }
#pragma unroll
        for (int kk = 0; kk < 2; ++kk)
#pragma unroll
            for (int dt = 0; dt < 4; ++dt)
#pragma unroll
                for (int rt = 0; rt < RT; ++rt) O[rt][hl][dt] = __builtin_amdgcn_mfma_f32_16x16x32_bf16(vf[kk][dt], pb[rt][kk], O[rt][hl][dt], 0, 0, 0);
    }
}
DI void att_tile_near(LAS u16* Kb, LAS u16* Vb, LAS float* bl, const unsigned (&bits)[RT], int kt, int rowl, const bf16x8 (&qf)[RT][NH][2], f32x4 (&O)[RT][NH][4], float (&m)[RT][NH], float (&l)[RT][NH], int lq, int g4) {
#pragma unroll
    for (int hl = 0; hl < NH; ++hl) {
        bf16x8 vf[2][4];
        f32x4 s[RT][4];
#pragma unroll
        for (int nt = 0; nt < 4; ++nt) {
#pragma unroll
            for (int rt = 0; rt < RT; ++rt) s[rt][nt] = (f32x4){0.f, 0.f, 0.f, 0.f};
#pragma unroll
            for (int ks = 0; ks < 2; ++ks) { const bf16x8 kfr = *(LAS bf16x8*)(Kb + (nt * 16 + lq) * KP + hl * 64 + ks * 32 + g4 * 8);
#pragma unroll
                for (int rt = 0; rt < RT; ++rt) s[rt][nt] = __builtin_amdgcn_mfma_f32_16x16x32_bf16(kfr, qf[rt][hl][ks], s[rt][nt], 0, 0, 0); } }
        bf16x8 pb[RT][2];
#pragma unroll
        for (int rt = 0; rt < RT; ++rt) {
            float bia[16];
#pragma unroll
            for (int nt = 0; nt < 4; ++nt)
#pragma unroll
                for (int i = 0; i < 4; ++i) { int ri = kt * 64 + nt * 16 + g4 * 4 + i - (rowl + rt * 16 + lq) + 128; ri = ri < 0 ? 0 : (ri > 255 ? 255 : ri); bia[nt * 4 + i] = bl[128 + ri * NH + hl]; }
            float mx = -INFINITY;
#pragma unroll
            for (int nt = 0; nt < 4; ++nt)
#pragma unroll
                for (int i = 0; i < 4; ++i) { const float xb = s[rt][nt][i] * (0.125f * LOG2E) + bia[nt * 4 + i];
                    const int sel = __builtin_amdgcn_sbfe((int)bits[rt], nt * 4 + i, 1);
                    const float x = __int_as_float((__float_as_int(xb) & sel) | (int)(0xff800000u & ~(unsigned)sel)); s[rt][nt][i] = x; mx = fmaxf(mx, x); }
            mx = fmaxf(mx, __shfl_xor(mx, 16)); mx = fmaxf(mx, __shfl_xor(mx, 32));
            const float mnew = fmaxf(m[rt][hl], mx), msafe = (mnew == -INFINITY) ? 0.f : mnew, alpha = __builtin_amdgcn_exp2f(m[rt][hl] - msafe); m[rt][hl] = mnew;
            float ls = 0.f;
#pragma unroll
            for (int nt = 0; nt < 4; ++nt)
#pragma unroll
                for (int i = 0; i < 4; ++i) { const float p = __builtin_amdgcn_exp2f(s[rt][nt][i] - msafe); s[rt][nt][i] = p; ls += p; }
            l[rt][hl] = l[rt][hl] * alpha + ls;
#pragma unroll
            for (int dt = 0; dt < 4; ++dt) O[rt][hl][dt] = O[rt][hl][dt] * alpha;
#pragma unroll
            for (int kk = 0; kk < 2; ++kk) { const u32x4 pw = pack8(s[rt][2 * kk], s[rt][2 * kk + 1]); pb[rt][kk] = __builtin_bit_cast(bf16x8, pw); }
        }
#pragma unroll
        for (int kk = 0; kk < 2; ++kk)
#pragma unroll
            for (int dt = 0; dt < 4; ++dt) { LAS u16* vp = Vb + (hl * 64 + dt * 16 + lq) * VP + kk * 32 + g4 * 4; const u32x2 v0 = *(LAS u32x2*)vp, v1 = *(LAS u32x2*)(vp + 16);
                u32x4 vw; vw.x = v0.x; vw.y = v0.y; vw.z = v1.x; vw.w = v1.y; vf[kk][dt] = __builtin_bit_cast(bf16x8, vw); }
#pragma unroll
        for (int kk = 0; kk < 2; ++kk)
#pragma unroll
            for (int dt = 0; dt < 4; ++dt)
#pragma unroll
                for (int rt = 0; rt < RT; ++rt) O[rt][hl][dt] = __builtin_amdgcn_mfma_f32_16x16x32_bf16(vf[kk][dt], pb[rt][kk], O[rt][hl][dt], 0, 0, 0);
    }
}
DI void att_phase(const Frame& F, LAS unsigned char* lds) {
    constexpr int KT = 64 * KP, VTS = NH * 64 * VP;
    LAS u16* Kbuf = (LAS u16*)lds;
    LAS u16* Vbuf = (LAS u16*)(lds + 4 * KT * 2);
    LAS float* bl = (LAS float*)(lds + 4 * KT * 2 + 4 * VTS * 2);
    const int tid = F.tid, lane = F.lane, wave = F.wave, lq = lane & 15, g4 = lane >> 4;
    constexpr int NQ = 8 / NH;
    constexpr int BR = 8 * 16 * RT, NBT = SEQ / BR;
    for (int pp = blockIdx.x; pp < 4 * NQ * (NBT / 2); pp += gridDim.x) {
        const int x = pp & 7, y = pp >> 3, b = x >> 1, hq = (x & 1) * (NQ / 2) + (y % (NQ / 2)), ii = y / (NQ / 2);
        __syncthreads();
        if (tid < 128) bl[tid] = ((tid & 3) < NH) ? F.in[23][(tid >> 2) * 8 + hq * NH + (tid & 3)] * LOG2E : 0.f;
        for (int e = tid; e < 256 * NH; e += NTHR) bl[128 + e] = F.in[23][t5_bucket(e / NH - 128) * 8 + hq * NH + (e % NH)] * LOG2E;
        __syncthreads();
        for (int which = 0; which < 2; ++which) {
            const int i = which ? NBT - 1 - ii : ii, npair = (BR / 128) * (i + 1), rowl = i * BR + wave * (16 * RT);
            const int c = rowl >> 6, my_ntile = c + 1;
            u16* qbase = F_Q(F) + ((size_t)b * SEQ + rowl + lq) * 512 + hq * (NH * 64);
            bf16x8 qf[RT][NH][2];
#pragma unroll
            for (int rt = 0; rt < RT; ++rt)
#pragma unroll
                for (int hl = 0; hl < NH; ++hl)
#pragma unroll
                    for (int ks = 0; ks < 2; ++ks) qf[rt][hl][ks] = *(const bf16x8*)(qbase + rt * 16 * 512 + hl * 64 + ks * 32 + g4 * 8);
            f32x4 O[RT][NH][4]; float m[RT][NH], l[RT][NH];
#pragma unroll
            for (int rt = 0; rt < RT; ++rt)
#pragma unroll
                for (int hl = 0; hl < NH; ++hl) { m[rt][hl] = -INFINITY; l[rt][hl] = 0.f;
#pragma unroll
                    for (int dt = 0; dt < 4; ++dt) O[rt][hl][dt] = (f32x4){0.f, 0.f, 0.f, 0.f}; }
            const size_t mb0 = (size_t)b * MASK_PER_B + (size_t)(c + 1) * (2 * c + ((rowl >> 4) & 3));
            const char* mp = (const char*)(F_MASK(F) + mb0 * 64) + (unsigned)(lane * 2);
            const int mrt = (c + 1) * 128;
            const u16* kg = F_K(F) + ((size_t)b * SEQ) * 512 + hq * (NH * 64); const u16* vg = F_VT(F) + ((size_t)(b * 512 + hq * (NH * 64))) * SEQ;
            constexpr int NE = NH, KCH = NH * 8, KR = 512 / KCH;
            u32x4 kr[2][NE], vr[2][NE];
            const unsigned voffK = (unsigned)(((tid / KCH) * 512 + (tid % KCH) * 8) * 2), voffV = (unsigned)(((tid >> 3) * SEQ + (tid & 7) * 8) * 2);
            const int krow = tid / KCH, kck = tid % KCH, vrow = tid >> 3, vck = tid & 7;
#pragma unroll
            for (int t = 0; t < 2; ++t)
#pragma unroll
                for (int e = 0; e < NE; ++e) { kr[t][e] = ldg16(kg + (size_t)(t * 64 + e * KR) * 512, voffK); vr[t][e] = ldg16(vg + (size_t)e * 64 * SEQ + t * 64, voffV); }
#pragma unroll
            for (int t = 0; t < 2; ++t)
#pragma unroll
                for (int e = 0; e < NE; ++e) { *(LAS u32x4*)(Kbuf + t * KT + (krow + e * KR) * KP + kck * 8) = kr[t][e]; *(LAS u32x4*)(Vbuf + t * VTS + (vrow + e * 64) * VP + vck * 8) = vr[t][e]; }
            unsigned bc[2][RT], bn[2][RT];
#pragma unroll
            for (int t = 0; t < 2; ++t)
#pragma unroll
                for (int rt = 0; rt < RT; ++rt) { const int kq = t < my_ntile ? t : my_ntile - 1; bc[t][rt] = *(const u16*)(mp + rt * mrt + kq * 128); }
            __builtin_amdgcn_s_waitcnt(0x0F70);
            __syncthreads();
#pragma unroll 1
            for (int kp = 0; kp < npair; ++kp) {
                const bool more = kp + 1 < npair; const int kt0 = 2 * kp, st = kp & 1;
                if (more) {
#pragma unroll
                    for (int t = 0; t < 2; ++t)
#pragma unroll
                        for (int rt = 0; rt < RT; ++rt) { const int kq = kt0 + 2 + t < my_ntile ? kt0 + 2 + t : my_ntile - 1; bn[t][rt] = *(const u16*)(mp + rt * mrt + kq * 128); }
#pragma unroll
                    for (int t = 0; t < 2; ++t)
#pragma unroll
                        for (int e = 0; e < NE; ++e) { kr[t][e] = ldg16(kg + (size_t)((kt0 + 2 + t) * 64 + e * KR) * 512, voffK); vr[t][e] = ldg16(vg + (size_t)e * 64 * SEQ + (kt0 + 2 + t) * 64, voffV); }
                }
#pragma unroll
                for (int t = 0; t < 2; ++t) { const int kt = kt0 + t;
                    if (kt < my_ntile) {
                        LAS u16* Kb = Kbuf + (st * 2 + t) * KT; LAS u16* Vb = Vbuf + (st * 2 + t) * VTS;
                        if (kt * 64 + 63 - rowl <= -91) att_tile_far(Kb, Vb, bl, bc[t], qf, O, m, l, lq, g4);
                        else att_tile_near(Kb, Vb, bl, bc[t], kt, rowl, qf, O, m, l, lq, g4);
                    } }
                if (more) {
#pragma unroll
                    for (int t = 0; t < 2; ++t)
#pragma unroll
                        for (int e = 0; e < NE; ++e) { *(LAS u32x4*)(Kbuf + ((st ^ 1) * 2 + t) * KT + (krow + e * KR) * KP + kck * 8) = kr[t][e]; *(LAS u32x4*)(Vbuf + ((st ^ 1) * 2 + t) * VTS + (vrow + e * 64) * VP + vck * 8) = vr[t][e]; }
#pragma unroll
                    for (int t = 0; t < 2; ++t)
#pragma unroll
                        for (int rt = 0; rt < RT; ++rt) bc[t][rt] = bn[t][rt];
                }
                __syncthreads();
            }
#pragma unroll
            for (int rt = 0; rt < RT; ++rt)
#pragma unroll
                for (int hl = 0; hl < NH; ++hl) { float lt = l[rt][hl]; lt += __shfl_xor(lt, 16); lt += __shfl_xor(lt, 32); const float inv = 1.0f / lt;
#pragma unroll
                    for (int dt = 0; dt < 4; ++dt) { const f32x4 o = O[rt][hl][dt] * inv; u32x2 w; w.x = cvt_pk_bf16(o[0], o[1]); w.y = cvt_pk_bf16(o[2], o[3]);
                        *(u32x2*)(qbase + rt * 16 * 512 + hl * 64 + dt * 16 + g4 * 4) = w; } }
        }
    }
}

#define XB_TMO      128
#define XB_XCNT(j)  (256  + 64 * (j))
#define XB_XSUB(j)  (1280 + 64 * (j))
#define XB_XGEN(j)  (2304 + 64 * (j))
#define XB_TOP      3328
#define XB_TOPGEN   3392
#define XCD_BAR_WORDS 3456
#define XB_SPIN_CAP (1u << 18)
DI unsigned xb_ld(unsigned* p)              { return __hip_atomic_load(p, __ATOMIC_RELAXED, __HIP_MEMORY_SCOPE_AGENT); }
DI unsigned xb_add(unsigned* p, unsigned v) { return __hip_atomic_fetch_add(p, v, __ATOMIC_RELAXED, __HIP_MEMORY_SCOPE_AGENT); }
DI unsigned xb_xcc_id() { return (unsigned)__builtin_amdgcn_s_getreg((3 << 11) | 20) & 0xFu; }
#define XB_SPIN(cond, bar) do { unsigned _sp = 0; while (cond) { __builtin_amdgcn_s_sleep(1); \
    if ((++_sp & 255u) == 0u) { if (xb_ld(&(bar)[XB_TMO])) break; if (_sp > XB_SPIN_CAP) { (void)xb_add(&(bar)[XB_TMO], 1u); break; } } } } while (0)
struct XcdBarrier { unsigned* bar; unsigned x; volatile LAS unsigned* st; };
DI XcdBarrier xcd_barrier_post(unsigned* bar, volatile LAS unsigned* st) {
    XcdBarrier b; b.bar = bar; b.x = xb_xcc_id(); b.st = st;
    if (threadIdx.x == 0) (void)xb_add(&bar[XB_XCNT(b.x)], 1u);
    return b;
}
DI void xcd_barrier_complete(unsigned* bar, unsigned x, unsigned& nloc, unsigned& nx) {
    const unsigned G = gridDim.x * gridDim.y * gridDim.z;
    unsigned sum, cnt, mine, sp = 0u;
    for (;;) {
        sum = 0u; cnt = 0u; mine = 0u;
#pragma unroll
        for (unsigned j = 0; j < 16; ++j) { const unsigned c = xb_ld(&bar[XB_XCNT(j)]); sum += c; cnt += (c > 0u) ? 1u : 0u; mine = (j == x) ? c : mine; }
        if (sum == G) break;
        __builtin_amdgcn_s_sleep(1);
        if ((++sp & 255u) == 0u) { if (xb_ld(&bar[XB_TMO])) break; if (sp > XB_SPIN_CAP) { (void)xb_add(&bar[XB_TMO], 1u); break; } }
    }
    nloc = mine > 0u ? mine : 1u; nx = cnt > 0u ? cnt : 1u;
}
DI unsigned xb_uadd(unsigned* p, unsigned v) { unsigned r = 0u; if ((threadIdx.x & 63) == 0) r = xb_add(p, v); return (unsigned)__builtin_amdgcn_readfirstlane((int)r); }
DI unsigned xb_uld(unsigned* p) { return (unsigned)__builtin_amdgcn_readfirstlane((int)xb_ld(p)); }
DI void xcd_barrier(unsigned* bar, unsigned bx, volatile LAS unsigned* bst) {
    asm volatile("s_waitcnt vmcnt(0)" ::: "memory");
    __syncthreads();
    if (__builtin_amdgcn_readfirstlane((int)(threadIdx.x >> 6)) == 0) {
        asm volatile("s_waitcnt vmcnt(0) lgkmcnt(0)" ::: "memory");
        unsigned nloc = (unsigned)__builtin_amdgcn_readfirstlane((int)bst[0]), nx = (unsigned)__builtin_amdgcn_readfirstlane((int)bst[1]);
        if (nloc == 0u) {
            const unsigned G = gridDim.x; unsigned sp = 0u;
            for (;;) {
                unsigned sum = 0u, cnt = 0u, mine = 0u;
#pragma unroll
                for (unsigned j = 0; j < 16; ++j) { const unsigned c = xb_uld(&bar[XB_XCNT(j)]); sum += c; cnt += (c > 0u) ? 1u : 0u; mine = (j == bx) ? c : mine; }
                nloc = mine > 0u ? mine : 1u; nx = cnt > 0u ? cnt : 1u;
                if (sum == G) break;
                __builtin_amdgcn_s_sleep(1);
                if (++sp > XB_SPIN_CAP) { (void)xb_uadd(&bar[XB_TMO], 1u); break; }
            }
            if ((threadIdx.x & 63) == 0) { bst[0] = nloc; bst[1] = nx; }
        }
        const unsigned old = xb_uadd(&bar[XB_XSUB(bx)], 1u);
        const unsigned gen = old / nloc;
        if (old + 1u == (gen + 1u) * nloc) {
            __builtin_amdgcn_fence(__ATOMIC_RELEASE, "agent");
            asm volatile("s_waitcnt vmcnt(0)" ::: "memory");
            const unsigned og = xb_uadd(&bar[XB_TOP], 1u);
            const unsigned tg = og / nx;
            if (og + 1u == (tg + 1u) * nx) (void)xb_uadd(&bar[XB_TOPGEN], 1u);
            else { unsigned sp = 0u; while (xb_uld(&bar[XB_TOPGEN]) == tg) { __builtin_amdgcn_s_sleep(1); if (++sp > XB_SPIN_CAP) { (void)xb_uadd(&bar[XB_TMO], 1u); break; } } }
            __builtin_amdgcn_fence(__ATOMIC_ACQUIRE, "agent");
            (void)xb_uadd(&bar[XB_XGEN(bx)], 1u);
            asm volatile("s_waitcnt vmcnt(0)" ::: "memory");
        } else {
            unsigned sp = 0u; while (xb_uld(&bar[XB_XGEN(bx)]) == gen) { __builtin_amdgcn_s_sleep(1); if (++sp > XB_SPIN_CAP) { (void)xb_uadd(&bar[XB_TMO], 1u); break; } }
            __builtin_amdgcn_fence(__ATOMIC_ACQUIRE, "agent");
            asm volatile("s_waitcnt vmcnt(0)" ::: "memory");
        }
    }
    __syncthreads();
}

constexpr int NPH = 33;
#define PHON(k) ((PHM >> (k)) & 1)
DI void fresh(Frame& F, const Args& args) {
    int t = threadIdx.x; asm volatile("" : "+v"(t)); F.tid = t; F.lane = t & 63; F.wave = __builtin_amdgcn_readfirstlane(t >> 6);
    int z = 0; asm volatile("" : "+s"(z)); F.in = args.in + z;
    F.ws = args.ws + z; F.out = args.out + z;
}
#ifndef RPT
#define RPT 0
#endif
#define PH_BEGIN(k) if (args.lo <= (k) && (k) < args.hi) { fresh(F, args); unsigned char* ws = F.ws; (void)ws;
#define PH_END(k) if ((k) + 1 < args.hi) xcd_barrier(xbar, xx, xst); }
template <int PHM, int L>
DI void layer_phases(Frame& F, const Args& args, LAS unsigned char* lds, cg::grid_group& grid, unsigned* xbar, unsigned xx, volatile LAS unsigned* xst) {
    constexpr int P = 1 + 16 * L;
#define WL (ws + WS_W + (size_t)L * SZ_LAYERW)
#define TAB (ws + WS_TAB + (size_t)L * SZ_TABL)
#define WLDS (lds + F.wave * 19456)
    PH_BEGIN(P + 0) if (PHON(0)) { EpiUp E{F_H(F)}; run_gemm(lds, F_XB(F), (const u16*)(WL + OFF_UP1), NUP, D_, E); } if ((RPT >> 0) & 1) { xcd_barrier(xbar, xx, xst); fresh(F, args); if (PHON(0)) { EpiUp E{F_H(F)}; run_gemm(lds, F_XB(F), (const u16*)(WL + OFF_UP1), NUP, D_, E); } } PH_END(P + 0)
    PH_BEGIN(P + 1) if (PHON(1)) { EpiRes E{L == 0 ? F.in[0] : (const float*)F.out, F.out, 0.5f, L == 0 ? (const f32x2_t*)nullptr : (const f32x2_t*)(ws + WS_STATS), F.in[21], F.in[22]};     run_gemm(lds, F_H(F), (const u16*)(WL + OFF_DN1), D_, DFF, E); } if ((RPT >> 1) & 1) { xcd_barrier(xbar, xx, xst); fresh(F, args); if (PHON(1)) { EpiRes E{L == 0 ? F.in[0] : (const float*)F.out, F.out, 0.5f, L == 0 ? (const f32x2_t*)nullptr : (const f32x2_t*)(ws + WS_STATS), F.in[21], F.in[22]};     run_gemm(lds, F_H(F), (const u16*)(WL + OFF_DN1), D_, DFF, E); } } PH_END(P + 1)
    PH_BEGIN(P + 2) if (PHON(2)) ln_phase(F, F.in[3] + L * D_, F.in[4] + L * D_, false); if ((RPT >> 2) & 1) { xcd_barrier(xbar, xx, xst); fresh(F, args); if (PHON(2)) ln_phase(F, F.in[3] + L * D_, F.in[4] + L * D_, false); } PH_END(P + 2)
    PH_BEGIN(P + 3) if (PHON(3)) { EpiIn E{ws}; run_gemm(lds, F_XB(F), (const u16*)(WL + OFF_WIN), NIN, D_, E); } if ((RPT >> 3) & 1) { xcd_barrier(xbar, xx, xst); fresh(F, args); if (PHON(3)) { EpiIn E{ws}; run_gemm(lds, F_XB(F), (const u16*)(WL + OFF_WIN), NIN, D_, E); } } PH_END(P + 3)
    PH_BEGIN(P + 4) if (PHON(4)) { idx_phase(F, lds); __syncthreads(); fresh(F, args); { for (int t = blockIdx.x * 8 + F.wave; t < 4096; t += gridDim.x * 8) vt_tile(F, WLDS, t);
        { int gcur = -1; float ar = 0.f, ai = 0.f, cr = 0.f, ci = 0.f, bb[32]; bf16x8 cf[4]; f32x4 dv = {0.f, 0.f, 0.f, 0.f};
          for (int it = blockIdx.x * 8 + F.wave; it < 16384; it += gridDim.x * 8) { const int g = it & 31; if (g != gcur) { ssm_load_g(TAB, F.in[13] + L * 512, g, F.lane, ar, ai, cr, ci, bb, cf, dv); gcur = g; } ssmA_item(F, WLDS, it, ar, ai, bb); } } } } PH_END(P + 4)
    PH_BEGIN(P + 5) if (PHON(5)) { att_phase(F, lds); __syncthreads(); fresh(F, args); { int gcur = -1; float ar = 0.f, ai = 0.f, cr = 0.f, ci = 0.f, bb[32]; bf16x8 cf[4]; f32x4 dv = {0.f, 0.f, 0.f, 0.f};
          for (int it = blockIdx.x * 8 + F.wave; it < 16384; it += gridDim.x * 8) { const int g = it & 31; if (g != gcur) { ssm_load_g(TAB, F.in[13] + L * 512, g, F.lane, ar, ai, cr, ci, bb, cf, dv); gcur = g; } ssmC_item(F, WLDS, it, ar, ai, cr, ci, bb, cf, dv); } } } PH_END(P + 5)
    PH_BEGIN(P + 6) if (PHON(6)) { EpiMix<0> E{F_U(F), nullptr, F_YS(F), 512}; run_gemm(lds, F_U(F), (const u16*)(WL + OFF_GLU), 512, 512, E); } if ((RPT >> 6) & 1) { xcd_barrier(xbar, xx, xst); fresh(F, args); if (PHON(6)) { EpiMix<0> E{F_U(F), nullptr, F_YS(F), 512}; run_gemm(lds, F_U(F), (const u16*)(WL + OFF_GLU), 512, 512, E); } } PH_END(P + 6)
    PH_BEGIN(P + 7) if (PHON(7)) { EpiMix<1> E{F_GS(F), nullptr, F_GS(F), 1024}; run_gemm(lds, F_YS(F), (const u16*)(WL + OFF_WB0), D_, 512, E); } if ((RPT >> 7) & 1) { xcd_barrier(xbar, xx, xst); fresh(F, args); if (PHON(7)) { EpiMix<1> E{F_GS(F), nullptr, F_GS(F), 1024}; run_gemm(lds, F_YS(F), (const u16*)(WL + OFF_WB0), D_, 512, E); } } PH_END(P + 7)
    PH_BEGIN(P + 10) if (PHON(10)) { EpiMix<2> E{F_GA(F), F_GS(F), F_GA(F), 1024}; run_gemm(lds, F_Q(F), (const u16*)(WL + OFF_WB1), D_, 512, E); } if ((RPT >> 10) & 1) { xcd_barrier(xbar, xx, xst); fresh(F, args); if (PHON(10)) { EpiMix<2> E{F_GA(F), F_GS(F), F_GA(F), 1024}; run_gemm(lds, F_Q(F), (const u16*)(WL + OFF_WB1), D_, 512, E); } } PH_END(P + 10)
    PH_BEGIN(P + 11) if (PHON(11)) { EpiRes E{(const float*)F.out, F.out, 1.0f, (const f32x2_t*)(ws + WS_STATS), F.in[3] + L * D_, F.in[4] + L * D_}; run_gemm(lds, F_GA(F), (const u16*)(WL + OFF_WOUT), D_, D_, E); } if ((RPT >> 11) & 1) { xcd_barrier(xbar, xx, xst); fresh(F, args); if (PHON(11)) { EpiRes E{(const float*)F.out, F.out, 1.0f, (const f32x2_t*)(ws + WS_STATS), F.in[3] + L * D_, F.in[4] + L * D_}; run_gemm(lds, F_GA(F), (const u16*)(WL + OFF_WOUT), D_, D_, E); } } PH_END(P + 11)
    PH_BEGIN(P + 12) if (PHON(12)) ln_phase(F, F.in[17] + L * D_, F.in[18] + L * D_, false); if ((RPT >> 12) & 1) { xcd_barrier(xbar, xx, xst); fresh(F, args); if (PHON(12)) ln_phase(F, F.in[17] + L * D_, F.in[18] + L * D_, false); } PH_END(P + 12)
    PH_BEGIN(P + 13) if (PHON(13)) { EpiUp E{F_H(F)}; run_gemm(lds, F_XB(F), (const u16*)(WL + OFF_UP2), NUP, D_, E); } if ((RPT >> 13) & 1) { xcd_barrier(xbar, xx, xst); fresh(F, args); if (PHON(13)) { EpiUp E{F_H(F)}; run_gemm(lds, F_XB(F), (const u16*)(WL + OFF_UP2), NUP, D_, E); } } PH_END(P + 13)
    PH_BEGIN(P + 14) if (PHON(14)) { EpiRes E{(const float*)F.out, F.out, 0.5f, (const f32x2_t*)(ws + WS_STATS), F.in[17] + L * D_, F.in[18] + L * D_}; run_gemm(lds, F_H(F), (const u16*)(WL + OFF_DN2), D_, DFF, E); } if ((RPT >> 14) & 1) { xcd_barrier(xbar, xx, xst); fresh(F, args); if (PHON(14)) { EpiRes E{(const float*)F.out, F.out, 0.5f, (const f32x2_t*)(ws + WS_STATS), F.in[17] + L * D_, F.in[18] + L * D_}; run_gemm(lds, F_H(F), (const u16*)(WL + OFF_DN2), D_, DFF, E); } } PH_END(P + 14)
    PH_BEGIN(P + 15) if (PHON(15)) ln_phase(F, F.in[21] + L * D_, F.in[22] + L * D_, L == 1); if ((RPT >> 15) & 1) { xcd_barrier(xbar, xx, xst); fresh(F, args); if (PHON(15)) ln_phase(F, F.in[21] + L * D_, F.in[22] + L * D_, L == 1); } PH_END(P + 15)
#undef WL
#undef TAB
#undef WLDS
}
template <int PHM>
__global__ void __launch_bounds__(NTHR, 2) mega(Args args) {
    extern __shared__ __attribute__((aligned(16))) unsigned char lds_raw[];
    LAS unsigned char* lds = (LAS unsigned char*)lds_raw;
    Frame F;
    cg::grid_group grid = cg::this_grid();
    volatile LAS unsigned* xst = (volatile LAS unsigned*)(lds + LDS_MAIN);
    if (threadIdx.x < 4) xst[threadIdx.x] = 0u;
    __syncthreads();
    unsigned* bar = (unsigned*)(args.ws + WS_BAR);
    if (args.lo <= 0 && 0 < args.hi) { fresh(F, args);
        if (blockIdx.x == 0) { for (int i = F.tid; i < XCD_BAR_WORDS; i += NTHR) bar[i] = 0u; }
        if (PHON(16)) p0_phase(F, lds);
        if (1 < args.hi) grid.sync(); }
    const unsigned xx = xb_xcc_id();
    if (threadIdx.x == 0) (void)xb_add(&bar[XB_XCNT(xx)], 1u);
    layer_phases<PHM, 0>(F, args, lds, grid, bar, xx, xst);
    layer_phases<PHM, 1>(F, args, lds, grid, bar, xx, xst);
}

typedef void (*kern_t)(Args);
#if !ONE_LAUNCH
static kern_t phase_kernel(int ph) {
    if (ph == 0) return mega<(1 << 16)>;
    switch ((ph - 1) & 15) {
    case 0: return mega<(1 << 0)>; case 1: return mega<(1 << 1)>; case 2: return mega<(1 << 2)>; case 3: return mega<(1 << 3)>;
    case 4: return mega<(1 << 4)>; case 5: return mega<(1 << 5)>; case 6: return mega<(1 << 6)>; case 7: return mega<(1 << 7)>;
    case 8: return mega<(1 << 8)>; case 9: return mega<(1 << 9)>; case 10: return mega<(1 << 10)>; case 11: return mega<(1 << 11)>;
    case 12: return mega<(1 << 12)>; case 13: return mega<(1 << 13)>; case 14: return mega<(1 << 14)>; default: return mega<(1 << 15)>;
    }
}
#endif
extern "C" void kernel_launch(void* const* d_in, const int* in_sizes, int n_in, void* d_out, int out_size, void* d_ws, size_t ws_size, hipStream_t stream) {
    static int grid = 0;
    if (grid == 0) {
        int dev = 0, cus = 0;
        if (n_in != 24 || out_size != T_ * D_ || ws_size < WS_END) { fprintf(stderr, "kernel_launch: unexpected problem (n_in %d out %d ws %zu need %zu)\n", n_in, out_size, ws_size, (size_t)WS_END); grid = -1; return; }
        (void)hipGetDevice(&dev); (void)hipDeviceGetAttribute(&cus, hipDeviceAttributeMultiprocessorCount, dev);
#if ONE_LAUNCH
        if (hipFuncSetAttribute((const void*)mega<0x1ffff>, hipFuncAttributeMaxDynamicSharedMemorySize, LDS_BYTES) != hipSuccess) fprintf(stderr, "kernel_launch: hipFuncSetAttribute failed\n");
#else
        for (int ph = 0; ph < 17; ++ph) if (hipFuncSetAttribute((const void*)phase_kernel(ph), hipFuncAttributeMaxDynamicSharedMemorySize, LDS_BYTES) != hipSuccess) fprintf(stderr, "kernel_launch: hipFuncSetAttribute failed\n");
#endif
        (void)hipGetLastError();
        grid = cus > 0 ? cus : 256;
    }
    if (grid < 0) return;
    Args a{};
    for (int i = 0; i < 24; ++i) a.in[i] = (const float*)d_in[i];
    a.out = (float*)d_out; a.ws = (unsigned char*)d_ws;
#if ONE_LAUNCH
    a.lo = 0; a.hi = NPH;
    void* kargs[] = {&a};
    hipError_t e = hipLaunchCooperativeKernel((const void*)mega<0x1ffff>, dim3(grid), dim3(NTHR), kargs, LDS_BYTES, stream);
    if (e != hipSuccess) fprintf(stderr, "cooperative launch failed: %s (grid %d)\n", hipGetErrorString(e), grid);
#else
    for (int ph = 0; ph < NPH; ++ph) { a.lo = ph; a.hi = ph + 1; hipLaunchKernelGGL(phase_kernel(ph), dim3(grid), dim3(NTHR), LDS_BYTES, stream, a); }
#endif
}
```

```cpp
#include <hip/hip_runtime.h>
#include <hip/hip_cooperative_groups.h>
#include <cstdio>
namespace cg = cooperative_groups;
#ifndef ONE_LAUNCH
#define ONE_LAUNCH 1
#endif
namespace pg8 {
#define PG8_LAS __attribute__((address_space(3)))
typedef unsigned short bf16_t;
typedef short bf16x8 __attribute__((ext_vector_type(8)));
typedef float f32x4 __attribute__((ext_vector_type(4)));
typedef unsigned u32x4 __attribute__((ext_vector_type(4)));
constexpr int BM = 256, BK = 64, HALF = 128, HTB = HALF * BK * 2  , STAGE_BYTES = 8 * HTB, NXCD = 8, WGM = 8;

__host__ __device__ __forceinline__ int lds_byte(int r, int c) { const int st = (r >> 4) * 2 + (c >> 5), rr = r & 15, cc = c & 31, ob = rr * 64 + cc * 2; return st * 1024 + (ob ^ (((ob >> 9) & 1) << 5)); }
__host__ __device__ __forceinline__ void stage_rc(int b, int& R, int& C) { const int st = b / 1024, sb = b % 1024, swz = sb ^ (((sb >> 9) & 1) << 5); R = (st >> 1) * 16 + swz / 64; C = (st & 1) * 32 + (swz % 64) / 2; }
__host__ __device__ __forceinline__ int perm32(int rho) { const int n = rho >> 4, i = rho & 15; return 8 * (i >> 2) + 4 * n + (i & 3); }

struct Unit { int pm, pn; };
struct Gemm { const bf16_t* A; const bf16_t* Bt; int M, N, K; };

struct StaticOrder {
    int nM, nN, nwg, G, c;
    __host__ __device__ void init(int M, int N, int G_, int c_) { nM = M / BM; nN = N / BM; nwg = nM * nN; G = G_; c = c_; }
    __host__ __device__ bool next(int i, Unit& u) const {
        const long L = (long)i * G + c; if (L >= nwg) return false;
        int wgid = (int)L; { const int q = nwg / NXCD, r = nwg % NXCD, xcd = wgid % NXCD, off = wgid / NXCD; wgid = (xcd < r ? xcd * (q + 1) : r * (q + 1) + (xcd - r) * q) + off; }
        const int nig = WGM * nN, gid = wgid / nig, fm = gid * WGM, gsz = (nM - fm) < WGM ? (nM - fm) : WGM;
        u.pm = fm + ((wgid % nig) % gsz); u.pn = (wgid % nig) / gsz; return true;
    }
    __device__ __forceinline__ void a_ready(const Unit&) const {}
    __device__ __forceinline__ void done(const Unit&) const {}
};
__device__ __forceinline__ unsigned cvt_pk_bf16(float lo, float hi) { unsigned r; asm volatile("v_cvt_pk_bf16_f32 %0, %1, %2" : "=v"(r) : "v"(lo), "v"(hi)); return r; }
template <class Epi, class Sched, bool STAMP = false>
__device__ __forceinline__ void gemm_phase(PG8_LAS unsigned char* lds, const Gemm g, const Sched& S, const Epi& E, unsigned long long* stamps) {
    const int tid = threadIdx.x, wid = __builtin_amdgcn_readfirstlane(tid >> 6), lane = tid & 63, wr = wid >> 2, wc = wid & 3, fr = lane & 15, fq = lane >> 4;
    const int K = g.K, nt = K / BK;
    int ts_lo = 0, ts_hi = 0, nts = 0; const unsigned long long rt_entry = STAMP ? (unsigned long long)wall_clock64() : 0ull;
#define PG8_STAMP() do { if (STAMP && wid == 0 && nts < 64) { const unsigned long long _c = (unsigned long long)clock64(); \
        ts_lo = (lane == nts) ? (int)(unsigned)_c : ts_lo; ts_hi = (lane == nts) ? (int)(unsigned)(_c >> 32) : ts_hi; ++nts; } } while (0)
    PG8_STAMP();
    unsigned voffA[2], voffB[2];
#pragma unroll
    for (int i = 0; i < 2; ++i) { int R, C; stage_rc(tid * 16 + i * 8192, R, C); const int Rb = Epi::PERM ? ((R & ~31) + perm32(R & 31)) : R;
        voffA[i] = (unsigned)(R * K + C) * 2u; voffB[i] = (unsigned)(Rb * K + C) * 2u; }
    const size_t kstep = (size_t)(BK * 2);
    const size_t hstep = (size_t)HALF * K * 2;
    const size_t tstep = 2 * hstep;
    const unsigned ldsw = (unsigned)wid * 1024u;
    const int aoff = lds_byte(wr * 64 + fr, fq * 8), boff = lds_byte(wc * 32 + fr, fq * 8);
#define PG8_SA(b, h) (((b) * 2 + (h)) * HTB)
#define PG8_SB(b, h) ((4 + (b) * 2 + (h)) * HTB)
#define PG8_STAGE(bufoff, gbase, voff) do { _Pragma("unroll") for (int _i = 0; _i < 2; ++_i) \
        __builtin_amdgcn_global_load_lds((const unsigned*)((const char*)(gbase) + (voff)[_i]), (PG8_LAS unsigned*)(lds + (bufoff) + ldsw + _i * 8192), 16, 0, 0); } while (0)
#define PG8_LDA(dst, b, h) do { _Pragma("unroll") for (int m = 0; m < 4; ++m) _Pragma("unroll") for (int k = 0; k < 2; ++k) dst[m][k] = *(const PG8_LAS bf16x8*)(lds + PG8_SA(b, h) + aoff + m * 2048 + k * 1024); } while (0)
#define PG8_LDB(dst, b, h) do { _Pragma("unroll") for (int n = 0; n < 2; ++n) _Pragma("unroll") for (int k = 0; k < 2; ++k) dst[n][k] = *(const PG8_LAS bf16x8*)(lds + PG8_SB(b, h) + boff + n * 2048 + k * 1024); } while (0)
#define PG8_MMA(ai, bj, At, Bt) do { __builtin_amdgcn_s_setprio(1); _Pragma("unroll") for (int m = 0; m < 4; ++m) _Pragma("unroll") for (int n = 0; n < 2; ++n) _Pragma("unroll") for (int k = 0; k < 2; ++k) \
        acc[ai][bj][m][n] = __builtin_amdgcn_mfma_f32_16x16x32_bf16(Bt[n][k], At[m][k], acc[ai][bj][m][n], 0, 0, 0); __builtin_amdgcn_s_setprio(0); } while (0)
#define PG8_WAIT_V(n) asm volatile("s_waitcnt vmcnt(" #n ")" ::: "memory")
#define PG8_WAIT_L(n) asm volatile("s_waitcnt lgkmcnt(" #n ")" ::: "memory")
#define PG8_BAR __builtin_amdgcn_s_barrier()
#define PG8_SCHED __builtin_amdgcn_sched_barrier(0)
    Unit cur, nxt; int ui = 0;
    if (!S.next(0, cur)) return;
    f32x4 acc[2][2][4][2];
#pragma unroll
    for (int a = 0; a < 2; ++a)
#pragma unroll
        for (int b = 0; b < 2; ++b)
#pragma unroll
            for (int m = 0; m < 4; ++m)
#pragma unroll
                for (int n = 0; n < 2; ++n) acc[a][b][m][n] = (f32x4){0.f, 0.f, 0.f, 0.f};
    bf16x8 At[4][2], B0[2][2], B1[2][2];
    const char* cA = (const char*)g.A + (size_t)cur.pm * tstep; const char* cB = (const char*)g.Bt + (size_t)cur.pn * tstep;
    S.a_ready(cur);
    PG8_STAGE(PG8_SB(0, 0), cB, voffB); PG8_STAGE(PG8_SA(0, 0), cA, voffA); PG8_STAGE(PG8_SB(0, 1), cB + hstep, voffB); PG8_STAGE(PG8_SA(0, 1), cA + hstep, voffA);
    if (wr == 1) PG8_BAR;
    PG8_WAIT_V(4); PG8_BAR;
    PG8_STAGE(PG8_SB(1, 0), cB + kstep, voffB); PG8_STAGE(PG8_SA(1, 0), cA + kstep, voffA); PG8_STAGE(PG8_SB(1, 1), cB + hstep + kstep, voffB);
    PG8_WAIT_V(6); PG8_BAR;
    PG8_STAMP();
    for (;;) {
        const bool has_next = S.next(ui + 1, nxt);
        const char* nA = has_next ? (const char*)g.A + (size_t)nxt.pm * tstep : cA; const char* nB = has_next ? (const char*)g.Bt + (size_t)nxt.pn * tstep : cB;
        for (int t = 0; t < nt; t += 2) {
            const bool last = (t == nt - 2);
            const char* a1 = cA + (size_t)(t + 1) * kstep;
            const char* a2 = last ? nA : cA + (size_t)(t + 2) * kstep; const char* b2 = last ? nB : cB + (size_t)(t + 2) * kstep;
            const char* a3 = a2 + kstep; const char* b3 = b2 + kstep;
            if (last && has_next) S.a_ready(nxt);
            PG8_LDB(B0, 0, 0); PG8_SCHED; PG8_LDA(At, 0, 0); PG8_STAGE(PG8_SA(1, 1), a1 + hstep, voffA);
            PG8_WAIT_L(8); PG8_BAR; PG8_WAIT_L(0); PG8_MMA(0, 0, At, B0); PG8_BAR; PG8_SCHED;
            PG8_LDB(B1, 0, 1); PG8_STAGE(PG8_SB(0, 0), b2, voffB);
            PG8_BAR; PG8_WAIT_L(0); PG8_MMA(0, 1, At, B1); PG8_BAR;
            PG8_LDA(At, 0, 1); PG8_STAGE(PG8_SA(0, 0), a2, voffA);
            PG8_BAR; PG8_WAIT_L(0); PG8_MMA(1, 0, At, B0); PG8_BAR; PG8_SCHED;
            PG8_STAGE(PG8_SB(0, 1), b2 + hstep, voffB);
            PG8_WAIT_V(6); PG8_BAR; PG8_MMA(1, 1, At, B1); PG8_BAR;
            PG8_LDB(B0, 1, 0); PG8_SCHED; PG8_LDA(At, 1, 0); PG8_STAGE(PG8_SA(0, 1), a2 + hstep, voffA);
            PG8_WAIT_L(8); PG8_BAR; PG8_WAIT_L(0); PG8_MMA(0, 0, At, B0); PG8_BAR; PG8_SCHED;
            PG8_LDB(B1, 1, 1); PG8_STAGE(PG8_SB(1, 0), b3, voffB);
            PG8_BAR; PG8_WAIT_L(0); PG8_MMA(0, 1, At, B1); PG8_BAR;
            PG8_LDA(At, 1, 1); PG8_STAGE(PG8_SA(1, 0), a3, voffA);
            PG8_BAR; PG8_WAIT_L(0); PG8_MMA(1, 0, At, B0); PG8_BAR; PG8_SCHED;
            PG8_STAGE(PG8_SB(1, 1), b3 + hstep, voffB);
            PG8_WAIT_V(6); PG8_BAR; PG8_MMA(1, 1, At, B1); PG8_BAR;
        }
        PG8_STAMP();
        if constexpr (!Epi::AFTER_DRAIN) { E(acc, cur, wr, wc, fr, fq); S.done(cur); }
        PG8_STAMP();
        if (!has_next) break;
#pragma unroll
        for (int a = 0; a < 2; ++a)
#pragma unroll
            for (int b = 0; b < 2; ++b)
#pragma unroll
                for (int m = 0; m < 4; ++m)
#pragma unroll
                    for (int n = 0; n < 2; ++n) acc[a][b][m][n] = (f32x4){0.f, 0.f, 0.f, 0.f};
        cur = nxt; cA = nA; cB = nB; ++ui;
    }
    PG8_WAIT_V(0);
    if (wr == 0) PG8_BAR;
    PG8_BAR;
    if constexpr (Epi::AFTER_DRAIN) { E.fused(acc, cur, wr, wc, fr, fq, lds, wid, lane); S.done(cur); }
    PG8_STAMP();
    if (STAMP && wid == 0) { stamps[lane] = lane < nts ? (((unsigned long long)(unsigned)ts_hi << 32) | (unsigned)ts_lo) : 0ull;
        if (lane == 62) stamps[62] = rt_entry; if (lane == 63) stamps[63] = (unsigned long long)wall_clock64(); }
#undef PG8_STAMP
#undef PG8_SA
#undef PG8_SB
#undef PG8_STAGE
#undef PG8_LDA
#undef PG8_LDB
#undef PG8_MMA
#undef PG8_WAIT_V
#undef PG8_WAIT_L
#undef PG8_BAR
#undef PG8_SCHED
}
}

using pg8::bf16x8; using pg8::f32x4; using pg8::u32x4;
typedef __bf16 bf16x2_t __attribute__((ext_vector_type(2)));
typedef float f32x2_t __attribute__((ext_vector_type(2)));
__device__ __forceinline__ unsigned cvt_pk_bf16(float lo, float hi) { f32x2_t f = {lo, hi}; bf16x2_t b = __builtin_convertvector(f, bf16x2_t); return __builtin_bit_cast(unsigned, b); }
typedef unsigned short u16;
typedef unsigned long long u64;
typedef unsigned u32x2 __attribute__((ext_vector_type(2)));
#define LAS __attribute__((address_space(3)))
#define DI __device__ __forceinline__

constexpr int T_ = 32768, D_ = 1024, DFF = 2816, NUP = 5632, NIN = 4608, SEQ = 8192;
constexpr float ALPHA = 1.41421356237309515f, LN_EPS = 1e-5f, LOG2E = 1.44269504088896f;
constexpr int NTHR = 512;
constexpr int LDS_MAIN = 155648, LDS_BYTES = LDS_MAIN + 16;

constexpr size_t SZ_WUP = (size_t)NUP * D_ * 2, SZ_WDN = (size_t)D_ * DFF * 2, SZ_WIN = (size_t)NIN * D_ * 2, SZ_WGLU = 512 * 512 * 2, SZ_WB = (size_t)1024 * 512 * 2, SZ_WOUT = (size_t)1024 * 1024 * 2;
constexpr size_t OFF_UP1 = 0, OFF_DN1 = OFF_UP1 + SZ_WUP, OFF_WIN = OFF_DN1 + SZ_WDN, OFF_GLU = OFF_WIN + SZ_WIN, OFF_WB0 = OFF_GLU + SZ_WGLU, OFF_WB1 = OFF_WB0 + SZ_WB,
                 OFF_WOUT = OFF_WB1 + SZ_WB, OFF_UP2 = OFF_WOUT + SZ_WOUT, OFF_DN2 = OFF_UP2 + SZ_WUP, SZ_LAYERW = OFF_DN2 + SZ_WDN;
constexpr size_t MiB = 1048576;
constexpr size_t SZ_TABL = 1024 * 1024;
constexpr size_t TAB_A1 = 0, TAB_A64 = 16384, TAB_BB = 32768, TAB_CT = 32768 + 262144, TAB_BBH = TAB_CT + 131072;
constexpr size_t WS_W = 0, WS_TAB = 2 * SZ_LAYERW, WS_XB = WS_TAB + 2 * SZ_TABL, WS_H = WS_XB + 64 * MiB, WS_GS = WS_H + 176 * MiB, WS_GA = WS_GS + 64 * MiB, WS_BAR = WS_GA + 64 * MiB, WS_STATS = WS_BAR + 65536, WS_END = WS_STATS + 262144;
constexpr size_t H_U = 0, H_Q = 32 * MiB, H_K = 64 * MiB, H_V = 96 * MiB, H_QI = 128 * MiB, H_KIB = 144 * MiB, H_WI = 146 * MiB, H_SLOC = 147 * MiB, H_MASK = 155 * MiB;
constexpr int MASK_PER_B = 33024;

struct Args { const float* in[24]; float* out; unsigned char* ws; int lo, hi; };

struct Frame {
    const float* const* in; float* out; unsigned char* ws;
    int tid, lane, wave;
};
#define FP(F, T, off) ((T*)((F).ws + (off)))
#define F_XB(F) FP(F, u16, WS_XB)
#define F_H(F) FP(F, u16, WS_H)
#define F_U(F) FP(F, u16, WS_H + H_U)
#define F_Q(F) FP(F, u16, WS_H + H_Q)
#define F_K(F) FP(F, u16, WS_H + H_K)
#define F_V(F) FP(F, u16, WS_H + H_V)
#define F_QI(F) FP(F, u16, WS_H + H_QI)
#define F_KIB(F) FP(F, u16, WS_H + H_KIB)
#define F_WI(F) FP(F, float, WS_H + H_WI)
#define F_SLOC(F) FP(F, float, WS_H + H_SLOC)
#define F_MASK(F) FP(F, u16, WS_H + H_MASK)
#define F_GS(F) FP(F, u16, WS_GS)
#define F_GA(F) FP(F, u16, WS_GA)
#define F_YS(F) FP(F, u16, WS_XB)
#define F_VT(F) FP(F, u16, WS_XB + 32 * MiB)

DI float bf_lo(unsigned u) { return __uint_as_float(u << 16); }
DI float bf_hi(unsigned u) { return __uint_as_float(u & 0xffff0000u); }
DI float fsigmoid(float x) { return __builtin_amdgcn_rcpf(1.0f + __expf(-x)); }
DI u32x4 pack8(const f32x4& a, const f32x4& b) { u32x4 w; w.x = cvt_pk_bf16(a[0], a[1]); w.y = cvt_pk_bf16(a[2], a[3]); w.z = cvt_pk_bf16(b[0], b[1]); w.w = cvt_pk_bf16(b[2], b[3]); return w; }
DI void unpack8(const u32x4& w, f32x4& a, f32x4& b) { a[0] = bf_lo(w.x); a[1] = bf_hi(w.x); a[2] = bf_lo(w.y); a[3] = bf_hi(w.y); b[0] = bf_lo(w.z); b[1] = bf_hi(w.z); b[2] = bf_lo(w.w); b[3] = bf_hi(w.w); }

struct EpiUp {
    static constexpr bool PERM = true, AFTER_DRAIN = false;
    u16* H;
    DI void operator()(const f32x4 (&acc)[2][2][4][2], const pg8::Unit& u, int wr, int wc, int fr, int fq) const {
        const int row0 = u.pm * 256 + wr * 64 + fr, col0 = u.pn * 128 + wc * 32 + 8 * fq;
#pragma unroll
        for (int ai = 0; ai < 2; ++ai)
#pragma unroll
            for (int m = 0; m < 4; ++m) {
                f32x4 o0, o1;
#pragma unroll
                for (int j = 0; j < 4; ++j) { const float g0 = acc[ai][0][m][0][j], g1 = acc[ai][0][m][1][j]; o0[j] = g0 * fsigmoid(g0) * acc[ai][1][m][0][j]; o1[j] = g1 * fsigmoid(g1) * acc[ai][1][m][1][j]; }
                *(u32x4*)(H + (size_t)(row0 + ai * 128 + m * 16) * DFF + col0) = pack8(o0, o1);
            }
    }
};
struct EpiRes {
    static constexpr bool PERM = false, AFTER_DRAIN = false;
    const float* R; float* Y; float sc; const f32x2_t* st; const float* g; const float* b;
    DI void operator()(const f32x4 (&acc)[2][2][4][2], const pg8::Unit& u, int wr, int wc, int fr, int fq) const {
        const int row0 = u.pm * 256 + wr * 64 + fr, col0 = u.pn * 256 + wc * 32 + 4 * fq;
#pragma unroll
        for (int ai = 0; ai < 2; ++ai)
#pragma unroll
            for (int m = 0; m < 4; ++m) { const int row = row0 + ai * 128 + m * 16; const size_t off = (size_t)row * D_ + col0;
                f32x2_t sr = {0.f, 1.f}; if (st) sr = st[row];
#pragma unroll
                for (int bj = 0; bj < 2; ++bj)
#pragma unroll
                    for (int n = 0; n < 2; ++n) { f32x4 r = *(const f32x4*)(R + off + bj * 128 + n * 16);
                        if (st) { const f32x4 gv = *(const f32x4*)(g + col0 + bj * 128 + n * 16), bv = *(const f32x4*)(b + col0 + bj * 128 + n * 16); r = (r - sr.x) * sr.y * gv + bv; }
                        *(f32x4*)(Y + off + bj * 128 + n * 16) = r * ALPHA + acc[ai][bj][m][n] * sc; }
                asm volatile("" ::: "memory"); }
    }
};
struct EpiIn {
    static constexpr bool PERM = true, AFTER_DRAIN = false;
    unsigned char* ws;
    DI void operator()(const f32x4 (&acc)[2][2][4][2], const pg8::Unit& u, int wr, int wc, int fr, int fq) const {
        const int row0 = u.pm * 256 + wr * 64 + fr, cl = wc * 32 + 8 * fq, pn = u.pn;
        size_t boff; int ld, c0;
        if (pn < 8) { boff = WS_H + (size_t)(pn >> 1) * (32 * MiB); ld = 512; c0 = (pn & 1) * 256; }
        else if (pn == 8) { boff = WS_H + H_QI; ld = 256; c0 = 0; }
        else if (pn == 9) { boff = WS_H + H_KIB; ld = 32; c0 = 0; }
        else { boff = WS_GS + (size_t)((pn - 10) >> 2) * (64 * MiB); ld = 1024; c0 = ((pn - 10) & 3) * 256; }
        u16* base = (u16*)(ws + boff); float* WI = (float*)(ws + WS_H + H_WI);
#pragma unroll
        for (int ai = 0; ai < 2; ++ai)
#pragma unroll
            for (int m = 0; m < 4; ++m) { const size_t row = (size_t)(row0 + ai * 128 + m * 16);
#pragma unroll
                for (int bj = 0; bj < 2; ++bj) { const int c = bj * 128 + cl; f32x4 v0 = acc[ai][bj][m][0], v1 = acc[ai][bj][m][1];
                    if (pn == 9) { if (c < 32) *(u32x4*)(base + row * 32 + c) = pack8(v0, v1); else if (c == 32) { *(f32x4*)(WI + row * 8) = v0; *(f32x4*)(WI + row * 8 + 4) = v1; } }
                    else { if (pn >= 10) {
#pragma unroll
                            for (int j = 0; j < 4; ++j) { v0[j] = fsigmoid(v0[j]); v1[j] = fsigmoid(v1[j]); } }
                        *(u32x4*)(base + row * ld + c0 + c) = pack8(v0, v1); } } }
    }
};
template <int MODE> struct EpiMix {
    static constexpr bool PERM = true, AFTER_DRAIN = false;
    const u16* A; const u16* Bsrc; u16* O; int ldc;
    DI void operator()(const f32x4 (&acc)[2][2][4][2], const pg8::Unit& u, int wr, int wc, int fr, int fq) const {
        const int row0 = u.pm * 256 + wr * 64 + fr, col0 = u.pn * 256 + wc * 32 + 8 * fq;
#pragma unroll
        for (int ai = 0; ai < 2; ++ai)
#pragma unroll
            for (int m = 0; m < 4; ++m) { const size_t off = (size_t)(row0 + ai * 128 + m * 16) * ldc + col0;
#pragma unroll
                for (int bj = 0; bj < 2; ++bj) { f32x4 v0 = acc[ai][bj][m][0], v1 = acc[ai][bj][m][1], a0, a1;
                    const u32x4 aw = *(const u32x4*)(A + off + bj * 128); unpack8(aw, a0, a1);
                    if (MODE == 0) {
#pragma unroll
                        for (int j = 0; j < 4; ++j) { v0[j] = a0[j] * fsigmoid(v0[j]); v1[j] = a1[j] * fsigmoid(v1[j]); } }
                    else if (MODE == 1) { v0 = a0 * v0; v1 = a1 * v1; }
                    else { f32x4 b0, b1; const u32x4 bw = *(const u32x4*)(Bsrc + off + bj * 128); unpack8(bw, b0, b1); v0 = b0 + a0 * v0; v1 = b1 + a1 * v1; }
                    *(u32x4*)(O + off + bj * 128) = pack8(v0, v1); } }
    }
};

template <class Epi> DI void run_gemm(LAS unsigned char* lds, const u16* A, const u16* Bt, int N, int K, const Epi& E) {
    pg8::Gemm g{A, Bt, T_, N, K}; pg8::StaticOrder S; S.init(T_, N, (int)gridDim.x, (int)blockIdx.x);
    pg8::gemm_phase<Epi, pg8::StaticOrder, false>(lds, g, S, E, nullptr);
    __syncthreads();
}

DI int srccol(int map, int n) {
    if (map == 0) return n;
    if (map == 1) { const int pn = n >> 8, r = n & 255; return r < 128 ? 128 * pn + r : DFF + 128 * pn + (r - 128); }
    return n < 2344 ? n : (n < 2560 ? -1 : n - 216);
}
DI void tconv(LAS float* tl  , const float* src, int Nsrc, int K, u16* dst, int Np, int map, int tid) {
    const int tilesN = Np >> 6, tilesK = K >> 6, ntile = tilesN * tilesK;
    for (int t0 = blockIdx.x * 2; t0 < ntile; t0 += gridDim.x * 2) {
        const bool hb = t0 + 1 < ntile; float va[8], vb[8];
        const int c = tid & 63, r0 = tid >> 6;
        { const int tn = t0 % tilesN, tk = t0 / tilesN; const int sc = srccol(map, tn * 64 + c);
#pragma unroll
          for (int rr = 0; rr < 8; ++rr) va[rr] = sc >= 0 ? src[(size_t)(tk * 64 + r0 + 8 * rr) * Nsrc + sc] : 0.f; }
        if (hb) { const int tn = (t0 + 1) % tilesN, tk = (t0 + 1) / tilesN; const int sc = srccol(map, tn * 64 + c);
#pragma unroll
          for (int rr = 0; rr < 8; ++rr) vb[rr] = sc >= 0 ? src[(size_t)(tk * 64 + r0 + 8 * rr) * Nsrc + sc] : 0.f; }
#pragma unroll
        for (int rr = 0; rr < 8; ++rr) { tl[(r0 + 8 * rr) * 65 + c] = va[rr]; if (hb) tl[64 * 65 + (r0 + 8 * rr) * 65 + c] = vb[rr]; }
        __syncthreads();
        { const int kk2 = (tid & 31) * 2, n0 = tid >> 5;
#pragma unroll
          for (int h = 0; h < 2; ++h) { if (h == 1 && !hb) break; const int t = t0 + h, tn = t % tilesN, tk = t / tilesN; LAS float* tt = tl + h * 64 * 65;
#pragma unroll
            for (int rr = 0; rr < 4; ++rr) { const int n = n0 + 16 * rr; *(unsigned*)(dst + (size_t)(tn * 64 + n) * K + tk * 64 + kk2) = cvt_pk_bf16(tt[kk2 * 65 + n], tt[(kk2 + 1) * 65 + n]); } } }
        __syncthreads();
    }
}
DI void ssm_tables(const Frame& F, int l, int g, int p) {
    unsigned char* tab = F.ws + WS_TAB + (size_t)l * SZ_TABL;
    const int lg = l * 32 + g;
    const double lr = fmin((double)F.in[6][lg * 64 + p], -1e-4), li = (double)F.in[7][lg * 64 + p], dt = exp((double)F.in[8][lg]);
    const double zr = lr * dt, zi = li * dt, ea = exp(zr);
    double ar = ea * cos(zi), ai = ea * sin(zi);
    const double nr = ar - 1.0, ni = ai, den = lr * lr + li * li, fr_ = (nr * lr + ni * li) / den, fi_ = (ni * lr - nr * li) / den;
    ((float*)(tab + TAB_A1))[(g * 64 + p) * 2] = (float)ar; ((float*)(tab + TAB_A1))[(g * 64 + p) * 2 + 1] = (float)ai;
    double pr = ar, pi = ai;
#pragma unroll 1
    for (int s = 0; s < 6; ++s) { const double t = pr * pr - pi * pi; pi = 2.0 * pr * pi; pr = t; }
    ((float*)(tab + TAB_A64))[(g * 64 + p) * 2] = (float)pr; ((float*)(tab + TAB_A64))[(g * 64 + p) * 2 + 1] = (float)pi;
    float* BB = (float*)(tab + TAB_BB) + (size_t)g * 32 * 64;
    const float* bre = F.in[9] + ((size_t)lg * 64 + p) * 16; const float* bim = F.in[10] + ((size_t)lg * 64 + p) * 16;
    u16* BBH = (u16*)(tab + TAB_BBH) + (size_t)g * 128 * 16;
#pragma unroll 1
    for (int h = 0; h < 16; ++h) { const double br = bre[h], bi = bim[h]; const float vr = (float)(fr_ * br - fi_ * bi), vi = (float)(fr_ * bi + fi_ * br); BB[(2 * h) * 64 + p] = vr; BB[(2 * h + 1) * 64 + p] = vi;
        const unsigned pk = cvt_pk_bf16(vr, vi); BBH[(2 * p) * 16 + h] = (u16)(pk & 0xffffu); BBH[(2 * p + 1) * 16 + h] = (u16)(pk >> 16); }
    u16* CT = (u16*)(tab + TAB_CT) + (size_t)g * 16 * 128;
    const float* cre = F.in[11] + (size_t)lg * 16 * 64; const float* cim = F.in[12] + (size_t)lg * 16 * 64;
#pragma unroll 1
    for (int h = 0; h < 16; ++h) { *(unsigned*)(CT + h * 128 + 2 * p) = cvt_pk_bf16(cre[h * 64 + p], -cim[h * 64 + p]); }
}
DI void p0_phase(const Frame& F, LAS unsigned char* lds) {
    LAS float* tl = (LAS float*)lds;
    for (int l = 0; l < 2; ++l) {
        unsigned char* wl = F.ws + WS_W + (size_t)l * SZ_LAYERW;
        tconv(tl, F.in[1] + (size_t)l * D_ * NUP, NUP, D_, (u16*)(wl + OFF_UP1), NUP, 1, F.tid);
        tconv(tl, F.in[2] + (size_t)l * DFF * D_, D_, DFF, (u16*)(wl + OFF_DN1), D_, 0, F.tid);
        tconv(tl, F.in[5] + (size_t)l * D_ * 4392, 4392, D_, (u16*)(wl + OFF_WIN), NIN, 2, F.tid);
        tconv(tl, F.in[14] + (size_t)l * 512 * 512, 512, 512, (u16*)(wl + OFF_GLU), 512, 0, F.tid);
        tconv(tl, F.in[15] + (size_t)(l * 2 + 0) * 512 * 1024, 1024, 512, (u16*)(wl + OFF_WB0), 1024, 0, F.tid);
        tconv(tl, F.in[15] + (size_t)(l * 2 + 1) * 512 * 1024, 1024, 512, (u16*)(wl + OFF_WB1), 1024, 0, F.tid);
        tconv(tl, F.in[16] + (size_t)l * 1024 * 1024, 1024, 1024, (u16*)(wl + OFF_WOUT), 1024, 0, F.tid);
        tconv(tl, F.in[19] + (size_t)l * D_ * NUP, NUP, D_, (u16*)(wl + OFF_UP2), NUP, 1, F.tid);
        tconv(tl, F.in[20] + (size_t)l * DFF * D_, D_, DFF, (u16*)(wl + OFF_DN2), D_, 0, F.tid);
    }
    { const size_t n4 = (size_t)T_ * D_ / 4, step = (size_t)gridDim.x * NTHR; const f32x4* x4 = (const f32x4*)F.in[0]; u32x2* o = (u32x2*)F_XB(F);
      for (size_t i = (size_t)blockIdx.x * NTHR + F.tid; i < n4; i += 4 * step) { f32x4 v[4];
#pragma unroll
          for (int j = 0; j < 4; ++j) if (i + j * step < n4) v[j] = x4[i + j * step];
#pragma unroll
          for (int j = 0; j < 4; ++j) if (i + j * step < n4) { u32x2 w; w.x = cvt_pk_bf16(v[j][0], v[j][1]); w.y = cvt_pk_bf16(v[j][2], v[j][3]); o[i + j * step] = w; } } }
    { const int gw = blockIdx.x * 8 + F.wave; if (gw < 64) ssm_tables(F, gw >> 5, gw & 31, F.lane); }
}

DI float wave_sum(float v) {
#pragma unroll
    for (int o = 32; o >= 1; o >>= 1) v += __shfl_xor(v, o);
    return v;
}
DI void ln_phase(const Frame& F, const float* g, const float* b, bool final) {
    const int lane = F.lane; f32x4 gv[4], bv[4];
#pragma unroll
    for (int i = 0; i < 4; ++i) { gv[i] = *(const f32x4*)(g + i * 256 + lane * 4); bv[i] = *(const f32x4*)(b + i * 256 + lane * 4); }
    const int stride = gridDim.x * 8; f32x2_t* stats = (f32x2_t*)(F.ws + WS_STATS);
    for (int row0 = blockIdx.x * 8 + F.wave; row0 < T_; row0 += 2 * stride) {
        const int row1 = row0 + stride < T_ ? row0 + stride : row0;
        float* p0 = F.out + (size_t)row0 * D_; float* p1 = F.out + (size_t)row1 * D_; f32x4 v[4], u[4]; float s0 = 0.f, s1 = 0.f;
#pragma unroll
        for (int i = 0; i < 4; ++i) { v[i] = *(const f32x4*)(p0 + i * 256 + lane * 4); u[i] = *(const f32x4*)(p1 + i * 256 + lane * 4); }
#pragma unroll
        for (int i = 0; i < 4; ++i) { s0 += (v[i][0] + v[i][1]) + (v[i][2] + v[i][3]); s1 += (u[i][0] + u[i][1]) + (u[i][2] + u[i][3]); }
        const float mean0 = wave_sum(s0) * (1.0f / 1024.0f), mean1 = wave_sum(s1) * (1.0f / 1024.0f); float q0 = 0.f, q1 = 0.f;
#pragma unroll
        for (int i = 0; i < 4; ++i) { v[i] = v[i] - mean0; u[i] = u[i] - mean1; q0 += (v[i][0] * v[i][0] + v[i][1] * v[i][1]) + (v[i][2] * v[i][2] + v[i][3] * v[i][3]); q1 += (u[i][0] * u[i][0] + u[i][1] * u[i][1]) + (u[i][2] * u[i][2] + u[i][3] * u[i][3]); }
        const float rstd0 = rsqrtf(wave_sum(q0) * (1.0f / 1024.0f) + LN_EPS), rstd1 = rsqrtf(wave_sum(q1) * (1.0f / 1024.0f) + LN_EPS);
        if (!final && lane == 0) { stats[row0] = (f32x2_t){mean0, rstd0}; if (row1 != row0) stats[row1] = (f32x2_t){mean1, rstd1}; }
#pragma unroll
        for (int i = 0; i < 4; ++i) { const f32x4 y = v[i] * rstd0 * gv[i] + bv[i]; if (final) *(f32x4*)(p0 + i * 256 + lane * 4) = y;
            else { u32x2 w; w.x = cvt_pk_bf16(y[0], y[1]); w.y = cvt_pk_bf16(y[2], y[3]); *(u32x2*)(F_XB(F) + (size_t)row0 * D_ + i * 256 + lane * 4) = w; } }
        if (row1 != row0) {
#pragma unroll
            for (int i = 0; i < 4; ++i) { const f32x4 y = u[i] * rstd1 * gv[i] + bv[i]; if (final) *(f32x4*)(p1 + i * 256 + lane * 4) = y;
                else { u32x2 w; w.x = cvt_pk_bf16(y[0], y[1]); w.y = cvt_pk_bf16(y[2], y[3]); *(u32x2*)(F_XB(F) + (size_t)row1 * D_ + i * 256 + lane * 4) = w; } } }
    }
}

DI void wave_lds_fence() { asm volatile("s_waitcnt lgkmcnt(0)" ::: "memory"); __builtin_amdgcn_wave_barrier(); }
DI float gelu_tanh(float x) { const float z = 0.7978845608028654f * (x + 0.044715f * x * x * x); return x * __builtin_amdgcn_rcpf(1.0f + __expf(-2.0f * z)); }

DI void vt_tile(const Frame& F, LAS unsigned char* wl, int tile) {
    LAS u16* tb = (LAS u16*)wl;
    const int tt = tile >> 3, hb = tile & 7, lane = F.lane; const int t0 = tt * 64;
    const u16* src = F_V(F) + (size_t)(t0 + lane) * 512 + hb * 64;
#pragma unroll
    for (int c = 0; c < 8; ++c) *(LAS u32x4*)(tb + lane * 72 + c * 8) = *(const u32x4*)(src + c * 8);
    wave_lds_fence();
    const int b = t0 >> 13, tl = t0 & 8191;
    u16* dst = F_VT(F) + ((size_t)(b * 512 + hb * 64 + lane)) * SEQ + tl;
#pragma unroll
    for (int c = 0; c < 8; ++c) { u32x4 w; unsigned e[8];
#pragma unroll
        for (int j = 0; j < 8; ++j) e[j] = tb[(c * 8 + j) * 72 + lane];
        w.x = e[0] | (e[1] << 16); w.y = e[2] | (e[3] << 16); w.z = e[4] | (e[5] << 16); w.w = e[6] | (e[7] << 16);
        *(u32x4*)(dst + c * 8) = w; }
    wave_lds_fence();
}
struct SsmP { float ar, ai, cr, ci; };
DI void ssm_load_g(const unsigned char* tab, const float* dskip, int g, int lane, float& ar, float& ai, float& cr, float& ci, bf16x8 (&af)[8], bf16x8 (&cf)[4], f32x4& dv) {
    ar = ((const float*)(tab + TAB_A1))[(g * 64 + lane) * 2]; ai = ((const float*)(tab + TAB_A1))[(g * 64 + lane) * 2 + 1];
    cr = ((const float*)(tab + TAB_A64))[(g * 64 + lane) * 2]; ci = ((const float*)(tab + TAB_A64))[(g * 64 + lane) * 2 + 1];
    const int lq = lane & 15, g4 = lane >> 4;
    const u16* BBH = (const u16*)(tab + TAB_BBH) + (size_t)g * 128 * 16;
#pragma unroll
    for (int mt = 0; mt < 8; ++mt) { const u32x4 z = {0u, 0u, 0u, 0u}; af[mt] = g4 < 2 ? *(const bf16x8*)(BBH + (mt * 16 + lq) * 16 + g4 * 8) : __builtin_bit_cast(bf16x8, z); }
    const u16* CT = (const u16*)(tab + TAB_CT) + (size_t)g * 16 * 128;
#pragma unroll
    for (int ks = 0; ks < 4; ++ks) cf[ks] = *(const bf16x8*)(CT + lq * 128 + ks * 32 + g4 * 8);
    dv = *(const f32x4*)(dskip + g * 16 + g4 * 4);
}
DI void ssm_bu_tile(const Frame& F, LAS unsigned* bt  , int t0, int g, const bf16x8 (&af)[8], int lq, int g4) {
    bf16x8 bf[4];
#pragma unroll
    for (int nt = 0; nt < 4; ++nt) { const u32x4 z = {0u, 0u, 0u, 0u}; bf[nt] = g4 < 2 ? *(const bf16x8*)(F_U(F) + (size_t)(t0 + nt * 16 + lq) * 512 + g * 16 + g4 * 8) : __builtin_bit_cast(bf16x8, z); }
#pragma unroll
    for (int nt = 0; nt < 4; ++nt)
#pragma unroll
        for (int mt = 0; mt < 8; ++mt) { const f32x4 z = {0.f, 0.f, 0.f, 0.f}; const f32x4 acc = __builtin_amdgcn_mfma_f32_16x16x32_bf16(af[mt], bf[nt], z, 0, 0, 0);
            u32x2 w; w.x = cvt_pk_bf16(acc[0], acc[1]); w.y = cvt_pk_bf16(acc[2], acc[3]);
            *(LAS u32x2*)(bt + (nt * 16 + lq) * 68 + mt * 8 + g4 * 2) = w; }
}
DI void ssmA_item(const Frame& F, LAS unsigned char* wl, int item, const float ar, const float ai, const bf16x8 (&af)[8]) {
    LAS unsigned* bt = (LAS unsigned*)wl;
    const int chunk = item >> 5, g = item & 31, lane = F.lane; const int t0 = chunk * 64;
    ssm_bu_tile(F, bt, t0, g, af, lane & 15, lane >> 4);
    wave_lds_fence();
    float sr = 0.f, si = 0.f;
#pragma unroll 8
    for (int j = 0; j < 64; ++j) { const unsigned w = bt[j * 68 + lane]; const float br = bf_lo(w), bi = bf_hi(w);
        const float nr = ar * sr - ai * si + br, ni = ar * si + ai * sr + bi; sr = nr; si = ni; }
    *(float2*)(F_SLOC(F) + ((size_t)item * 64 + lane) * 2) = make_float2(sr, si);
    wave_lds_fence();
}
DI void ssmC_item(const Frame& F, LAS unsigned char* wl, int item, const float ar, const float ai, const float cr, const float ci, const bf16x8 (&af)[8], const bf16x8 (&cf)[4], const f32x4 dv) {
    LAS u16* ut = (LAS u16*)wl;
    LAS unsigned* st = (LAS unsigned*)(wl + 2048);
    const int chunk = item >> 5, g = item & 31, lane = F.lane, lq = lane & 15, g4 = lane >> 4; const int t0 = chunk * 64;
    { const u16* up = F_U(F) + (size_t)(t0 + lane) * 512 + g * 16; const u32x4 a = *(const u32x4*)up, b = *(const u32x4*)(up + 8);
      *(LAS u32x4*)(ut + lane * 16) = a; *(LAS u32x4*)(ut + lane * 16 + 8) = b; }
    float sr = 0.f, si = 0.f;
    { const int cin = chunk & 127, c0 = chunk - cin; const float2* sl = (const float2*)F_SLOC(F) + ((size_t)c0 * 32 + g) * 64 + lane;
#pragma unroll 8
      for (int c = 0; c < cin; ++c) { const float2 v = sl[(size_t)c * 32 * 64]; const float nr = cr * sr - ci * si + v.x, ni = cr * si + ci * sr + v.y; sr = nr; si = ni; } }
    ssm_bu_tile(F, st, t0, g, af, lq, g4);
    wave_lds_fence();
#pragma unroll 8
    for (int j = 0; j < 64; ++j) { const unsigned w = st[j * 68 + lane]; const float br = bf_lo(w), bi = bf_hi(w);
        const float nr = ar * sr - ai * si + br, ni = ar * si + ai * sr + bi; sr = nr; si = ni;
        st[j * 68 + lane] = cvt_pk_bf16(sr, si); }
    wave_lds_fence();
#pragma unroll
    for (int mt = 0; mt < 4; ++mt) {
        f32x4 acc = {0.f, 0.f, 0.f, 0.f};
#pragma unroll
        for (int ks = 0; ks < 4; ++ks) { const bf16x8 sf = *(LAS bf16x8*)(st + (mt * 16 + lq) * 68 + ks * 16 + g4 * 4); acc = __builtin_amdgcn_mfma_f32_16x16x32_bf16(cf[ks], sf, acc, 0, 0, 0); }
        const int l = mt * 16 + lq; const u32x2 uw = *(LAS u32x2*)(ut + l * 16 + g4 * 4);
        const float u0 = bf_lo(uw.x), u1 = bf_hi(uw.x), u2 = bf_lo(uw.y), u3 = bf_hi(uw.y);
        u32x2 o; o.x = cvt_pk_bf16(gelu_tanh(acc[0] + dv[0] * u0), gelu_tanh(acc[1] + dv[1] * u1)); o.y = cvt_pk_bf16(gelu_tanh(acc[2] + dv[2] * u2), gelu_tanh(acc[3] + dv[3] * u3));
        *(u32x2*)(F_U(F) + (size_t)(t0 + l) * 512 + g * 16 + g4 * 4) = o;
    }
    wave_lds_fence();
}

DI unsigned fkey(float x) { const int u = __float_as_int(x + 0.0f); return (unsigned)u ^ ((unsigned)(u >> 31) | 0x80000000u); }
DI f32x4 idx_scores(const bf16x8 af, const bf16x8 (&qf)[8], const float (&w)[8]) {
    f32x4 a[8];
#pragma unroll
    for (int h = 0; h < 8; ++h) { const f32x4 z = {0.f, 0.f, 0.f, 0.f}; a[h] = __builtin_amdgcn_mfma_f32_16x16x32_bf16(af, qf[h], z, 0, 0, 0); }
    f32x2_t s01 = {0.f, 0.f}, s23 = {0.f, 0.f};
#pragma unroll
    for (int h = 0; h < 8; ++h) {
        const float r0 = __int_as_float(max(__float_as_int(a[h][0]), 0)), r1 = __int_as_float(max(__float_as_int(a[h][1]), 0));
        const float r2 = __int_as_float(max(__float_as_int(a[h][2]), 0)), r3 = __int_as_float(max(__float_as_int(a[h][3]), 0));
        const f32x2_t ww = {w[h], w[h]}; s01 = __builtin_elementwise_fma(ww, (f32x2_t){r0, r1}, s01); s23 = __builtin_elementwise_fma(ww, (f32x2_t){r2, r3}, s23);
    }
    return (f32x4){s01[0], s01[1], s23[0], s23[1]};
}
DI void idx_load4(bf16x8 (&af)[4], const u16* kib, int kb, unsigned voff) {
    const char* p = (const char*)(kib + (size_t)kb * 64 * 32);
#pragma unroll
    for (int st = 0; st < 4; ++st) af[st] = __builtin_bit_cast(bf16x8, *(const u32x4*)(p + st * 1024 + voff));
}
DI unsigned wave_usum(unsigned v) {
#pragma unroll
    for (int o = 32; o >= 1; o >>= 1) v += (unsigned)__shfl_xor((int)v, o);
    return v;
}
DI unsigned wave_suffix(unsigned c, int lane) {
    unsigned s = c;
#pragma unroll
    for (int off = 1; off < 64; off <<= 1) { const unsigned t = __shfl_down(s, off); if (lane + off < 64) s += t; }
    return s;
}
constexpr int HS = 2052;
DI bool idx_select(LAS unsigned* hist, LAS unsigned* rpre, LAS unsigned* rneed, int row, int lane, int dbits, unsigned& ne_out) {
    LAS unsigned* h = hist + row * HS; unsigned c = 0;
#pragma unroll
    for (int j = 0; j < 8; ++j) { const u32x4 v = *(LAS u32x4*)(h + lane * 32 + j * 4); c += (v.x & 0xffffu) + (v.x >> 16) + (v.y & 0xffffu) + (v.y >> 16) + (v.z & 0xffffu) + (v.z >> 16) + (v.w & 0xffffu) + (v.w >> 16); }
    const unsigned s = wave_suffix(c, lane), need = rneed[row];
    const u64 bal = __ballot(s >= need); const int L = 63 - __clzll(bal);
    const unsigned cum_hi = __shfl(s - c, L);
    const unsigned v = ((LAS u16*)h)[L * 64 + lane];
    const unsigned s2 = wave_suffix(v, lane);
    const u64 bal2 = __ballot(cum_hi + s2 >= need); const int l2 = 63 - __clzll(bal2);
    const unsigned cum = __shfl(cum_hi + s2 - v, l2), ne = __shfl(v, l2), nn = need - cum;
    if (lane == 0) { rpre[row] = (rpre[row] << dbits) | (unsigned)(L * 64 + l2); rneed[row] = nn; }
    ne_out = ne;
    return nn < ne;
}
#ifndef REPM
#define REPM 0
#endif
DI void idx_phase(const Frame& F, LAS unsigned char* lds) {
    LAS unsigned* hist = (LAS unsigned*)lds;
    LAS unsigned* rpre = (LAS unsigned*)(lds + 16 * HS * 4);
    LAS unsigned* rneed = rpre + 16; LAS unsigned* rcut = rpre + 32; LAS unsigned* rp3 = rpre + 48; LAS unsigned* flags = rpre + 64;
    LAS unsigned* lcnt = rpre + 80; LAS unsigned* lkey = hist; LAS unsigned* lidx = hist + 4096;
    constexpr unsigned CAP6 = 512u; LAS unsigned* lkey6 = hist; LAS unsigned* lidx6 = hist + 8192; LAS u16* lmask = (LAS u16*)(hist + 16384);
    const int tid = F.tid, lane = F.lane, wave = F.wave, lq = lane & 15, g4 = lane >> 4;
    const unsigned voff = (unsigned)(lq * 64 + g4 * 16);
    for (int pair = blockIdx.x; pair < 256; pair += gridDim.x) {
        const int b = pair >> 6, jj = pair & 63;
        const u16* kib = F_KIB(F) + (size_t)b * SEQ * 32;
#pragma unroll 1
        for (int it = 0; it < 8; ++it) {
            const int which = it >> 2, sub = it & 3, tile = which ? 127 - jj : jj, nkb = tile + 1;
            const size_t tq = (size_t)b * SEQ + tile * 64 + sub * 16 + lq;
            bf16x8 qf[8]; float w[8];
#pragma unroll
            for (int h = 0; h < 8; ++h) qf[h] = *(const bf16x8*)(F_QI(F) + tq * 256 + h * 32 + g4 * 8);
            { const f32x4 w0 = *(const f32x4*)(F_WI(F) + tq * 8), w1 = *(const f32x4*)(F_WI(F) + tq * 8 + 4);
#pragma unroll
              for (int i = 0; i < 4; ++i) { w[i] = w0[i]; w[4 + i] = w1[i]; } }
            const size_t mbase = (size_t)b * MASK_PER_B + (size_t)(tile + 1) * (2 * tile + sub);
            if (tid < 16) { rpre[tid] = 0u; rneed[tid] = 256u; rcut[tid] = 0x7fffffffu; rp3[tid] = 0u; }
            if (tid == 0) { flags[0] = 0u; flags[1] = 0u; flags[2] = 0u; }
            int mode = nkb > 4 ? 1 : 4; bool rep_done = false; (void)rep_done;
#pragma unroll 1
            while (true) {
                if (mode < 3) { for (int i = tid; i < 4 * HS; i += NTHR) ((LAS u32x4*)hist)[i] = (u32x4){0u, 0u, 0u, 0u}; }
                if ((mode == 3 || mode == 6) && tid < 16) lcnt[tid] = 0u;
                __syncthreads();
                unsigned thr = 0u, cut = 0x7fffffffu, pre = rpre[lq], rem = rneed[lq], mycut = 0x7fffffffu; const bool p3 = rp3[lq] != 0u, need_res = rcut[lq] == 0xffffffffu;
                const unsigned st3 = rp3[lq]; unsigned tsh = 8u;
                if (mode == 4 && nkb > 4) { thr = pre; if (st3 != 0u) cut = rcut[lq]; if (st3 == 1u) tsh = 0u; }
                const u64 tcomp = ((u64)thr << 32) | (u64)(~cut);
                const int kb0 = mode == 5 ? 0 : wave, kstep = mode == 5 ? 1 : 8;
                const unsigned dsh = mode == 1 ? 20u : 8u, psh = mode == 1 ? 32u : 20u;
                if (kb0 < nkb && (mode != 5 || wave == 0)) {
                    bf16x8 af[4], nf[4];
                    idx_load4(af, kib, kb0, voff);
                    __builtin_amdgcn_s_waitcnt(0x0F70);
#pragma unroll 1
                    for (int kb = kb0; kb < nkb; kb += kstep) {
                        if (kb + kstep < nkb) idx_load4(nf, kib, kb + kstep, voff);
                        unsigned bits = 0u;
#pragma unroll
                        for (int st = 0; st < 4; ++st) {
                            const f32x4 sc = idx_scores(af[st], qf, w);
                            unsigned key[4];
#pragma unroll
                            for (int i = 0; i < 4; ++i) key[i] = fkey(sc[i]);
                            if (mode == 4) {
#pragma unroll
                                for (int i = 0; i < 4; ++i) { const unsigned idx = (unsigned)(kb * 64 + st * 16 + g4 * 4 + i); const u64 comp = ((u64)(key[i] >> tsh) << 32) | (u64)(~idx); bits |= (comp >= tcomp ? 1u : 0u) << (st * 4 + i); }
                            } else if (mode == 5) {
                                int tie[4]; int any = 0;
#pragma unroll
                                for (int i = 0; i < 4; ++i) { tie[i] = (need_res && (key[i] >> 8) == pre) ? 1 : 0; any |= tie[i]; }
                                if (__any(any)) {
#pragma unroll
                                    for (int gg = 0; gg < 4; ++gg)
#pragma unroll
                                        for (int i = 0; i < 4; ++i) { const int f = (g4 == gg) ? tie[i] : 0; const int c = __shfl(f, gg * 16 + lq);
                                            if (c && rem > 0u) { --rem; if (rem == 0u) mycut = (unsigned)(kb * 64 + st * 16 + gg * 4 + i); } }
                                }
                            } else if (mode == 6) {
                                int m4 = 0;
#pragma unroll
                                for (int i = 0; i < 4; ++i) { const unsigned k12 = key[i] >> 20; bits |= (k12 > pre ? 1u : 0u) << (st * 4 + i); m4 |= (k12 == pre) ? (1 << i) : 0; }
                                if (__any(m4)) {
#pragma unroll
                                    for (int i = 0; i < 4; ++i) if ((m4 >> i) & 1) { const unsigned slot = __hip_atomic_fetch_add(lcnt + lq, 1u, __ATOMIC_RELAXED, __HIP_MEMORY_SCOPE_WORKGROUP);
                                        if (slot < CAP6) { lkey6[lq * CAP6 + slot] = key[i]; lidx6[lq * CAP6 + slot] = (unsigned)(kb * 64 + st * 16 + g4 * 4 + i); } }
                                }
                            } else if (mode == 3) {
                                int m4 = 0;
#pragma unroll
                                for (int i = 0; i < 4; ++i) m4 |= (p3 && (key[i] >> 8) == pre) ? (1 << i) : 0;
                                if (__any(m4)) {
#pragma unroll
                                    for (int i = 0; i < 4; ++i) if ((m4 >> i) & 1) { const unsigned slot = __hip_atomic_fetch_add(lcnt + lq, 1u, __ATOMIC_RELAXED, __HIP_MEMORY_SCOPE_WORKGROUP);
                                        if (slot < 256u) { lkey[lq * 256 + slot] = key[i]; lidx[lq * 256 + slot] = (unsigned)(kb * 64 + st * 16 + g4 * 4 + i); } }
                                }
                            } else if (mode == 1) {
#pragma unroll
                                for (int i = 0; i < 4; ++i) { const unsigned digit = key[i] >> 20;
                                    __hip_atomic_fetch_add(hist + lq * HS + (digit >> 1), 1u << ((digit & 1u) * 16), __ATOMIC_RELAXED, __HIP_MEMORY_SCOPE_WORKGROUP); }
                            } else {
#pragma unroll
                                for (int i = 0; i < 4; ++i) { const unsigned digit = (key[i] >> dsh) & 4095u; const bool ok = (unsigned)((u64)key[i] >> psh) == pre;
                                    __hip_atomic_fetch_add(hist + lq * HS + (digit >> 1), ok ? (1u << ((digit & 1u) * 16)) : 0u, __ATOMIC_RELAXED, __HIP_MEMORY_SCOPE_WORKGROUP); }
                            }
                            __builtin_amdgcn_sched_barrier(0);
                        }
                        if (mode == 4) F_MASK(F)[(mbase + kb) * 64 + lane] = (u16)(nkb > 4 ? bits : 0xffffu);
                        if (mode == 6) lmask[kb * 64 + lane] = (u16)bits;
#pragma unroll
                        for (int st = 0; st < 4; ++st) af[st] = nf[st];
                    }
                    if (mode == 5 && need_res && g4 == 0) rcut[lq] = mycut;
                }
                __syncthreads();
#if REPM
                if (mode == REPM && !rep_done) { rep_done = true; continue; }
#endif
                if (mode == 6) {
#pragma unroll 1
                    for (int r = 0; r < 2; ++r) { const int row = wave * 2 + r; const unsigned n = lcnt[row], need = rneed[row];
                        unsigned low[8], xi[8];
#pragma unroll
                        for (int c = 0; c < 8; ++c) { const unsigned e = (unsigned)(c * 64 + lane); const bool valid = e < n; low[c] = valid ? (lkey6[row * CAP6 + e] & 0xfffffu) + 1u : 0u; xi[c] = valid ? lidx6[row * CAP6 + e] : 0xffffffffu; }
                        unsigned t20 = 0u;
#pragma unroll 1
                        for (int bb = 20; bb >= 0; --bb) { const unsigned t = t20 | (1u << bb); unsigned cnt = 0u;
#pragma unroll
                            for (int c = 0; c < 8; ++c) cnt += (unsigned)__popcll(__ballot(low[c] >= t));
                            if (cnt >= need) t20 = t; }
                        unsigned cgt = 0u, ceq = 0u;
#pragma unroll
                        for (int c = 0; c < 8; ++c) { cgt += (unsigned)__popcll(__ballot(low[c] > t20)); ceq += (unsigned)__popcll(__ballot(low[c] == t20)); }
                        const unsigned need_eq = need - cgt; unsigned cut6 = 0x7fffffffu;
                        if (ceq > need_eq) {
                            unsigned cc = 0u;
#pragma unroll 1
                            for (int bb = 12; bb >= 0; --bb) { const unsigned t = cc | (1u << bb); unsigned cnt = 0u;
#pragma unroll
                                for (int c = 0; c < 8; ++c) cnt += (unsigned)__popcll(__ballot(low[c] == t20 && xi[c] < t));
                                if (cnt < need_eq) cc = t; }
                            cut6 = cc; }
#pragma unroll
                        for (int c = 0; c < 8; ++c) { if (low[c] != 0u && (low[c] > t20 || (low[c] == t20 && xi[c] <= cut6))) { const unsigned idx = xi[c];
                                const unsigned hw = (idx >> 6) * 64u + ((idx >> 2) & 3u) * 16u + (unsigned)row, bit = ((idx >> 4) & 3u) * 4u + (idx & 3u);
                                __hip_atomic_fetch_or((LAS unsigned*)lmask + (hw >> 1), 1u << (16u * (hw & 1u) + bit), __ATOMIC_RELAXED, __HIP_MEMORY_SCOPE_WORKGROUP); } }
                    }
                    __syncthreads();
#pragma unroll 1
                    for (int kb = wave; kb < nkb; kb += 8) F_MASK(F)[(mbase + kb) * 64 + lane] = lmask[kb * 64 + lane];
                    __syncthreads();
                    break;
                }
                if (mode == 4) break;
                if (mode == 5) { mode = 4; continue; }
#pragma unroll 1
                for (int r = 0; r < 2; ++r) { const int row = wave * 2 + r;
                    if (mode == 3) {
                        if (rp3[row] == 0u) continue;
                        const unsigned n = lcnt[row];
                        if (n > 256u) { if (lane == 0) { rcut[row] = 0xffffffffu; rp3[row] = 2u; flags[1] = 1u; } continue; }
                        unsigned ki[4], xi[4], rank[4];
#pragma unroll
                        for (int c = 0; c < 4; ++c) { const unsigned e = (unsigned)(c * 64 + lane); ki[c] = e < n ? lkey[row * 256 + e] : 0u; xi[c] = e < n ? lidx[row * 256 + e] : 0xffffffffu; rank[c] = 0u; }
#pragma unroll 1
                        for (unsigned j = 0; j < n; ++j) { const unsigned kj = lkey[row * 256 + j], xj = lidx[row * 256 + j];
#pragma unroll
                            for (int c = 0; c < 4; ++c) rank[c] += (kj > ki[c] || (kj == ki[c] && xj < xi[c])) ? 1u : 0u; }
                        const unsigned want = rneed[row];
#pragma unroll
                        for (int c = 0; c < 4; ++c) if ((unsigned)(c * 64 + lane) < n && rank[c] + 1u == want) { rpre[row] = ki[c]; rcut[row] = xi[c]; }
                        continue;
                    }
                    unsigned ne; const bool over = idx_select(hist, rpre, rneed, row, lane, 12, ne);
                    if (mode == 1 && ne > CAP6 && lane == 0) flags[2] = 1u;
                    if (over && lane == 0 && mode == 2) { rp3[row] = 1u; flags[0] = 1u; } }
                __syncthreads();
                if (mode == 1) mode = flags[2] == 0u ? 6 : 2; else if (mode == 2) mode = flags[0] != 0u ? 3 : 4; else mode = flags[1] != 0u ? 5 : 4;
            }
        }
    }
}

DI int t5_bucket(int rel) {
    const int n = rel < 0 ? -rel : rel;
    const int lg = 8 + (n >= 12) + (n >= 16) + (n >= 23) + (n >= 32) + (n >= 46) + (n >= 64) + (n >= 91);
    return (rel > 0 ? 16 : 0) + (n < 8 ? n : lg);
}
DI u32x4 ldg16(const void* sbase, unsigned voff) { return *(const u32x4*)((const char*)sbase + voff); }
constexpr int NH = 1;
constexpr int RT = 2;
constexpr int KP = NH * 64 + 8, VP = 72;
template <bool NEAR>
DI void att_tile_old(LAS u16* Kb, LAS u16* Vb, LAS float* bl, const unsigned (&bits)[RT], int kt, int rowl, int lq, int g4, const bf16x8 (&qf)[RT][NH][2], f32x4 (&O)[RT][NH][4], float (&m)[RT][NH], float (&l)[RT][NH]) {
#pragma unroll
    for (int hl = 0; hl < NH; ++hl) {
        f32x4 s[RT][4];
#pragma unroll
        for (int nt = 0; nt < 4; ++nt) {
#pragma unroll
            for (int rt = 0; rt < RT; ++rt) s[rt][nt] = (f32x4){0.f, 0.f, 0.f, 0.f};
#pragma unroll
            for (int ks = 0; ks < 2; ++ks) { const bf16x8 a = *(LAS bf16x8*)(Kb + (nt * 16 + lq) * KP + hl * 64 + ks * 32 + g4 * 8);
#pragma unroll
                for (int rt = 0; rt < RT; ++rt) s[rt][nt] = __builtin_amdgcn_mfma_f32_16x16x32_bf16(a, qf[rt][hl][ks], s[rt][nt], 0, 0, 0); } }
        const float bfar = bl[15 * 4 + hl];
        bf16x8 pb[RT][2];
#pragma unroll
        for (int rt = 0; rt < RT; ++rt) {
            float mx = -INFINITY;
#pragma unroll
            for (int nt = 0; nt < 4; ++nt)
#pragma unroll
                for (int i = 0; i < 4; ++i) { float bias = bfar; if (NEAR) { int ri = kt * 64 + nt * 16 + g4 * 4 + i - (rowl + rt * 16 + lq) + 128; ri = ri < 0 ? 0 : (ri > 255 ? 255 : ri); bias = bl[128 + ri * NH + hl]; } const float x = ((bits[rt] >> (nt * 4 + i)) & 1u) ? s[rt][nt][i] * (0.125f * LOG2E) + bias : -INFINITY; s[rt][nt][i] = x; mx = fmaxf(mx, x); }
            mx = fmaxf(mx, __shfl_xor(mx, 16)); mx = fmaxf(mx, __shfl_xor(mx, 32));
            const float mnew = fmaxf(m[rt][hl], mx), msafe = (mnew == -INFINITY) ? 0.f : mnew, alpha = __builtin_amdgcn_exp2f(m[rt][hl] - msafe); m[rt][hl] = mnew;
            float ls = 0.f;
#pragma unroll
            for (int nt = 0; nt < 4; ++nt)
#pragma unroll
                for (int i = 0; i < 4; ++i) { const float p = __builtin_amdgcn_exp2f(s[rt][nt][i] - msafe); s[rt][nt][i] = p; ls += p; }
            l[rt][hl] = l[rt][hl] * alpha + ls;
#pragma unroll
            for (int dt = 0; dt < 4; ++dt) O[rt][hl][dt] = O[rt][hl][dt] * alpha;
#pragma unroll
            for (int kk = 0; kk < 2; ++kk) { const u32x4 pw = pack8(s[rt][2 * kk], s[rt][2 * kk + 1]); pb[rt][kk] = __builtin_bit_cast(bf16x8, pw); }
        }
#pragma unroll
        for (int kk = 0; kk < 2; ++kk)
#pragma unroll
            for (int dt = 0; dt < 4; ++dt) { LAS u16* vp = Vb + (hl * 64 + dt * 16 + lq) * VP + kk * 32 + g4 * 4; const u32x2 v0 = *(LAS u32x2*)vp, v1 = *(LAS u32x2*)(vp + 16);
                u32x4 vw; vw.x = v0.x; vw.y = v0.y; vw.z = v1.x; vw.w = v1.y; const bf16x8 vf = __builtin_bit_cast(bf16x8, vw);
#pragma unroll
                for (int rt = 0; rt < RT; ++rt) O[rt][hl][dt] = __builtin_amdgcn_mfma_f32_16x16x32_bf16(vf, pb[rt][kk], O[rt][hl][dt], 0, 0, 0); }
    }
}
DI void att_tile_far(LAS u16* Kb, LAS u16* Vb, LAS float* bl, const unsigned (&bits)[RT], const bf16x8 (&qf)[RT][NH][2], f32x4 (&O)[RT][NH][4], float (&m)[RT][NH], float (&l)[RT][NH], int lq, int g4) {
#pragma unroll
    for (int hl = 0; hl < NH; ++hl) {
        bf16x8 kf[4][2], vf[2][4];
#pragma unroll
        for (int nt = 0; nt < 4; ++nt)
#pragma unroll
            for (int ks = 0; ks < 2; ++ks) kf[nt][ks] = *(LAS bf16x8*)(Kb + (nt * 16 + lq) * KP + hl * 64 + ks * 32 + g4 * 8);
#pragma unroll
        for (int kk = 0; kk < 2; ++kk)
#pragma unroll
            for (int dt = 0; dt < 4; ++dt) { LAS u16* vp = Vb + (hl * 64 + dt * 16 + lq) * VP + kk * 32 + g4 * 4; const u32x2 v0 = *(LAS u32x2*)vp, v1 = *(LAS u32x2*)(vp + 16);
                u32x4 vw; vw.x = v0.x; vw.y = v0.y; vw.z = v1.x; vw.w = v1.y; vf[kk][dt] = __builtin_bit_cast(bf16x8, vw); }
        const float bfar = bl[15 * 4 + hl];
        f32x4 s[RT][4];
#pragma unroll
        for (int nt = 0; nt < 4; ++nt) {
#pragma unroll
            for (int rt = 0; rt < RT; ++rt) s[rt][nt] = (f32x4){0.f, 0.f, 0.f, 0.f};
#pragma unroll
            for (int ks = 0; ks < 2; ++ks)
#pragma unroll
                for (int rt = 0; rt < RT; ++rt) s[rt][nt] = __builtin_amdgcn_mfma_f32_16x16x32_bf16(kf[nt][ks], qf[rt][hl][ks], s[rt][nt], 0, 0, 0); }
        bf16x8 pb[RT][2];
#pragma unroll
        for (int rt = 0; rt < RT; ++rt) {
            float mx = -INFINITY;
#pragma unroll
            for (int nt = 0; nt < 4; ++nt)
#pragma unroll
                for (int i = 0; i < 4; ++i) { const int sel = __builtin_amdgcn_sbfe((int)bits[rt], nt * 4 + i, 1);
                    const float x = __int_as_float((__float_as_int(s[rt][nt][i]) & sel) | (int)(0xff800000u & ~(unsigned)sel)); s[rt][nt][i] = x; mx = fmaxf(mx, x); }
            mx = fmaxf(mx, __shfl_xor(mx, 16)); mx = fmaxf(mx, __shfl_xor(mx, 32));
            const float mxl = mx * (0.125f * LOG2E) + bfar;
            const float mnew = fmaxf(m[rt][hl], mxl), msafe = (mnew == -INFINITY) ? 0.f : mnew, alpha = __builtin_amdgcn_exp2f(m[rt][hl] - msafe); m[rt][hl] = mnew;
            const float boff = bfar - msafe; float ls = 0.f;
#pragma unroll
            for (int nt = 0; nt < 4; ++nt)
#pragma unroll
                for (int i = 0; i < 4; ++i) { const float p = __builtin_amdgcn_exp2f(s[rt][nt][i] * (0.125f * LOG2E) + boff); s[rt][nt][i] = p; ls += p; }
            l[rt][hl] = l[rt][hl] * alpha + ls;
#pragma unroll
            for (int dt = 0; dt < 4; ++dt) O[rt][hl][dt] = O[rt][hl][dt] * alpha;
#pragma unroll
            for (int kk = 0; kk < 2; ++kk) { const u32x4 pw = pack8(s[rt][2 * kk], s[rt][2 * kk + 1]); pb[rt][kk] = __builtin_bit_cast(bf16x8, pw); }
        }
#pragma unroll
        for (int kk = 0; kk < 2; ++kk)
#pragma unroll
            for (int dt = 0; dt < 4; ++dt)
#pragma unroll
                for (int rt = 0; rt < RT; ++rt) O[rt][hl][dt] = __builtin_amdgcn_mfma_f32_16x16x32_bf16(vf[kk][dt], pb[rt][kk], O[rt][hl][dt], 0, 0, 0);
    }
}
DI void att_tile_near(LAS u16* Kb, LAS u16* Vb, LAS float* bl, const unsigned (&bits)[RT], int kt, int rowl, const bf16x8 (&qf)[RT][NH][2], f32x4 (&O)[RT][NH][4], float (&m)[RT][NH], float (&l)[RT][NH], int lq, int g4) {
#pragma unroll
    for (int hl = 0; hl < NH; ++hl) {
        bf16x8 vf[2][4];
        f32x4 s[RT][4];
#pragma unroll
        for (int nt = 0; nt < 4; ++nt) {
#pragma unroll
            for (int rt = 0; rt < RT; ++rt) s[rt][nt] = (f32x4){0.f, 0.f, 0.f, 0.f};
#pragma unroll
            for (int ks = 0; ks < 2; ++ks) { const bf16x8 kfr = *(LAS bf16x8*)(Kb + (nt * 16 + lq) * KP + hl * 64 + ks * 32 + g4 * 8);
#pragma unroll
                for (int rt = 0; rt < RT; ++rt) s[rt][nt] = __builtin_amdgcn_mfma_f32_16x16x32_bf16(kfr, qf[rt][hl][ks], s[rt][nt], 0, 0, 0); } }
        bf16x8 pb[RT][2];
#pragma unroll
        for (int rt = 0; rt < RT; ++rt) {
            float bia[16];
#pragma unroll
            for (int nt = 0; nt < 4; ++nt)
#pragma unroll
                for (int i = 0; i < 4; ++i) { int ri = kt * 64 + nt * 16 + g4 * 4 + i - (rowl + rt * 16 + lq) + 128; ri = ri < 0 ? 0 : (ri > 255 ? 255 : ri); bia[nt * 4 + i] = bl[128 + ri * NH + hl]; }
            float mx = -INFINITY;
#pragma unroll
            for (int nt = 0; nt < 4; ++nt)
#pragma unroll
                for (int i = 0; i < 4; ++i) { const float xb = s[rt][nt][i] * (0.125f * LOG2E) + bia[nt * 4 + i];
                    const int sel = __builtin_amdgcn_sbfe((int)bits[rt], nt * 4 + i, 1);
                    const float x = __int_as_float((__float_as_int(xb) & sel) | (int)(0xff800000u & ~(unsigned)sel)); s[rt][nt][i] = x; mx = fmaxf(mx, x); }
            mx = fmaxf(mx, __shfl_xor(mx, 16)); mx = fmaxf(mx, __shfl_xor(mx, 32));
            const float mnew = fmaxf(m[rt][hl], mx), msafe = (mnew == -INFINITY) ? 0.f : mnew, alpha = __builtin_amdgcn_exp2f(m[rt][hl] - msafe); m[rt][hl] = mnew;
            float ls = 0.f;
#pragma unroll
            for (int nt = 0; nt < 4; ++nt)
#pragma unroll
                for (int i = 0; i < 4; ++i) { const float p = __builtin_amdgcn_exp2f(s[rt][nt][i] - msafe); s[rt][nt][i] = p; ls += p; }
            l[rt][hl] = l[rt][hl] * alpha + ls;
#pragma unroll
            for (int dt = 0; dt < 4; ++dt) O[rt][hl][dt] = O[rt][hl][dt] * alpha;
#pragma unroll
            for (int kk = 0; kk < 2; ++kk) { const u32x4 pw = pack8(s[rt][2 * kk], s[rt][2 * kk + 1]); pb[rt][kk] = __builtin_bit_cast(bf16x8, pw); }
        }
#pragma unroll
        for (int kk = 0; kk < 2; ++kk)
#pragma unroll
            for (int dt = 0; dt < 4; ++dt) { LAS u16* vp = Vb + (hl * 64 + dt * 16 + lq) * VP + kk * 32 + g4 * 4; const u32x2 v0 = *(LAS u32x2*)vp, v1 = *(LAS u32x2*)(vp + 16);
                u32x4 vw; vw.x = v0.x; vw.y = v0.y; vw.z = v1.x; vw.w = v1.y; vf[kk][dt] = __builtin_bit_cast(bf16x8, vw); }
#pragma unroll
        for (int kk = 0; kk < 2; ++kk)
#pragma unroll
            for (int dt = 0; dt < 4; ++dt)
#pragma unroll
                for (int rt = 0; rt < RT; ++rt) O[rt][hl][dt] = __builtin_amdgcn_mfma_f32_16x16x32_bf16(vf[kk][dt], pb[rt][kk], O[rt][hl][dt], 0, 0, 0);
    }
}
DI void att_phase(const Frame& F, LAS unsigned char* lds) {
    constexpr int KT = 64 * KP, VTS = NH * 64 * VP;
    LAS u16* Kbuf = (LAS u16*)lds;
    LAS u16* Vbuf = (LAS u16*)(lds + 4 * KT * 2);
    LAS float* bl = (LAS float*)(lds + 4 * KT * 2 + 4 * VTS * 2);
    const int tid = F.tid, lane = F.lane, wave = F.wave, lq = lane & 15, g4 = lane >> 4;
    constexpr int NQ = 8 / NH;
    constexpr int BR = 8 * 16 * RT, NBT = SEQ / BR;
    for (int pp = blockIdx.x; pp < 4 * NQ * (NBT / 2); pp += gridDim.x) {
        const int x = pp & 7, y = pp >> 3, b = x >> 1, hq = (x & 1) * (NQ / 2) + (y % (NQ / 2)), ii = y / (NQ / 2);
        __syncthreads();
        if (tid < 128) bl[tid] = ((tid & 3) < NH) ? F.in[23][(tid >> 2) * 8 + hq * NH + (tid & 3)] * LOG2E : 0.f;
        for (int e = tid; e < 256 * NH; e += NTHR) bl[128 + e] = F.in[23][t5_bucket(e / NH - 128) * 8 + hq * NH + (e % NH)] * LOG2E;
        __syncthreads();
        for (int which = 0; which < 2; ++which) {
            const int i = which ? NBT - 1 - ii : ii, npair = (BR / 128) * (i + 1), rowl = i * BR + wave * (16 * RT);
            const int c = rowl >> 6, my_ntile = c + 1;
            u16* qbase = F_Q(F) + ((size_t)b * SEQ + rowl + lq) * 512 + hq * (NH * 64);
            bf16x8 qf[RT][NH][2];
#pragma unroll
            for (int rt = 0; rt < RT; ++rt)
#pragma unroll
                for (int hl = 0; hl < NH; ++hl)
#pragma unroll
                    for (int ks = 0; ks < 2; ++ks) qf[rt][hl][ks] = *(const bf16x8*)(qbase + rt * 16 * 512 + hl * 64 + ks * 32 + g4 * 8);
            f32x4 O[RT][NH][4]; float m[RT][NH], l[RT][NH];
#pragma unroll
            for (int rt = 0; rt < RT; ++rt)
#pragma unroll
                for (int hl = 0; hl < NH; ++hl) { m[rt][hl] = -INFINITY; l[rt][hl] = 0.f;
#pragma unroll
                    for (int dt = 0; dt < 4; ++dt) O[rt][hl][dt] = (f32x4){0.f, 0.f, 0.f, 0.f}; }
            const size_t mb0 = (size_t)b * MASK_PER_B + (size_t)(c + 1) * (2 * c + ((rowl >> 4) & 3));
            const char* mp = (const char*)(F_MASK(F) + mb0 * 64) + (unsigned)(lane * 2);
            const int mrt = (c + 1) * 128;
            const u16* kg = F_K(F) + ((size_t)b * SEQ) * 512 + hq * (NH * 64); const u16* vg = F_VT(F) + ((size_t)(b * 512 + hq * (NH * 64))) * SEQ;
            constexpr int NE = NH, KCH = NH * 8, KR = 512 / KCH;
            u32x4 kr[2][NE], vr[2][NE];
            const unsigned voffK = (unsigned)(((tid / KCH) * 512 + (tid % KCH) * 8) * 2), voffV = (unsigned)(((tid >> 3) * SEQ + (tid & 7) * 8) * 2);
            const int krow = tid / KCH, kck = tid % KCH, vrow = tid >> 3, vck = tid & 7;
#pragma unroll
            for (int t = 0; t < 2; ++t)
#pragma unroll
                for (int e = 0; e < NE; ++e) { kr[t][e] = ldg16(kg + (size_t)(t * 64 + e * KR) * 512, voffK); vr[t][e] = ldg16(vg + (size_t)e * 64 * SEQ + t * 64, voffV); }
#pragma unroll
            for (int t = 0; t < 2; ++t)
#pragma unroll
                for (int e = 0; e < NE; ++e) { *(LAS u32x4*)(Kbuf + t * KT + (krow + e * KR) * KP + kck * 8) = kr[t][e]; *(LAS u32x4*)(Vbuf + t * VTS + (vrow + e * 64) * VP + vck * 8) = vr[t][e]; }
            unsigned bc[2][RT], bn[2][RT];
#pragma unroll
            for (int t = 0; t < 2; ++t)
#pragma unroll
                for (int rt = 0; rt < RT; ++rt) { const int kq = t < my_ntile ? t : my_ntile - 1; bc[t][rt] = *(const u16*)(mp + rt * mrt + kq * 128); }
            __builtin_amdgcn_s_waitcnt(0x0F70);
            __syncthreads();
#pragma unroll 1
            for (int kp = 0; kp < npair; ++kp) {
                const bool more = kp + 1 < npair; const int kt0 = 2 * kp, st = kp & 1;
                if (more) {
#pragma unroll
                    for (int t = 0; t < 2; ++t)
#pragma unroll
                        for (int rt = 0; rt < RT; ++rt) { const int kq = kt0 + 2 + t < my_ntile ? kt0 + 2 + t : my_ntile - 1; bn[t][rt] = *(const u16*)(mp + rt * mrt + kq * 128); }
#pragma unroll
                    for (int t = 0; t < 2; ++t)
#pragma unroll
                        for (int e = 0; e < NE; ++e) { kr[t][e] = ldg16(kg + (size_t)((kt0 + 2 + t) * 64 + e * KR) * 512, voffK); vr[t][e] = ldg16(vg + (size_t)e * 64 * SEQ + (kt0 + 2 + t) * 64, voffV); }
                }
#pragma unroll
                for (int t = 0; t < 2; ++t) { const int kt = kt0 + t;
                    if (kt < my_ntile) {
                        LAS u16* Kb = Kbuf + (st * 2 + t) * KT; LAS u16* Vb = Vbuf + (st * 2 + t) * VTS;
                        if (kt * 64 + 63 - rowl <= -91) att_tile_far(Kb, Vb, bl, bc[t], qf, O, m, l, lq, g4);
                        else att_tile_near(Kb, Vb, bl, bc[t], kt, rowl, qf, O, m, l, lq, g4);
                    } }
                if (more) {
#pragma unroll
                    for (int t = 0; t < 2; ++t)
#pragma unroll
                        for (int e = 0; e < NE; ++e) { *(LAS u32x4*)(Kbuf + ((st ^ 1) * 2 + t) * KT + (krow + e * KR) * KP + kck * 8) = kr[t][e]; *(LAS u32x4*)(Vbuf + ((st ^ 1) * 2 + t) * VTS + (vrow + e * 64) * VP + vck * 8) = vr[t][e]; }
#pragma unroll
                    for (int t = 0; t < 2; ++t)
#pragma unroll
                        for (int rt = 0; rt < RT; ++rt) bc[t][rt] = bn[t][rt];
                }
                __syncthreads();
            }
#pragma unroll
            for (int rt = 0; rt < RT; ++rt)
#pragma unroll
                for (int hl = 0; hl < NH; ++hl) { float lt = l[rt][hl]; lt += __shfl_xor(lt, 16); lt += __shfl_xor(lt, 32); const float inv = 1.0f / lt;
#pragma unroll
                    for (int dt = 0; dt < 4; ++dt) { const f32x4 o = O[rt][hl][dt] * inv; u32x2 w; w.x = cvt_pk_bf16(o[0], o[1]); w.y = cvt_pk_bf16(o[2], o[3]);
                        *(u32x2*)(qbase + rt * 16 * 512 + hl * 64 + dt * 16 + g4 * 4) = w; } }
        }
    }
}

#define XB_TMO      128
#define XB_XCNT(j)  (256  + 64 * (j))
#define XB_XSUB(j)  (1280 + 64 * (j))
#define XB_XGEN(j)  (2304 + 64 * (j))
#define XB_TOP      3328
#define XB_TOPGEN   3392
#define XCD_BAR_WORDS 3456
#define XB_SPIN_CAP (1u << 18)
DI unsigned xb_ld(unsigned* p)              { return __hip_atomic_load(p, __ATOMIC_RELAXED, __HIP_MEMORY_SCOPE_AGENT); }
DI unsigned xb_add(unsigned* p, unsigned v) { return __hip_atomic_fetch_add(p, v, __ATOMIC_RELAXED, __HIP_MEMORY_SCOPE_AGENT); }
DI unsigned xb_xcc_id() { return (unsigned)__builtin_amdgcn_s_getreg((3 << 11) | 20) & 0xFu; }
#define XB_SPIN(cond, bar) do { unsigned _sp = 0; while (cond) { __builtin_amdgcn_s_sleep(1); \
    if ((++_sp & 255u) == 0u) { if (xb_ld(&(bar)[XB_TMO])) break; if (_sp > XB_SPIN_CAP) { (void)xb_add(&(bar)[XB_TMO], 1u); break; } } } } while (0)
struct XcdBarrier { unsigned* bar; unsigned x; volatile LAS unsigned* st; };
DI XcdBarrier xcd_barrier_post(unsigned* bar, volatile LAS unsigned* st) {
    XcdBarrier b; b.bar = bar; b.x = xb_xcc_id(); b.st = st;
    if (threadIdx.x == 0) (void)xb_add(&bar[XB_XCNT(b.x)], 1u);
    return b;
}
DI void xcd_barrier_complete(unsigned* bar, unsigned x, unsigned& nloc, unsigned& nx) {
    const unsigned G = gridDim.x * gridDim.y * gridDim.z;
    unsigned sum, cnt, mine, sp = 0u;
    for (;;) {
        sum = 0u; cnt = 0u; mine = 0u;
#pragma unroll
        for (unsigned j = 0; j < 16; ++j) { const unsigned c = xb_ld(&bar[XB_XCNT(j)]); sum += c; cnt += (c > 0u) ? 1u : 0u; mine = (j == x) ? c : mine; }
        if (sum == G) break;
        __builtin_amdgcn_s_sleep(1);
        if ((++sp & 255u) == 0u) { if (xb_ld(&bar[XB_TMO])) break; if (sp > XB_SPIN_CAP) { (void)xb_add(&bar[XB_TMO], 1u); break; } }
    }
    nloc = mine > 0u ? mine : 1u; nx = cnt > 0u ? cnt : 1u;
}
DI unsigned xb_uadd(unsigned* p, unsigned v) { unsigned r = 0u; if ((threadIdx.x & 63) == 0) r = xb_add(p, v); return (unsigned)__builtin_amdgcn_readfirstlane((int)r); }
DI unsigned xb_uld(unsigned* p) { return (unsigned)__builtin_amdgcn_readfirstlane((int)xb_ld(p)); }
DI void xcd_barrier(unsigned* bar, unsigned bx, volatile LAS unsigned* bst) {
    asm volatile("s_waitcnt vmcnt(0)" ::: "memory");
    __syncthreads();
    if (__builtin_amdgcn_readfirstlane((int)(threadIdx.x >> 6)) == 0) {
        asm volatile("s_waitcnt vmcnt(0) lgkmcnt(0)" ::: "memory");
        unsigned nloc = (unsigned)__builtin_amdgcn_readfirstlane((int)bst[0]), nx = (unsigned)__builtin_amdgcn_readfirstlane((int)bst[1]);
        if (nloc == 0u) {
            const unsigned G = gridDim.x; unsigned sp = 0u;
            for (;;) {
                unsigned sum = 0u, cnt = 0u, mine = 0u;
#pragma unroll
                for (unsigned j = 0; j < 16; ++j) { const unsigned c = xb_uld(&bar[XB_XCNT(j)]); sum += c; cnt += (c > 0u) ? 1u : 0u; mine = (j == bx) ? c : mine; }
                nloc = mine > 0u ? mine : 1u; nx = cnt > 0u ? cnt : 1u;
                if (sum == G) break;
                __builtin_amdgcn_s_sleep(1);
                if (++sp > XB_SPIN_CAP) { (void)xb_uadd(&bar[XB_TMO], 1u); break; }
            }
            if ((threadIdx.x & 63) == 0) { bst[0] = nloc; bst[1] = nx; }
        }
        const unsigned old = xb_uadd(&bar[XB_XSUB(bx)], 1u);
        const unsigned gen = old / nloc;
        if (old + 1u == (gen + 1u) * nloc) {
            __builtin_amdgcn_fence(__ATOMIC_RELEASE, "agent");
            asm volatile("s_waitcnt vmcnt(0)" ::: "memory");
            const unsigned og = xb_uadd(&bar[XB_TOP], 1u);
            const unsigned tg = og / nx;
            if (og + 1u == (tg + 1u) * nx) (void)xb_uadd(&bar[XB_TOPGEN], 1u);
            else { unsigned sp = 0u; while (xb_uld(&bar[XB_TOPGEN]) == tg) { __builtin_amdgcn_s_sleep(1); if (++sp > XB_SPIN_CAP) { (void)xb_uadd(&bar[XB_TMO], 1u); break; } } }
            __builtin_amdgcn_fence(__ATOMIC_ACQUIRE, "agent");
            (void)xb_uadd(&bar[XB_XGEN(bx)], 1u);
            asm volatile("s_waitcnt vmcnt(0)" ::: "memory");
        } else {
            unsigned sp = 0u; while (xb_uld(&bar[XB_XGEN(bx)]) == gen) { __builtin_amdgcn_s_sleep(1); if (++sp > XB_SPIN_CAP) { (void)xb_uadd(&bar[XB_TMO], 1u); break; } }
            __builtin_amdgcn_fence(__ATOMIC_ACQUIRE, "agent");
            asm volatile("s_waitcnt vmcnt(0)" ::: "memory");
        }
    }
    __syncthreads();
}

constexpr int NPH = 33;
#define PHON(k) ((PHM >> (k)) & 1)
DI void fresh(Frame& F, const Args& args) {
    int t = threadIdx.x; asm volatile("" : "+v"(t)); F.tid = t; F.lane = t & 63; F.wave = __builtin_amdgcn_readfirstlane(t >> 6);
    int z = 0; asm volatile("" : "+s"(z)); F.in = args.in + z;
    F.ws = args.ws + z; F.out = args.out + z;
}
#ifndef RPT
#define RPT 0
#endif
#define PH_BEGIN(k) if (args.lo <= (k) && (k) < args.hi) { fresh(F, args); unsigned char* ws = F.ws; (void)ws;
#define PH_END(k) if ((k) + 1 < args.hi) xcd_barrier(xbar, xx, xst); }
template <int PHM, int L>
DI void layer_phases(Frame& F, const Args& args, LAS unsigned char* lds, cg::grid_group& grid, unsigned* xbar, unsigned xx, volatile LAS unsigned* xst) {
    constexpr int P = 1 + 16 * L;
#define WL (ws + WS_W + (size_t)L * SZ_LAYERW)
#define TAB (ws + WS_TAB + (size_t)L * SZ_TABL)
#define WLDS (lds + F.wave * 19456)
    PH_BEGIN(P + 0) if (PHON(0)) { EpiUp E{F_H(F)}; run_gemm(lds, F_XB(F), (const u16*)(WL + OFF_UP1), NUP, D_, E); } if ((RPT >> 0) & 1) { xcd_barrier(xbar, xx, xst); fresh(F, args); if (PHON(0)) { EpiUp E{F_H(F)}; run_gemm(lds, F_XB(F), (const u16*)(WL + OFF_UP1), NUP, D_, E); } } PH_END(P + 0)
    PH_BEGIN(P + 1) if (PHON(1)) { EpiRes E{L == 0 ? F.in[0] : (const float*)F.out, F.out, 0.5f, L == 0 ? (const f32x2_t*)nullptr : (const f32x2_t*)(ws + WS_STATS), F.in[21], F.in[22]};     run_gemm(lds, F_H(F), (const u16*)(WL + OFF_DN1), D_, DFF, E); } if ((RPT >> 1) & 1) { xcd_barrier(xbar, xx, xst); fresh(F, args); if (PHON(1)) { EpiRes E{L == 0 ? F.in[0] : (const float*)F.out, F.out, 0.5f, L == 0 ? (const f32x2_t*)nullptr : (const f32x2_t*)(ws + WS_STATS), F.in[21], F.in[22]};     run_gemm(lds, F_H(F), (const u16*)(WL + OFF_DN1), D_, DFF, E); } } PH_END(P + 1)
    PH_BEGIN(P + 2) if (PHON(2)) ln_phase(F, F.in[3] + L * D_, F.in[4] + L * D_, false); if ((RPT >> 2) & 1) { xcd_barrier(xbar, xx, xst); fresh(F, args); if (PHON(2)) ln_phase(F, F.in[3] + L * D_, F.in[4] + L * D_, false); } PH_END(P + 2)
    PH_BEGIN(P + 3) if (PHON(3)) { EpiIn E{ws}; run_gemm(lds, F_XB(F), (const u16*)(WL + OFF_WIN), NIN, D_, E); } if ((RPT >> 3) & 1) { xcd_barrier(xbar, xx, xst); fresh(F, args); if (PHON(3)) { EpiIn E{ws}; run_gemm(lds, F_XB(F), (const u16*)(WL + OFF_WIN), NIN, D_, E); } } PH_END(P + 3)
    PH_BEGIN(P + 4) if (PHON(4)) { idx_phase(F, lds); __syncthreads(); fresh(F, args); { for (int t = blockIdx.x * 8 + F.wave; t < 4096; t += gridDim.x * 8) vt_tile(F, WLDS, t);
        { int gcur = -1; float ar = 0.f, ai = 0.f, cr = 0.f, ci = 0.f; bf16x8 af[8], cf[4]; f32x4 dv = {0.f, 0.f, 0.f, 0.f};
          for (int it = blockIdx.x * 8 + F.wave; it < 16384; it += gridDim.x * 8) { const int g = it & 31; if (g != gcur) { ssm_load_g(TAB, F.in[13] + L * 512, g, F.lane, ar, ai, cr, ci, af, cf, dv); gcur = g; } ssmA_item(F, WLDS, it, ar, ai, af); } } } } PH_END(P + 4)
    PH_BEGIN(P + 5) if (PHON(5)) { att_phase(F, lds); __syncthreads(); fresh(F, args); { int gcur = -1; float ar = 0.f, ai = 0.f, cr = 0.f, ci = 0.f; bf16x8 af[8], cf[4]; f32x4 dv = {0.f, 0.f, 0.f, 0.f};
          for (int it = blockIdx.x * 8 + F.wave; it < 16384; it += gridDim.x * 8) { const int g = it & 31; if (g != gcur) { ssm_load_g(TAB, F.in[13] + L * 512, g, F.lane, ar, ai, cr, ci, af, cf, dv); gcur = g; } ssmC_item(F, WLDS, it, ar, ai, cr, ci, af, cf, dv); } } } PH_END(P + 5)
    PH_BEGIN(P + 6) if (PHON(6)) { EpiMix<0> E{F_U(F), nullptr, F_YS(F), 512}; run_gemm(lds, F_U(F), (const u16*)(WL + OFF_GLU), 512, 512, E); } if ((RPT >> 6) & 1) { xcd_barrier(xbar, xx, xst); fresh(F, args); if (PHON(6)) { EpiMix<0> E{F_U(F), nullptr, F_YS(F), 512}; run_gemm(lds, F_U(F), (const u16*)(WL + OFF_GLU), 512, 512, E); } } PH_END(P + 6)
    PH_BEGIN(P + 7) if (PHON(7)) { EpiMix<1> E{F_GS(F), nullptr, F_GS(F), 1024}; run_gemm(lds, F_YS(F), (const u16*)(WL + OFF_WB0), D_, 512, E); } if ((RPT >> 7) & 1) { xcd_barrier(xbar, xx, xst); fresh(F, args); if (PHON(7)) { EpiMix<1> E{F_GS(F), nullptr, F_GS(F), 1024}; run_gemm(lds, F_YS(F), (const u16*)(WL + OFF_WB0), D_, 512, E); } } PH_END(P + 7)
    PH_BEGIN(P + 10) if (PHON(10)) { EpiMix<2> E{F_GA(F), F_GS(F), F_GA(F), 1024}; run_gemm(lds, F_Q(F), (const u16*)(WL + OFF_WB1), D_, 512, E); } if ((RPT >> 10) & 1) { xcd_barrier(xbar, xx, xst); fresh(F, args); if (PHON(10)) { EpiMix<2> E{F_GA(F), F_GS(F), F_GA(F), 1024}; run_gemm(lds, F_Q(F), (const u16*)(WL + OFF_WB1), D_, 512, E); } } PH_END(P + 10)
    PH_BEGIN(P + 11) if (PHON(11)) { EpiRes E{(const float*)F.out, F.out, 1.0f, (const f32x2_t*)(ws + WS_STATS), F.in[3] + L * D_, F.in[4] + L * D_}; run_gemm(lds, F_GA(F), (const u16*)(WL + OFF_WOUT), D_, D_, E); } if ((RPT >> 11) & 1) { xcd_barrier(xbar, xx, xst); fresh(F, args); if (PHON(11)) { EpiRes E{(const float*)F.out, F.out, 1.0f, (const f32x2_t*)(ws + WS_STATS), F.in[3] + L * D_, F.in[4] + L * D_}; run_gemm(lds, F_GA(F), (const u16*)(WL + OFF_WOUT), D_, D_, E); } } PH_END(P + 11)
    PH_BEGIN(P + 12) if (PHON(12)) ln_phase(F, F.in[17] + L * D_, F.in[18] + L * D_, false); if ((RPT >> 12) & 1) { xcd_barrier(xbar, xx, xst); fresh(F, args); if (PHON(12)) ln_phase(F, F.in[17] + L * D_, F.in[18] + L * D_, false); } PH_END(P + 12)
    PH_BEGIN(P + 13) if (PHON(13)) { EpiUp E{F_H(F)}; run_gemm(lds, F_XB(F), (const u16*)(WL + OFF_UP2), NUP, D_, E); } if ((RPT >> 13) & 1) { xcd_barrier(xbar, xx, xst); fresh(F, args); if (PHON(13)) { EpiUp E{F_H(F)}; run_gemm(lds, F_XB(F), (const u16*)(WL + OFF_UP2), NUP, D_, E); } } PH_END(P + 13)
    PH_BEGIN(P + 14) if (PHON(14)) { EpiRes E{(const float*)F.out, F.out, 0.5f, (const f32x2_t*)(ws + WS_STATS), F.in[17] + L * D_, F.in[18] + L * D_}; run_gemm(lds, F_H(F), (const u16*)(WL + OFF_DN2), D_, DFF, E); } if ((RPT >> 14) & 1) { xcd_barrier(xbar, xx, xst); fresh(F, args); if (PHON(14)) { EpiRes E{(const float*)F.out, F.out, 0.5f, (const f32x2_t*)(ws + WS_STATS), F.in[17] + L * D_, F.in[18] + L * D_}; run_gemm(lds, F_H(F), (const u16*)(WL + OFF_DN2), D_, DFF, E); } } PH_END(P + 14)
    PH_BEGIN(P + 15) if (PHON(15)) ln_phase(F, F.in[21] + L * D_, F.in[22] + L * D_, L == 1); if ((RPT >> 15) & 1) { xcd_barrier(xbar, xx, xst); fresh(F, args); if (PHON(15)) ln_phase(F, F.in[21] + L * D_, F.in[22] + L * D_, L == 1); } PH_END(P + 15)
#undef WL
#undef TAB
#undef WLDS
}
template <int PHM>
__global__ void __launch_bounds__(NTHR, 2) mega(Args args) {
    extern __shared__ __attribute__((aligned(16))) unsigned char lds_raw[];
    LAS unsigned char* lds = (LAS unsigned char*)lds_raw;
    Frame F;
    cg::grid_group grid = cg::this_grid();
    volatile LAS unsigned* xst = (volatile LAS unsigned*)(lds + LDS_MAIN);
    if (threadIdx.x < 4) xst[threadIdx.x] = 0u;
    __syncthreads();
    unsigned* bar = (unsigned*)(args.ws + WS_BAR);
    if (args.lo <= 0 && 0 < args.hi) { fresh(F, args);
        if (blockIdx.x == 0) { for (int i = F.tid; i < XCD_BAR_WORDS; i += NTHR) bar[i] = 0u; }
        if (PHON(16)) p0_phase(F, lds);
        if (1 < args.hi) grid.sync(); }
    const unsigned xx = xb_xcc_id();
    if (threadIdx.x == 0) (void)xb_add(&bar[XB_XCNT(xx)], 1u);
    layer_phases<PHM, 0>(F, args, lds, grid, bar, xx, xst);
    layer_phases<PHM, 1>(F, args, lds, grid, bar, xx, xst);
}

typedef void (*kern_t)(Args);
#if !ONE_LAUNCH
static kern_t phase_kernel(int ph) {
    if (ph == 0) return mega<(1 << 16)>;
    switch ((ph - 1) & 15) {
    case 0: return mega<(1 << 0)>; case 1: return mega<(1 << 1)>; case 2: return mega<(1 << 2)>; case 3: return mega<(1 << 3)>;
    case 4: return mega<(1 << 4)>; case 5: return mega<(1 << 5)>; case 6: return mega<(1 << 6)>; case 7: return mega<(1 << 7)>;
    case 8: return mega<(1 << 8)>; case 9: return mega<(1 << 9)>; case 10: return mega<(1 << 10)>; case 11: return mega<(1 << 11)>;
    case 12: return mega<(1 << 12)>; case 13: return mega<(1 << 13)>; case 14: return mega<(1 << 14)>; default: return mega<(1 << 15)>;
    }
}
#endif
extern "C" void kernel_launch(void* const* d_in, const int* in_sizes, int n_in, void* d_out, int out_size, void* d_ws, size_t ws_size, hipStream_t stream) {
    static int grid = 0;
    if (grid == 0) {
        int dev = 0, cus = 0;
        if (n_in != 24 || out_size != T_ * D_ || ws_size < WS_END) { fprintf(stderr, "kernel_launch: unexpected problem (n_in %d out %d ws %zu need %zu)\n", n_in, out_size, ws_size, (size_t)WS_END); grid = -1; return; }
        (void)hipGetDevice(&dev); (void)hipDeviceGetAttribute(&cus, hipDeviceAttributeMultiprocessorCount, dev);
#if ONE_LAUNCH
        if (hipFuncSetAttribute((const void*)mega<0x1ffff>, hipFuncAttributeMaxDynamicSharedMemorySize, LDS_BYTES) != hipSuccess) fprintf(stderr, "kernel_launch: hipFuncSetAttribute failed\n");
#else
        for (int ph = 0; ph < 17; ++ph) if (hipFuncSetAttribute((const void*)phase_kernel(ph), hipFuncAttributeMaxDynamicSharedMemorySize, LDS_BYTES) != hipSuccess) fprintf(stderr, "kernel_launch: hipFuncSetAttribute failed\n");
#endif
        (void)hipGetLastError();
        grid = cus > 0 ? cus : 256;
    }
    if (grid < 0) return;
    Args a{};
    for (int i = 0; i < 24; ++i) a.in[i] = (const float*)d_in[i];
    a.out = (float*)d_out; a.ws = (unsigned char*)d_ws;
#if ONE_LAUNCH
    a.lo = 0; a.hi = NPH;
    void* kargs[] = {&a};
    hipError_t e = hipLaunchCooperativeKernel((const void*)mega<0x1ffff>, dim3(grid), dim3(NTHR), kargs, LDS_BYTES, stream);
    if (e != hipSuccess) fprintf(stderr, "cooperative launch failed: %s (grid %d)\n", hipGetErrorString(e), grid);
#else
    for (int ph = 0; ph < NPH; ++ph) { a.lo = ph; a.hi = ph + 1; hipLaunchKernelGGL(phase_kernel(ph), dim3(grid), dim3(NTHR), LDS_BYTES, stream, a); }
#endif
}
```

```cpp
#include <hip/hip_runtime.h>
#include <hip/hip_cooperative_groups.h>
#include <cstdio>
namespace cg = cooperative_groups;
#ifndef ONE_LAUNCH
#define ONE_LAUNCH 1
#endif
namespace pg8 {
#define PG8_LAS __attribute__((address_space(3)))
typedef unsigned short bf16_t;
typedef short bf16x8 __attribute__((ext_vector_type(8)));
typedef float f32x4 __attribute__((ext_vector_type(4)));
typedef unsigned u32x4 __attribute__((ext_vector_type(4)));
constexpr int BM = 256, BK = 64, HALF = 128, HTB = HALF * BK * 2  , STAGE_BYTES = 8 * HTB, NXCD = 8, WGM = 8;

__host__ __device__ __forceinline__ int lds_byte(int r, int c) { const int st = (r >> 4) * 2 + (c >> 5), rr = r & 15, cc = c & 31, ob = rr * 64 + cc * 2; return st * 1024 + (ob ^ (((ob >> 9) & 1) << 5)); }
__host__ __device__ __forceinline__ void stage_rc(int b, int& R, int& C) { const int st = b / 1024, sb = b % 1024, swz = sb ^ (((sb >> 9) & 1) << 5); R = (st >> 1) * 16 + swz / 64; C = (st & 1) * 32 + (swz % 64) / 2; }
__host__ __device__ __forceinline__ int perm32(int rho) { const int n = rho >> 4, i = rho & 15; return 8 * (i >> 2) + 4 * n + (i & 3); }

struct Unit { int pm, pn; };
struct Gemm { const bf16_t* A; const bf16_t* Bt; int M, N, K; };

struct StaticOrder {
    int nM, nN, nwg, G, c;
    __host__ __device__ void init(int M, int N, int G_, int c_) { nM = M / BM; nN = N / BM; nwg = nM * nN; G = G_; c = c_; }
    __host__ __device__ bool next(int i, Unit& u) const {
        const long L = (long)i * G + c; if (L >= nwg) return false;
        int wgid = (int)L; { const int q = nwg / NXCD, r = nwg % NXCD, xcd = wgid % NXCD, off = wgid / NXCD; wgid = (xcd < r ? xcd * (q + 1) : r * (q + 1) + (xcd - r) * q) + off; }
        const int nig = WGM * nN, gid = wgid / nig, fm = gid * WGM, gsz = (nM - fm) < WGM ? (nM - fm) : WGM;
        u.pm = fm + ((wgid % nig) % gsz); u.pn = (wgid % nig) / gsz; return true;
    }
    __device__ __forceinline__ void a_ready(const Unit&) const {}
    __device__ __forceinline__ void done(const Unit&) const {}
};
__device__ __forceinline__ unsigned cvt_pk_bf16(float lo, float hi) { unsigned r; asm volatile("v_cvt_pk_bf16_f32 %0, %1, %2" : "=v"(r) : "v"(lo), "v"(hi)); return r; }
template <class Epi, class Sched, bool STAMP = false>
__device__ __forceinline__ void gemm_phase(PG8_LAS unsigned char* lds, const Gemm g, const Sched& S, const Epi& E, unsigned long long* stamps) {
    const int tid = threadIdx.x, wid = __builtin_amdgcn_readfirstlane(tid >> 6), lane = tid & 63, wr = wid >> 2, wc = wid & 3, fr = lane & 15, fq = lane >> 4;
    const int K = g.K, nt = K / BK;
    int ts_lo = 0, ts_hi = 0, nts = 0; const unsigned long long rt_entry = STAMP ? (unsigned long long)wall_clock64() : 0ull;
#define PG8_STAMP() do { if (STAMP && wid == 0 && nts < 64) { const unsigned long long _c = (unsigned long long)clock64(); \
        ts_lo = (lane == nts) ? (int)(unsigned)_c : ts_lo; ts_hi = (lane == nts) ? (int)(unsigned)(_c >> 32) : ts_hi; ++nts; } } while (0)
    PG8_STAMP();
    unsigned voffA[2], voffB[2];
#pragma unroll
    for (int i = 0; i < 2; ++i) { int R, C; stage_rc(tid * 16 + i * 8192, R, C); const int Rb = Epi::PERM ? ((R & ~31) + perm32(R & 31)) : R;
        voffA[i] = (unsigned)(R * K + C) * 2u; voffB[i] = (unsigned)(Rb * K + C) * 2u; }
    const size_t kstep = (size_t)(BK * 2);
    const size_t hstep = (size_t)HALF * K * 2;
    const size_t tstep = 2 * hstep;
    const unsigned ldsw = (unsigned)wid * 1024u;
    const int aoff = lds_byte(wr * 64 + fr, fq * 8), boff = lds_byte(wc * 32 + fr, fq * 8);
#define PG8_SA(b, h) (((b) * 2 + (h)) * HTB)
#define PG8_SB(b, h) ((4 + (b) * 2 + (h)) * HTB)
#define PG8_STAGE(bufoff, gbase, voff) do { _Pragma("unroll") for (int _i = 0; _i < 2; ++_i) \
        __builtin_amdgcn_global_load_lds((const unsigned*)((const char*)(gbase) + (voff)[_i]), (PG8_LAS unsigned*)(lds + (bufoff) + ldsw + _i * 8192), 16, 0, 0); } while (0)
#define PG8_LDA(dst, b, h) do { _Pragma("unroll") for (int m = 0; m < 4; ++m) _Pragma("unroll") for (int k = 0; k < 2; ++k) dst[m][k] = *(const PG8_LAS bf16x8*)(lds + PG8_SA(b, h) + aoff + m * 2048 + k * 1024); } while (0)
#define PG8_LDB(dst, b, h) do { _Pragma("unroll") for (int n = 0; n < 2; ++n) _Pragma("unroll") for (int k = 0; k < 2; ++k) dst[n][k] = *(const PG8_LAS bf16x8*)(lds + PG8_SB(b, h) + boff + n * 2048 + k * 1024); } while (0)
#define PG8_MMA(ai, bj, At, Bt) do { __builtin_amdgcn_s_setprio(1); _Pragma("unroll") for (int m = 0; m < 4; ++m) _Pragma("unroll") for (int n = 0; n < 2; ++n) _Pragma("unroll") for (int k = 0; k < 2; ++k) \
        acc[ai][bj][m][n] = __builtin_amdgcn_mfma_f32_16x16x32_bf16(Bt[n][k], At[m][k], acc[ai][bj][m][n], 0, 0, 0); __builtin_amdgcn_s_setprio(0); } while (0)
#define PG8_WAIT_V(n) asm volatile("s_waitcnt vmcnt(" #n ")" ::: "memory")
#define PG8_WAIT_L(n) asm volatile("s_waitcnt lgkmcnt(" #n ")" ::: "memory")
#define PG8_BAR __builtin_amdgcn_s_barrier()
#define PG8_SCHED __builtin_amdgcn_sched_barrier(0)
    Unit cur, nxt; int ui = 0;
    if (!S.next(0, cur)) return;
    f32x4 acc[2][2][4][2];
#pragma unroll
    for (int a = 0; a < 2; ++a)
#pragma unroll
        for (int b = 0; b < 2; ++b)
#pragma unroll
            for (int m = 0; m < 4; ++m)
#pragma unroll
                for (int n = 0; n < 2; ++n) acc[a][b][m][n] = (f32x4){0.f, 0.f, 0.f, 0.f};
    bf16x8 At[4][2], B0[2][2], B1[2][2];
    const char* cA = (const char*)g.A + (size_t)cur.pm * tstep; const char* cB = (const char*)g.Bt + (size_t)cur.pn * tstep;
    S.a_ready(cur);
    PG8_STAGE(PG8_SB(0, 0), cB, voffB); PG8_STAGE(PG8_SA(0, 0), cA, voffA); PG8_STAGE(PG8_SB(0, 1), cB + hstep, voffB); PG8_STAGE(PG8_SA(0, 1), cA + hstep, voffA);
    if (wr == 1) PG8_BAR;
    PG8_WAIT_V(4); PG8_BAR;
    PG8_STAGE(PG8_SB(1, 0), cB + kstep, voffB); PG8_STAGE(PG8_SA(1, 0), cA + kstep, voffA); PG8_STAGE(PG8_SB(1, 1), cB + hstep + kstep, voffB);
    PG8_WAIT_V(6); PG8_BAR;
    PG8_STAMP();
    for (;;) {
        const bool has_next = S.next(ui + 1, nxt);
        const char* nA = has_next ? (const char*)g.A + (size_t)nxt.pm * tstep : cA; const char* nB = has_next ? (const char*)g.Bt + (size_t)nxt.pn * tstep : cB;
        for (int t = 0; t < nt; t += 2) {
            const bool last = (t == nt - 2);
            const char* a1 = cA + (size_t)(t + 1) * kstep;
            const char* a2 = last ? nA : cA + (size_t)(t + 2) * kstep; const char* b2 = last ? nB : cB + (size_t)(t + 2) * kstep;
            const char* a3 = a2 + kstep; const char* b3 = b2 + kstep;
            if (last && has_next) S.a_ready(nxt);
            PG8_LDB(B0, 0, 0); PG8_SCHED; PG8_LDA(At, 0, 0); PG8_STAGE(PG8_SA(1, 1), a1 + hstep, voffA);
            PG8_WAIT_L(8); PG8_BAR; PG8_WAIT_L(0); PG8_MMA(0, 0, At, B0); PG8_BAR; PG8_SCHED;
            PG8_LDB(B1, 0, 1); PG8_STAGE(PG8_SB(0, 0), b2, voffB);
            PG8_BAR; PG8_WAIT_L(0); PG8_MMA(0, 1, At, B1); PG8_BAR;
            PG8_LDA(At, 0, 1); PG8_STAGE(PG8_SA(0, 0), a2, voffA);
            PG8_BAR; PG8_WAIT_L(0); PG8_MMA(1, 0, At, B0); PG8_BAR; PG8_SCHED;
            PG8_STAGE(PG8_SB(0, 1), b2 + hstep, voffB);
            PG8_WAIT_V(6); PG8_BAR; PG8_MMA(1, 1, At, B1); PG8_BAR;
            PG8_LDB(B0, 1, 0); PG8_SCHED; PG8_LDA(At, 1, 0); PG8_STAGE(PG8_SA(0, 1), a2 + hstep, voffA);
            PG8_WAIT_L(8); PG8_BAR; PG8_WAIT_L(0); PG8_MMA(0, 0, At, B0); PG8_BAR; PG8_SCHED;
            PG8_LDB(B1, 1, 1); PG8_STAGE(PG8_SB(1, 0), b3, voffB);
            PG8_BAR; PG8_WAIT_L(0); PG8_MMA(0, 1, At, B1); PG8_BAR;
            PG8_LDA(At, 1, 1); PG8_STAGE(PG8_SA(1, 0), a3, voffA);
            PG8_BAR; PG8_WAIT_L(0); PG8_MMA(1, 0, At, B0); PG8_BAR; PG8_SCHED;
            PG8_STAGE(PG8_SB(1, 1), b3 + hstep, voffB);
            PG8_WAIT_V(6); PG8_BAR; PG8_MMA(1, 1, At, B1); PG8_BAR;
        }
        PG8_STAMP();
        if constexpr (!Epi::AFTER_DRAIN) { E(acc, cur, wr, wc, fr, fq); S.done(cur); }
        PG8_STAMP();
        if (!has_next) break;
#pragma unroll
        for (int a = 0; a < 2; ++a)
#pragma unroll
            for (int b = 0; b < 2; ++b)
#pragma unroll
                for (int m = 0; m < 4; ++m)
#pragma unroll
                    for (int n = 0; n < 2; ++n) acc[a][b][m][n] = (f32x4){0.f, 0.f, 0.f, 0.f};
        cur = nxt; cA = nA; cB = nB; ++ui;
    }
    PG8_WAIT_V(0);
    if (wr == 0) PG8_BAR;
    PG8_BAR;
    if constexpr (Epi::AFTER_DRAIN) { E.fused(acc, cur, wr, wc, fr, fq, lds, wid, lane); S.done(cur); }
    PG8_STAMP();
    if (STAMP && wid == 0) { stamps[lane] = lane < nts ? (((unsigned long long)(unsigned)ts_hi << 32) | (unsigned)ts_lo) : 0ull;
        if (lane == 62) stamps[62] = rt_entry; if (lane == 63) stamps[63] = (unsigned long long)wall_clock64(); }
#undef PG8_STAMP
#undef PG8_SA
#undef PG8_SB
#undef PG8_STAGE
#undef PG8_LDA
#undef PG8_LDB
#undef PG8_MMA
#undef PG8_WAIT_V
#undef PG8_WAIT_L
#undef PG8_BAR
#undef PG8_SCHED
}
}

using pg8::bf16x8; using pg8::f32x4; using pg8::u32x4;
typedef __bf16 bf16x2_t __attribute__((ext_vector_type(2)));
typedef float f32x2_t __attribute__((ext_vector_type(2)));
__device__ __forceinline__ unsigned cvt_pk_bf16(float lo, float hi) { f32x2_t f = {lo, hi}; bf16x2_t b = __builtin_convertvector(f, bf16x2_t); return __builtin_bit_cast(unsigned, b); }
typedef unsigned short u16;
typedef unsigned long long u64;
typedef unsigned u32x2 __attribute__((ext_vector_type(2)));
#define LAS __attribute__((address_space(3)))
#define DI __device__ __forceinline__

constexpr int T_ = 32768, D_ = 1024, DFF = 2816, NUP = 5632, NIN = 4608, SEQ = 8192;
constexpr float ALPHA = 1.41421356237309515f, LN_EPS = 1e-5f, LOG2E = 1.44269504088896f;
constexpr int NTHR = 512;
constexpr int LDS_MAIN = 155648, LDS_BYTES = LDS_MAIN + 16;

constexpr size_t SZ_WUP = (size_t)NUP * D_ * 2, SZ_WDN = (size_t)D_ * DFF * 2, SZ_WIN = (size_t)NIN * D_ * 2, SZ_WGLU = 512 * 512 * 2, SZ_WB = (size_t)1024 * 512 * 2, SZ_WOUT = (size_t)1024 * 1024 * 2;
constexpr size_t OFF_UP1 = 0, OFF_DN1 = OFF_UP1 + SZ_WUP, OFF_WIN = OFF_DN1 + SZ_WDN, OFF_GLU = OFF_WIN + SZ_WIN, OFF_WB0 = OFF_GLU + SZ_WGLU, OFF_WB1 = OFF_WB0 + SZ_WB,
                 OFF_WOUT = OFF_WB1 + SZ_WB, OFF_UP2 = OFF_WOUT + SZ_WOUT, OFF_DN2 = OFF_UP2 + SZ_WUP, SZ_LAYERW = OFF_DN2 + SZ_WDN;
constexpr size_t MiB = 1048576;
constexpr size_t SZ_TABL = 1024 * 1024;
constexpr size_t TAB_A1 = 0, TAB_A64 = 16384, TAB_BB = 32768, TAB_CT = 32768 + 262144, TAB_BBH = TAB_CT + 131072;
constexpr size_t WS_W = 0, WS_TAB = 2 * SZ_LAYERW, WS_XB = WS_TAB + 2 * SZ_TABL, WS_H = WS_XB + 64 * MiB, WS_GS = WS_H + 176 * MiB, WS_GA = WS_GS + 64 * MiB, WS_BAR = WS_GA + 64 * MiB, WS_STATS = WS_BAR + 65536, WS_END = WS_STATS + 262144;
constexpr size_t H_U = 0, H_Q = 32 * MiB, H_K = 64 * MiB, H_V = 96 * MiB, H_QI = 128 * MiB, H_KIB = 144 * MiB, H_WI = 146 * MiB, H_SLOC = 147 * MiB, H_MASK = 155 * MiB;
constexpr int MASK_PER_B = 33024;

struct Args { const float* in[24]; float* out; unsigned char* ws; int lo, hi; };

struct Frame {
    const float* const* in; float* out; unsigned char* ws;
    int tid, lane, wave;
};
#define FP(F, T, off) ((T*)((F).ws + (off)))
#define F_XB(F) FP(F, u16, WS_XB)
#define F_H(F) FP(F, u16, WS_H)
#define F_U(F) FP(F, u16, WS_H + H_U)
#define F_Q(F) FP(F, u16, WS_H + H_Q)
#define F_K(F) FP(F, u16, WS_H + H_K)
#define F_V(F) FP(F, u16, WS_H + H_V)
#define F_QI(F) FP(F, u16, WS_H + H_QI)
#define F_KIB(F) FP(F, u16, WS_H + H_KIB)
#define F_WI(F) FP(F, float, WS_H + H_WI)
#define F_SLOC(F) FP(F, float, WS_H + H_SLOC)
#define F_MASK(F) FP(F, u16, WS_H + H_MASK)
#define F_GS(F) FP(F, u16, WS_GS)
#define F_GA(F) FP(F, u16, WS_GA)
#define F_YS(F) FP(F, u16, WS_XB)
#define F_VT(F) FP(F, u16, WS_XB + 32 * MiB)

DI float bf_lo(unsigned u) { return __uint_as_float(u << 16); }
DI float bf_hi(unsigned u) { return __uint_as_float(u & 0xffff0000u); }
DI float fsigmoid(float x) { return __builtin_amdgcn_rcpf(1.0f + __expf(-x)); }
DI u32x4 pack8(const f32x4& a, const f32x4& b) { u32x4 w; w.x = cvt_pk_bf16(a[0], a[1]); w.y = cvt_pk_bf16(a[2], a[3]); w.z = cvt_pk_bf16(b[0], b[1]); w.w = cvt_pk_bf16(b[2], b[3]); return w; }
DI void unpack8(const u32x4& w, f32x4& a, f32x4& b) { a[0] = bf_lo(w.x); a[1] = bf_hi(w.x); a[2] = bf_lo(w.y); a[3] = bf_hi(w.y); b[0] = bf_lo(w.z); b[1] = bf_hi(w.z); b[2] = bf_lo(w.w); b[3] = bf_hi(w.w); }

struct EpiUp {
    static constexpr bool PERM = true, AFTER_DRAIN = false;
    u16* H;
    DI void operator()(const f32x4 (&acc)[2][2][4][2], const pg8::Unit& u, int wr, int wc, int fr, int fq) const {
        const int row0 = u.pm * 256 + wr * 64 + fr, col0 = u.pn * 128 + wc * 32 + 8 * fq;
#pragma unroll
        for (int ai = 0; ai < 2; ++ai)
#pragma unroll
            for (int m = 0; m < 4; ++m) {
                f32x4 o0, o1;
#pragma unroll
                for (int j = 0; j < 4; ++j) { const float g0 = acc[ai][0][m][0][j], g1 = acc[ai][0][m][1][j]; o0[j] = g0 * fsigmoid(g0) * acc[ai][1][m][0][j]; o1[j] = g1 * fsigmoid(g1) * acc[ai][1][m][1][j]; }
                *(u32x4*)(H + (size_t)(row0 + ai * 128 + m * 16) * DFF + col0) = pack8(o0, o1);
            }
    }
};
struct EpiRes {
    static constexpr bool PERM = false, AFTER_DRAIN = false;
    const float* R; float* Y; float sc; const f32x2_t* st; const float* g; const float* b;
    DI void operator()(const f32x4 (&acc)[2][2][4][2], const pg8::Unit& u, int wr, int wc, int fr, int fq) const {
        const int row0 = u.pm * 256 + wr * 64 + fr, col0 = u.pn * 256 + wc * 32 + 4 * fq;
#pragma unroll
        for (int ai = 0; ai < 2; ++ai)
#pragma unroll
            for (int m = 0; m < 4; ++m) { const int row = row0 + ai * 128 + m * 16; const size_t off = (size_t)row * D_ + col0;
                f32x2_t sr = {0.f, 1.f}; if (st) sr = st[row];
#pragma unroll
                for (int bj = 0; bj < 2; ++bj)
#pragma unroll
                    for (int n = 0; n < 2; ++n) { f32x4 r = *(const f32x4*)(R + off + bj * 128 + n * 16);
                        if (st) { const f32x4 gv = *(const f32x4*)(g + col0 + bj * 128 + n * 16), bv = *(const f32x4*)(b + col0 + bj * 128 + n * 16); r = (r - sr.x) * sr.y * gv + bv; }
                        *(f32x4*)(Y + off + bj * 128 + n * 16) = r * ALPHA + acc[ai][bj][m][n] * sc; }
                asm volatile("" ::: "memory"); }
    }
};
struct EpiIn {
    static constexpr bool PERM = true, AFTER_DRAIN = false;
    unsigned char* ws;
    DI void operator()(const f32x4 (&acc)[2][2][4][2], const pg8::Unit& u, int wr, int wc, int fr, int fq) const {
        const int row0 = u.pm * 256 + wr * 64 + fr, cl = wc * 32 + 8 * fq, pn = u.pn;
        size_t boff; int ld, c0;
        if (pn < 8) { boff = WS_H + (size_t)(pn >> 1) * (32 * MiB); ld = 512; c0 = (pn & 1) * 256; }
        else if (pn == 8) { boff = WS_H + H_QI; ld = 256; c0 = 0; }
        else if (pn == 9) { boff = WS_H + H_KIB; ld = 32; c0 = 0; }
        else { boff = WS_GS + (size_t)((pn - 10) >> 2) * (64 * MiB); ld = 1024; c0 = ((pn - 10) & 3) * 256; }
        u16* base = (u16*)(ws + boff); float* WI = (float*)(ws + WS_H + H_WI);
#pragma unroll
        for (int ai = 0; ai < 2; ++ai)
#pragma unroll
            for (int m = 0; m < 4; ++m) { const size_t row = (size_t)(row0 + ai * 128 + m * 16);
#pragma unroll
                for (int bj = 0; bj < 2; ++bj) { const int c = bj * 128 + cl; f32x4 v0 = acc[ai][bj][m][0], v1 = acc[ai][bj][m][1];
                    if (pn == 9) { if (c < 32) *(u32x4*)(base + row * 32 + c) = pack8(v0, v1); else if (c == 32) { *(f32x4*)(WI + row * 8) = v0; *(f32x4*)(WI + row * 8 + 4) = v1; } }
                    else { if (pn >= 10) {
#pragma unroll
                            for (int j = 0; j < 4; ++j) { v0[j] = fsigmoid(v0[j]); v1[j] = fsigmoid(v1[j]); } }
                        *(u32x4*)(base + row * ld + c0 + c) = pack8(v0, v1); } } }
    }
};
template <int MODE> struct EpiMix {
    static constexpr bool PERM = true, AFTER_DRAIN = false;
    const u16* A; const u16* Bsrc; u16* O; int ldc;
    DI void operator()(const f32x4 (&acc)[2][2][4][2], const pg8::Unit& u, int wr, int wc, int fr, int fq) const {
        const int row0 = u.pm * 256 + wr * 64 + fr, col0 = u.pn * 256 + wc * 32 + 8 * fq;
#pragma unroll
        for (int ai = 0; ai < 2; ++ai)
#pragma unroll
            for (int m = 0; m < 4; ++m) { const size_t off = (size_t)(row0 + ai * 128 + m * 16) * ldc + col0;
#pragma unroll
                for (int bj = 0; bj < 2; ++bj) { f32x4 v0 = acc[ai][bj][m][0], v1 = acc[ai][bj][m][1], a0, a1;
                    const u32x4 aw = *(const u32x4*)(A + off + bj * 128); unpack8(aw, a0, a1);
                    if (MODE == 0) {
#pragma unroll
                        for (int j = 0; j < 4; ++j) { v0[j] = a0[j] * fsigmoid(v0[j]); v1[j] = a1[j] * fsigmoid(v1[j]); } }
                    else if (MODE == 1) { v0 = a0 * v0; v1 = a1 * v1; }
                    else { f32x4 b0, b1; const u32x4 bw = *(const u32x4*)(Bsrc + off + bj * 128); unpack8(bw, b0, b1); v0 = b0 + a0 * v0; v1 = b1 + a1 * v1; }
                    *(u32x4*)(O + off + bj * 128) = pack8(v0, v1); } }
    }
};

template <class Epi> DI void run_gemm(LAS unsigned char* lds, const u16* A, const u16* Bt, int N, int K, const Epi& E) {
    pg8::Gemm g{A, Bt, T_, N, K}; pg8::StaticOrder S; S.init(T_, N, (int)gridDim.x, (int)blockIdx.x);
    pg8::gemm_phase<Epi, pg8::StaticOrder, false>(lds, g, S, E, nullptr);
    __syncthreads();
}

DI int srccol(int map, int n) {
    if (map == 0) return n;
    if (map == 1) { const int pn = n >> 8, r = n & 255; return r < 128 ? 128 * pn + r : DFF + 128 * pn + (r - 128); }
    return n < 2344 ? n : (n < 2560 ? -1 : n - 216);
}
DI void tconv(LAS float* tl  , const float* src, int Nsrc, int K, u16* dst, int Np, int map, int tid) {
    const int tilesN = Np >> 6, tilesK = K >> 6, ntile = tilesN * tilesK;
    for (int t0 = blockIdx.x * 2; t0 < ntile; t0 += gridDim.x * 2) {
        const bool hb = t0 + 1 < ntile; float va[8], vb[8];
        const int c = tid & 63, r0 = tid >> 6;
        { const int tn = t0 % tilesN, tk = t0 / tilesN; const int sc = srccol(map, tn * 64 + c);
#pragma unroll
          for (int rr = 0; rr < 8; ++rr) va[rr] = sc >= 0 ? src[(size_t)(tk * 64 + r0 + 8 * rr) * Nsrc + sc] : 0.f; }
        if (hb) { const int tn = (t0 + 1) % tilesN, tk = (t0 + 1) / tilesN; const int sc = srccol(map, tn * 64 + c);
#pragma unroll
          for (int rr = 0; rr < 8; ++rr) vb[rr] = sc >= 0 ? src[(size_t)(tk * 64 + r0 + 8 * rr) * Nsrc + sc] : 0.f; }
#pragma unroll
        for (int rr = 0; rr < 8; ++rr) { tl[(r0 + 8 * rr) * 65 + c] = va[rr]; if (hb) tl[64 * 65 + (r0 + 8 * rr) * 65 + c] = vb[rr]; }
        __syncthreads();
        { const int kk2 = (tid & 31) * 2, n0 = tid >> 5;
#pragma unroll
          for (int h = 0; h < 2; ++h) { if (h == 1 && !hb) break; const int t = t0 + h, tn = t % tilesN, tk = t / tilesN; LAS float* tt = tl + h * 64 * 65;
#pragma unroll
            for (int rr = 0; rr < 4; ++rr) { const int n = n0 + 16 * rr; *(unsigned*)(dst + (size_t)(tn * 64 + n) * K + tk * 64 + kk2) = cvt_pk_bf16(tt[kk2 * 65 + n], tt[(kk2 + 1) * 65 + n]); } } }
        __syncthreads();
    }
}
DI void ssm_tables(const Frame& F, int l, int g, int p) {
    unsigned char* tab = F.ws + WS_TAB + (size_t)l * SZ_TABL;
    const int lg = l * 32 + g;
    const double lr = fmin((double)F.in[6][lg * 64 + p], -1e-4), li = (double)F.in[7][lg * 64 + p], dt = exp((double)F.in[8][lg]);
    const double zr = lr * dt, zi = li * dt, ea = exp(zr);
    double ar = ea * cos(zi), ai = ea * sin(zi);
    const double nr = ar - 1.0, ni = ai, den = lr * lr + li * li, fr_ = (nr * lr + ni * li) / den, fi_ = (ni * lr - nr * li) / den;
    ((float*)(tab + TAB_A1))[(g * 64 + p) * 2] = (float)ar; ((float*)(tab + TAB_A1))[(g * 64 + p) * 2 + 1] = (float)ai;
    double pr = ar, pi = ai;
#pragma unroll 1
    for (int s = 0; s < 6; ++s) { const double t = pr * pr - pi * pi; pi = 2.0 * pr * pi; pr = t; }
    ((float*)(tab + TAB_A64))[(g * 64 + p) * 2] = (float)pr; ((float*)(tab + TAB_A64))[(g * 64 + p) * 2 + 1] = (float)pi;
    float* BB = (float*)(tab + TAB_BB) + (size_t)g * 32 * 64;
    const float* bre = F.in[9] + ((size_t)lg * 64 + p) * 16; const float* bim = F.in[10] + ((size_t)lg * 64 + p) * 16;
    u16* BBH = (u16*)(tab + TAB_BBH) + (size_t)g * 128 * 16;
#pragma unroll 1
    for (int h = 0; h < 16; ++h) { const double br = bre[h], bi = bim[h]; const float vr = (float)(fr_ * br - fi_ * bi), vi = (float)(fr_ * bi + fi_ * br); BB[(2 * h) * 64 + p] = vr; BB[(2 * h + 1) * 64 + p] = vi;
        const unsigned pk = cvt_pk_bf16(vr, vi); BBH[(2 * p) * 16 + h] = (u16)(pk & 0xffffu); BBH[(2 * p + 1) * 16 + h] = (u16)(pk >> 16); }
    u16* CT = (u16*)(tab + TAB_CT) + (size_t)g * 16 * 128;
    const float* cre = F.in[11] + (size_t)lg * 16 * 64; const float* cim = F.in[12] + (size_t)lg * 16 * 64;
#pragma unroll 1
    for (int h = 0; h < 16; ++h) { *(unsigned*)(CT + h * 128 + 2 * p) = cvt_pk_bf16(cre[h * 64 + p], -cim[h * 64 + p]); }
}
DI void p0_phase(const Frame& F, LAS unsigned char* lds) {
    LAS float* tl = (LAS float*)lds;
    for (int l = 0; l < 2; ++l) {
        unsigned char* wl = F.ws + WS_W + (size_t)l * SZ_LAYERW;
        tconv(tl, F.in[1] + (size_t)l * D_ * NUP, NUP, D_, (u16*)(wl + OFF_UP1), NUP, 1, F.tid);
        tconv(tl, F.in[2] + (size_t)l * DFF * D_, D_, DFF, (u16*)(wl + OFF_DN1), D_, 0, F.tid);
        tconv(tl, F.in[5] + (size_t)l * D_ * 4392, 4392, D_, (u16*)(wl + OFF_WIN), NIN, 2, F.tid);
        tconv(tl, F.in[14] + (size_t)l * 512 * 512, 512, 512, (u16*)(wl + OFF_GLU), 512, 0, F.tid);
        tconv(tl, F.in[15] + (size_t)(l * 2 + 0) * 512 * 1024, 1024, 512, (u16*)(wl + OFF_WB0), 1024, 0, F.tid);
        tconv(tl, F.in[15] + (size_t)(l * 2 + 1) * 512 * 1024, 1024, 512, (u16*)(wl + OFF_WB1), 1024, 0, F.tid);
        tconv(tl, F.in[16] + (size_t)l * 1024 * 1024, 1024, 1024, (u16*)(wl + OFF_WOUT), 1024, 0, F.tid);
        tconv(tl, F.in[19] + (size_t)l * D_ * NUP, NUP, D_, (u16*)(wl + OFF_UP2), NUP, 1, F.tid);
        tconv(tl, F.in[20] + (size_t)l * DFF * D_, D_, DFF, (u16*)(wl + OFF_DN2), D_, 0, F.tid);
    }
    { const size_t n4 = (size_t)T_ * D_ / 4, step = (size_t)gridDim.x * NTHR; const f32x4* x4 = (const f32x4*)F.in[0]; u32x2* o = (u32x2*)F_XB(F);
      for (size_t i = (size_t)blockIdx.x * NTHR + F.tid; i < n4; i += 4 * step) { f32x4 v[4];
#pragma unroll
          for (int j = 0; j < 4; ++j) if (i + j * step < n4) v[j] = x4[i + j * step];
#pragma unroll
          for (int j = 0; j < 4; ++j) if (i + j * step < n4) { u32x2 w; w.x = cvt_pk_bf16(v[j][0], v[j][1]); w.y = cvt_pk_bf16(v[j][2], v[j][3]); o[i + j * step] = w; } } }
    { const int gw = blockIdx.x * 8 + F.wave; if (gw < 64) ssm_tables(F, gw >> 5, gw & 31, F.lane); }
}

DI float wave_sum(float v) {
#pragma unroll
    for (int o = 32; o >= 1; o >>= 1) v += __shfl_xor(v, o);
    return v;
}
DI void ln_phase(const Frame& F, const float* g, const float* b, bool final) {
    const int lane = F.lane; f32x4 gv[4], bv[4];
#pragma unroll
    for (int i = 0; i < 4; ++i) { gv[i] = *(const f32x4*)(g + i * 256 + lane * 4); bv[i] = *(const f32x4*)(b + i * 256 + lane * 4); }
    const int stride = gridDim.x * 8; f32x2_t* stats = (f32x2_t*)(F.ws + WS_STATS);
    for (int row0 = blockIdx.x * 8 + F.wave; row0 < T_; row0 += 2 * stride) {
        const int row1 = row0 + stride < T_ ? row0 + stride : row0;
        float* p0 = F.out + (size_t)row0 * D_; float* p1 = F.out + (size_t)row1 * D_; f32x4 v[4], u[4]; float s0 = 0.f, s1 = 0.f;
#pragma unroll
        for (int i = 0; i < 4; ++i) { v[i] = *(const f32x4*)(p0 + i * 256 + lane * 4); u[i] = *(const f32x4*)(p1 + i * 256 + lane * 4); }
#pragma unroll
        for (int i = 0; i < 4; ++i) { s0 += (v[i][0] + v[i][1]) + (v[i][2] + v[i][3]); s1 += (u[i][0] + u[i][1]) + (u[i][2] + u[i][3]); }
        const float mean0 = wave_sum(s0) * (1.0f / 1024.0f), mean1 = wave_sum(s1) * (1.0f / 1024.0f); float q0 = 0.f, q1 = 0.f;
#pragma unroll
        for (int i = 0; i < 4; ++i) { v[i] = v[i] - mean0; u[i] = u[i] - mean1; q0 += (v[i][0] * v[i][0] + v[i][1] * v[i][1]) + (v[i][2] * v[i][2] + v[i][3] * v[i][3]); q1 += (u[i][0] * u[i][0] + u[i][1] * u[i][1]) + (u[i][2] * u[i][2] + u[i][3] * u[i][3]); }
        const float rstd0 = rsqrtf(wave_sum(q0) * (1.0f / 1024.0f) + LN_EPS), rstd1 = rsqrtf(wave_sum(q1) * (1.0f / 1024.0f) + LN_EPS);
        if (!final && lane == 0) { stats[row0] = (f32x2_t){mean0, rstd0}; if (row1 != row0) stats[row1] = (f32x2_t){mean1, rstd1}; }
#pragma unroll
        for (int i = 0; i < 4; ++i) { const f32x4 y = v[i] * rstd0 * gv[i] + bv[i]; if (final) *(f32x4*)(p0 + i * 256 + lane * 4) = y;
            else { u32x2 w; w.x = cvt_pk_bf16(y[0], y[1]); w.y = cvt_pk_bf16(y[2], y[3]); *(u32x2*)(F_XB(F) + (size_t)row0 * D_ + i * 256 + lane * 4) = w; } }
        if (row1 != row0) {
#pragma unroll
            for (int i = 0; i < 4; ++i) { const f32x4 y = u[i] * rstd1 * gv[i] + bv[i]; if (final) *(f32x4*)(p1 + i * 256 + lane * 4) = y;
                else { u32x2 w; w.x = cvt_pk_bf16(y[0], y[1]); w.y = cvt_pk_bf16(y[2], y[3]); *(u32x2*)(F_XB(F) + (size_t)row1 * D_ + i * 256 + lane * 4) = w; } } }
    }
}

DI void wave_lds_fence() { asm volatile("s_waitcnt lgkmcnt(0)" ::: "memory"); __builtin_amdgcn_wave_barrier(); }
DI float gelu_tanh(float x) { const float z = 0.7978845608028654f * (x + 0.044715f * x * x * x); return x * __builtin_amdgcn_rcpf(1.0f + __expf(-2.0f * z)); }

DI void vt_tile(const Frame& F, LAS unsigned char* wl, int tile) {
    LAS u16* tb = (LAS u16*)wl;
    const int tt = tile >> 3, hb = tile & 7, lane = F.lane; const int t0 = tt * 64;
    const u16* src = F_V(F) + (size_t)(t0 + lane) * 512 + hb * 64;
#pragma unroll
    for (int c = 0; c < 8; ++c) *(LAS u32x4*)(tb + lane * 72 + c * 8) = *(const u32x4*)(src + c * 8);
    wave_lds_fence();
    const int b = t0 >> 13, tl = t0 & 8191;
    u16* dst = F_VT(F) + ((size_t)(b * 512 + hb * 64 + lane)) * SEQ + tl;
#pragma unroll
    for (int c = 0; c < 8; ++c) { u32x4 w; unsigned e[8];
#pragma unroll
        for (int j = 0; j < 8; ++j) e[j] = tb[(c * 8 + j) * 72 + lane];
        w.x = e[0] | (e[1] << 16); w.y = e[2] | (e[3] << 16); w.z = e[4] | (e[5] << 16); w.w = e[6] | (e[7] << 16);
        *(u32x4*)(dst + c * 8) = w; }
    wave_lds_fence();
}
struct SsmP { float ar, ai, cr, ci; };
DI void ssm_load_g(const unsigned char* tab, const float* dskip, int g, int lane, float& ar, float& ai, float& cr, float& ci, bf16x8 (&af)[8], bf16x8 (&cf)[4], f32x4& dv) {
    ar = ((const float*)(tab + TAB_A1))[(g * 64 + lane) * 2]; ai = ((const float*)(tab + TAB_A1))[(g * 64 + lane) * 2 + 1];
    cr = ((const float*)(tab + TAB_A64))[(g * 64 + lane) * 2]; ci = ((const float*)(tab + TAB_A64))[(g * 64 + lane) * 2 + 1];
    const int lq = lane & 15, g4 = lane >> 4;
    const u16* BBH = (const u16*)(tab + TAB_BBH) + (size_t)g * 128 * 16;
#pragma unroll
    for (int mt = 0; mt < 8; ++mt) { const u32x4 z = {0u, 0u, 0u, 0u}; af[mt] = g4 < 2 ? *(const bf16x8*)(BBH + (mt * 16 + lq) * 16 + g4 * 8) : __builtin_bit_cast(bf16x8, z); }
    const u16* CT = (const u16*)(tab + TAB_CT) + (size_t)g * 16 * 128;
#pragma unroll
    for (int ks = 0; ks < 4; ++ks) cf[ks] = *(const bf16x8*)(CT + lq * 128 + ks * 32 + g4 * 8);
    dv = *(const f32x4*)(dskip + g * 16 + g4 * 4);
}
DI void ssm_bu_tile(const Frame& F, LAS unsigned* bt  , int t0, int g, const bf16x8 (&af)[8], int lq, int g4) {
    bf16x8 bf[4];
#pragma unroll
    for (int nt = 0; nt < 4; ++nt) { const u32x4 z = {0u, 0u, 0u, 0u}; bf[nt] = g4 < 2 ? *(const bf16x8*)(F_U(F) + (size_t)(t0 + nt * 16 + lq) * 512 + g * 16 + g4 * 8) : __builtin_bit_cast(bf16x8, z); }
#pragma unroll
    for (int nt = 0; nt < 4; ++nt)
#pragma unroll
        for (int mt = 0; mt < 8; ++mt) { const f32x4 z = {0.f, 0.f, 0.f, 0.f}; const f32x4 acc = __builtin_amdgcn_mfma_f32_16x16x32_bf16(af[mt], bf[nt], z, 0, 0, 0);
            u32x2 w; w.x = cvt_pk_bf16(acc[0], acc[1]); w.y = cvt_pk_bf16(acc[2], acc[3]);
            *(LAS u32x2*)(bt + (nt * 16 + lq) * 68 + mt * 8 + g4 * 2) = w; }
}
DI void ssmA_item(const Frame& F, LAS unsigned char* wl, int item, const float ar, const float ai, const bf16x8 (&af)[8]) {
    LAS unsigned* bt = (LAS unsigned*)wl;
    const int chunk = item >> 5, g = item & 31, lane = F.lane; const int t0 = chunk * 64;
    ssm_bu_tile(F, bt, t0, g, af, lane & 15, lane >> 4);
    wave_lds_fence();
    float sr = 0.f, si = 0.f;
#pragma unroll 8
    for (int j = 0; j < 64; ++j) { const unsigned w = bt[j * 68 + lane]; const float br = bf_lo(w), bi = bf_hi(w);
        const float nr = ar * sr - ai * si + br, ni = ar * si + ai * sr + bi; sr = nr; si = ni; }
    *(float2*)(F_SLOC(F) + ((size_t)item * 64 + lane) * 2) = make_float2(sr, si);
    wave_lds_fence();
}
DI void ssmC_item(const Frame& F, LAS unsigned char* wl, int item, const float ar, const float ai, const float cr, const float ci, const bf16x8 (&af)[8], const bf16x8 (&cf)[4], const f32x4 dv, float& sr, float& si, bool first) {
    LAS u16* ut = (LAS u16*)wl;
    LAS unsigned* st = (LAS unsigned*)(wl + 2048);
    const int chunk = item >> 5, g = item & 31, lane = F.lane, lq = lane & 15, g4 = lane >> 4; const int t0 = chunk * 64;
    { const u16* up = F_U(F) + (size_t)(t0 + lane) * 512 + g * 16; const u32x4 a = *(const u32x4*)up, b = *(const u32x4*)(up + 8);
      *(LAS u32x4*)(ut + lane * 16) = a; *(LAS u32x4*)(ut + lane * 16 + 8) = b; }
    if (first) { sr = 0.f; si = 0.f;
      const int cin = chunk & 127, c0 = chunk - cin; const float2* sl = (const float2*)F_SLOC(F) + ((size_t)c0 * 32 + g) * 64 + lane;
#pragma unroll 8
      for (int c = 0; c < cin; ++c) { const float2 v = sl[(size_t)c * 32 * 64]; const float nr = cr * sr - ci * si + v.x, ni = cr * si + ci * sr + v.y; sr = nr; si = ni; } }
    ssm_bu_tile(F, st, t0, g, af, lq, g4);
    wave_lds_fence();
#pragma unroll 8
    for (int j = 0; j < 64; ++j) { const unsigned w = st[j * 68 + lane]; const float br = bf_lo(w), bi = bf_hi(w);
        const float nr = ar * sr - ai * si + br, ni = ar * si + ai * sr + bi; sr = nr; si = ni;
        st[j * 68 + lane] = cvt_pk_bf16(sr, si); }
    wave_lds_fence();
#pragma unroll
    for (int mt = 0; mt < 4; ++mt) {
        f32x4 acc = {0.f, 0.f, 0.f, 0.f};
#pragma unroll
        for (int ks = 0; ks < 4; ++ks) { const bf16x8 sf = *(LAS bf16x8*)(st + (mt * 16 + lq) * 68 + ks * 16 + g4 * 4); acc = __builtin_amdgcn_mfma_f32_16x16x32_bf16(cf[ks], sf, acc, 0, 0, 0); }
        const int l = mt * 16 + lq; const u32x2 uw = *(LAS u32x2*)(ut + l * 16 + g4 * 4);
        const float u0 = bf_lo(uw.x), u1 = bf_hi(uw.x), u2 = bf_lo(uw.y), u3 = bf_hi(uw.y);
        u32x2 o; o.x = cvt_pk_bf16(gelu_tanh(acc[0] + dv[0] * u0), gelu_tanh(acc[1] + dv[1] * u1)); o.y = cvt_pk_bf16(gelu_tanh(acc[2] + dv[2] * u2), gelu_tanh(acc[3] + dv[3] * u3));
        *(u32x2*)(F_U(F) + (size_t)(t0 + l) * 512 + g * 16 + g4 * 4) = o;
    }
    wave_lds_fence();
}

DI unsigned fkey(float x) { const int u = __float_as_int(x); return (unsigned)u ^ ((unsigned)(u >> 31) | 0x80000000u); }
DI f32x4 idx_scores(const bf16x8 af, const bf16x8 (&qf)[8], const float (&w)[8]) {
    f32x4 a[8];
#pragma unroll
    for (int h = 0; h < 8; ++h) { const f32x4 z = {0.f, 0.f, 0.f, 0.f}; a[h] = __builtin_amdgcn_mfma_f32_16x16x32_bf16(af, qf[h], z, 0, 0, 0); }
    f32x2_t s01 = {0.f, 0.f}, s23 = {0.f, 0.f};
#pragma unroll
    for (int h = 0; h < 8; ++h) {
        const float r0 = __int_as_float(max(__float_as_int(a[h][0]), 0)), r1 = __int_as_float(max(__float_as_int(a[h][1]), 0));
        const float r2 = __int_as_float(max(__float_as_int(a[h][2]), 0)), r3 = __int_as_float(max(__float_as_int(a[h][3]), 0));
        const f32x2_t ww = {w[h], w[h]}; s01 = __builtin_elementwise_fma(ww, (f32x2_t){r0, r1}, s01); s23 = __builtin_elementwise_fma(ww, (f32x2_t){r2, r3}, s23);
    }
    return (f32x4){s01[0], s01[1], s23[0], s23[1]};
}
DI void idx_load4(bf16x8 (&af)[4], const u16* kib, int kb, unsigned voff) {
    const char* p = (const char*)(kib + (size_t)kb * 64 * 32);
#pragma unroll
    for (int st = 0; st < 4; ++st) af[st] = __builtin_bit_cast(bf16x8, *(const u32x4*)(p + st * 1024 + voff));
}
DI unsigned wave_usum(unsigned v) {
#pragma unroll
    for (int o = 32; o >= 1; o >>= 1) v += (unsigned)__shfl_xor((int)v, o);
    return v;
}
DI unsigned wave_suffix(unsigned c, int lane) {
    unsigned s = c;
#pragma unroll
    for (int off = 1; off < 64; off <<= 1) { const unsigned t = __shfl_down(s, off); if (lane + off < 64) s += t; }
    return s;
}
constexpr int HS = 2052;
DI bool idx_select(LAS unsigned* hist, LAS unsigned* rpre, LAS unsigned* rneed, int row, int lane, int dbits, unsigned& ne_out) {
    LAS unsigned* h = hist + row * HS; unsigned c = 0;
#pragma unroll
    for (int j = 0; j < 8; ++j) { const u32x4 v = *(LAS u32x4*)(h + lane * 32 + j * 4); c += (v.x & 0xffffu) + (v.x >> 16) + (v.y & 0xffffu) + (v.y >> 16) + (v.z & 0xffffu) + (v.z >> 16) + (v.w & 0xffffu) + (v.w >> 16); }
    const unsigned s = wave_suffix(c, lane), need = rneed[row];
    const u64 bal = __ballot(s >= need); const int L = 63 - __clzll(bal);
    const unsigned cum_hi = __shfl(s - c, L);
    const unsigned v = ((LAS u16*)h)[L * 64 + lane];
    const unsigned s2 = wave_suffix(v, lane);
    const u64 bal2 = __ballot(cum_hi + s2 >= need); const int l2 = 63 - __clzll(bal2);
    const unsigned cum = __shfl(cum_hi + s2 - v, l2), ne = __shfl(v, l2), nn = need - cum;
    if (lane == 0) { rpre[row] = (rpre[row] << dbits) | (unsigned)(L * 64 + l2); rneed[row] = nn; }
    ne_out = ne;
    return nn < ne;
}
#ifndef REPM
#define REPM 0
#endif
DI void idx_phase(const Frame& F, LAS unsigned char* lds) {
    LAS unsigned* hist = (LAS unsigned*)lds;
    LAS unsigned* rpre = (LAS unsigned*)(lds + 16 * HS * 4);
    LAS unsigned* rneed = rpre + 16; LAS unsigned* rcut = rpre + 32; LAS unsigned* rp3 = rpre + 48; LAS unsigned* flags = rpre + 64;
    LAS unsigned* lcnt = rpre + 80; LAS unsigned* lkey = hist; LAS unsigned* lidx = hist + 4096;
    constexpr unsigned CAP6 = 512u; LAS unsigned* lkey6 = hist; LAS unsigned* lidx6 = hist + 8192; LAS u16* lmask = (LAS u16*)(hist + 16384);
    const int tid = F.tid, lane = F.lane, wave = F.wave, lq = lane & 15, g4 = lane >> 4;
    const unsigned voff = (unsigned)(lq * 64 + g4 * 16);
    for (int pair = blockIdx.x; pair < 256; pair += gridDim.x) {
        const int b = pair >> 6, jj = pair & 63;
        const u16* kib = F_KIB(F) + (size_t)b * SEQ * 32;
#pragma unroll 1
        for (int it = 0; it < 8; ++it) {
            const int which = it >> 2, sub = it & 3, tile = which ? 127 - jj : jj, nkb = tile + 1;
            const size_t tq = (size_t)b * SEQ + tile * 64 + sub * 16 + lq;
            bf16x8 qf[8]; float w[8];
#pragma unroll
            for (int h = 0; h < 8; ++h) qf[h] = *(const bf16x8*)(F_QI(F) + tq * 256 + h * 32 + g4 * 8);
            { const f32x4 w0 = *(const f32x4*)(F_WI(F) + tq * 8), w1 = *(const f32x4*)(F_WI(F) + tq * 8 + 4);
#pragma unroll
              for (int i = 0; i < 4; ++i) { w[i] = w0[i]; w[4 + i] = w1[i]; } }
            const size_t mbase = (size_t)b * MASK_PER_B + (size_t)(tile + 1) * (2 * tile + sub);
            if (tid < 16) { rpre[tid] = 0u; rneed[tid] = 256u; rcut[tid] = 0x7fffffffu; rp3[tid] = 0u; }
            if (tid == 0) { flags[0] = 0u; flags[1] = 0u; flags[2] = 0u; }
            int mode = nkb > 4 ? 1 : 4; bool rep_done = false; (void)rep_done;
#pragma unroll 1
            while (true) {
                if (mode < 3) { for (int i = tid; i < 4 * HS; i += NTHR) ((LAS u32x4*)hist)[i] = (u32x4){0u, 0u, 0u, 0u}; }
                if ((mode == 3 || mode == 6) && tid < 16) lcnt[tid] = 0u;
                __syncthreads();
                unsigned thr = 0u, cut = 0x7fffffffu, pre = rpre[lq], rem = rneed[lq], mycut = 0x7fffffffu; const bool p3 = rp3[lq] != 0u, need_res = rcut[lq] == 0xffffffffu;
                const unsigned st3 = rp3[lq]; unsigned tsh = 8u;
                if (mode == 4 && nkb > 4) { thr = pre; if (st3 != 0u) cut = rcut[lq]; if (st3 == 1u) tsh = 0u; }
                const u64 tcomp = ((u64)thr << 32) | (u64)(~cut);
                const int kb0 = mode == 5 ? 0 : wave, kstep = mode == 5 ? 1 : 8;
                const unsigned dsh = mode == 1 ? 20u : 8u, psh = mode == 1 ? 32u : 20u;
                if (kb0 < nkb && (mode != 5 || wave == 0)) {
                    bf16x8 af[4], nf[4];
                    idx_load4(af, kib, kb0, voff);
                    __builtin_amdgcn_s_waitcnt(0x0F70);
#pragma unroll 1
                    for (int kb = kb0; kb < nkb; kb += kstep) {
                        if (kb + kstep < nkb) idx_load4(nf, kib, kb + kstep, voff);
                        unsigned bits = 0u;
#pragma unroll
                        for (int st = 0; st < 4; ++st) {
                            const f32x4 sc = idx_scores(af[st], qf, w);
                            unsigned key[4];
#pragma unroll
                            for (int i = 0; i < 4; ++i) key[i] = fkey(sc[i]);
                            if (mode == 4) {
#pragma unroll
                                for (int i = 0; i < 4; ++i) { const unsigned idx = (unsigned)(kb * 64 + st * 16 + g4 * 4 + i); const u64 comp = ((u64)(key[i] >> tsh) << 32) | (u64)(~idx); bits |= (comp >= tcomp ? 1u : 0u) << (st * 4 + i); }
                            } else if (mode == 5) {
                                int tie[4]; int any = 0;
#pragma unroll
                                for (int i = 0; i < 4; ++i) { tie[i] = (need_res && (key[i] >> 8) == pre) ? 1 : 0; any |= tie[i]; }
                                if (__any(any)) {
#pragma unroll
                                    for (int gg = 0; gg < 4; ++gg)
#pragma unroll
                                        for (int i = 0; i < 4; ++i) { const int f = (g4 == gg) ? tie[i] : 0; const int c = __shfl(f, gg * 16 + lq);
                                            if (c && rem > 0u) { --rem; if (rem == 0u) mycut = (unsigned)(kb * 64 + st * 16 + gg * 4 + i); } }
                                }
                            } else if (mode == 6) {
                                int m4 = 0;
#pragma unroll
                                for (int i = 0; i < 4; ++i) { const unsigned k12 = key[i] >> 20; bits |= (k12 > pre ? 1u : 0u) << (st * 4 + i); m4 |= (k12 == pre) ? (1 << i) : 0; }
                                if (__any(m4)) {
#pragma unroll
                                    for (int i = 0; i < 4; ++i) if ((m4 >> i) & 1) { const unsigned slot = __hip_atomic_fetch_add(lcnt + lq, 1u, __ATOMIC_RELAXED, __HIP_MEMORY_SCOPE_WORKGROUP);
                                        if (slot < CAP6) { lkey6[lq * CAP6 + slot] = key[i]; lidx6[lq * CAP6 + slot] = (unsigned)(kb * 64 + st * 16 + g4 * 4 + i); } }
                                }
                            } else if (mode == 3) {
                                int m4 = 0;
#pragma unroll
                                for (int i = 0; i < 4; ++i) m4 |= (p3 && (key[i] >> 8) == pre) ? (1 << i) : 0;
                                if (__any(m4)) {
#pragma unroll
                                    for (int i = 0; i < 4; ++i) if ((m4 >> i) & 1) { const unsigned slot = __hip_atomic_fetch_add(lcnt + lq, 1u, __ATOMIC_RELAXED, __HIP_MEMORY_SCOPE_WORKGROUP);
                                        if (slot < 256u) { lkey[lq * 256 + slot] = key[i]; lidx[lq * 256 + slot] = (unsigned)(kb * 64 + st * 16 + g4 * 4 + i); } }
                                }
                            } else if (mode == 1) {
#pragma unroll
                                for (int i = 0; i < 4; ++i) { const unsigned digit = key[i] >> 20;
                                    __hip_atomic_fetch_add(hist + lq * HS + (digit >> 1), 1u << ((digit & 1u) * 16), __ATOMIC_RELAXED, __HIP_MEMORY_SCOPE_WORKGROUP); }
                            } else {
#pragma unroll
                                for (int i = 0; i < 4; ++i) { const unsigned digit = (key[i] >> dsh) & 4095u; const bool ok = (unsigned)((u64)key[i] >> psh) == pre;
                                    __hip_atomic_fetch_add(hist + lq * HS + (digit >> 1), ok ? (1u << ((digit & 1u) * 16)) : 0u, __ATOMIC_RELAXED, __HIP_MEMORY_SCOPE_WORKGROUP); }
                            }
                            __builtin_amdgcn_sched_barrier(0);
                        }
                        if (mode == 4) F_MASK(F)[(mbase + kb) * 64 + lane] = (u16)(nkb > 4 ? bits : 0xffffu);
                        if (mode == 6) lmask[kb * 64 + lane] = (u16)bits;
#pragma unroll
                        for (int st = 0; st < 4; ++st) af[st] = nf[st];
                    }
                    if (mode == 5 && need_res && g4 == 0) rcut[lq] = mycut;
                }
                __syncthreads();
#if REPM
                if (mode == REPM && !rep_done) { rep_done = true; continue; }
#endif
                if (mode == 6) {
#pragma unroll 1
                    for (int r = 0; r < 2; ++r) { const int row = wave * 2 + r; const unsigned n = lcnt[row], need = rneed[row];
                        unsigned low[8], xi[8];
#pragma unroll
                        for (int c = 0; c < 8; ++c) { const unsigned e = (unsigned)(c * 64 + lane); const bool valid = e < n; low[c] = valid ? (lkey6[row * CAP6 + e] & 0xfffffu) + 1u : 0u; xi[c] = valid ? lidx6[row * CAP6 + e] : 0xffffffffu; }
                        unsigned t20 = 0u;
#pragma unroll 1
                        for (int bb = 20; bb >= 0; --bb) { const unsigned t = t20 | (1u << bb); unsigned cnt = 0u;
#pragma unroll
                            for (int c = 0; c < 8; ++c) cnt += (unsigned)__popcll(__ballot(low[c] >= t));
                            if (cnt >= need) t20 = t; }
                        unsigned cgt = 0u, ceq = 0u;
#pragma unroll
                        for (int c = 0; c < 8; ++c) { cgt += (unsigned)__popcll(__ballot(low[c] > t20)); ceq += (unsigned)__popcll(__ballot(low[c] == t20)); }
                        const unsigned need_eq = need - cgt; unsigned cut6 = 0x7fffffffu;
                        if (ceq > need_eq) {
                            unsigned cc = 0u;
#pragma unroll 1
                            for (int bb = 12; bb >= 0; --bb) { const unsigned t = cc | (1u << bb); unsigned cnt = 0u;
#pragma unroll
                                for (int c = 0; c < 8; ++c) cnt += (unsigned)__popcll(__ballot(low[c] == t20 && xi[c] < t));
                                if (cnt < need_eq) cc = t; }
                            cut6 = cc; }
#pragma unroll
                        for (int c = 0; c < 8; ++c) { if (low[c] != 0u && (low[c] > t20 || (low[c] == t20 && xi[c] <= cut6))) { const unsigned idx = xi[c];
                                const unsigned hw = (idx >> 6) * 64u + ((idx >> 2) & 3u) * 16u + (unsigned)row, bit = ((idx >> 4) & 3u) * 4u + (idx & 3u);
                                __hip_atomic_fetch_or((LAS unsigned*)lmask + (hw >> 1), 1u << (16u * (hw & 1u) + bit), __ATOMIC_RELAXED, __HIP_MEMORY_SCOPE_WORKGROUP); } }
                    }
                    __syncthreads();
#pragma unroll 1
                    for (int kb = wave; kb < nkb; kb += 8) F_MASK(F)[(mbase + kb) * 64 + lane] = lmask[kb * 64 + lane];
                    __syncthreads();
                    break;
                }
                if (mode == 4) break;
                if (mode == 5) { mode = 4; continue; }
#pragma unroll 1
                for (int r = 0; r < 2; ++r) { const int row = wave * 2 + r;
                    if (mode == 3) {
                        if (rp3[row] == 0u) continue;
                        const unsigned n = lcnt[row];
                        if (n > 256u) { if (lane == 0) { rcut[row] = 0xffffffffu; rp3[row] = 2u; flags[1] = 1u; } continue; }
                        unsigned ki[4], xi[4], rank[4];
#pragma unroll
                        for (int c = 0; c < 4; ++c) { const unsigned e = (unsigned)(c * 64 + lane); ki[c] = e < n ? lkey[row * 256 + e] : 0u; xi[c] = e < n ? lidx[row * 256 + e] : 0xffffffffu; rank[c] = 0u; }
#pragma unroll 1
                        for (unsigned j = 0; j < n; ++j) { const unsigned kj = lkey[row * 256 + j], xj = lidx[row * 256 + j];
#pragma unroll
                            for (int c = 0; c < 4; ++c) rank[c] += (kj > ki[c] || (kj == ki[c] && xj < xi[c])) ? 1u : 0u; }
                        const unsigned want = rneed[row];
#pragma unroll
                        for (int c = 0; c < 4; ++c) if ((unsigned)(c * 64 + lane) < n && rank[c] + 1u == want) { rpre[row] = ki[c]; rcut[row] = xi[c]; }
                        continue;
                    }
                    unsigned ne; const bool over = idx_select(hist, rpre, rneed, row, lane, 12, ne);
                    if (mode == 1 && ne > CAP6 && lane == 0) flags[2] = 1u;
                    if (over && lane == 0 && mode == 2) { rp3[row] = 1u; flags[0] = 1u; } }
                __syncthreads();
                if (mode == 1) mode = flags[2] == 0u ? 6 : 2; else if (mode == 2) mode = flags[0] != 0u ? 3 : 4; else mode = flags[1] != 0u ? 5 : 4;
            }
        }
    }
}

DI int t5_bucket(int rel) {
    const int n = rel < 0 ? -rel : rel;
    const int lg = 8 + (n >= 12) + (n >= 16) + (n >= 23) + (n >= 32) + (n >= 46) + (n >= 64) + (n >= 91);
    return (rel > 0 ? 16 : 0) + (n < 8 ? n : lg);
}
DI u32x4 ldg16(const void* sbase, unsigned voff) { return *(const u32x4*)((const char*)sbase + voff); }
constexpr int NH = 1;
constexpr int RT = 2;
constexpr int KP = NH * 64 + 8, VP = 72;
template <bool NEAR>
DI void att_tile_old(LAS u16* Kb, LAS u16* Vb, LAS float* bl, const unsigned (&bits)[RT], int kt, int rowl, int lq, int g4, const bf16x8 (&qf)[RT][NH][2], f32x4 (&O)[RT][NH][4], float (&m)[RT][NH], float (&l)[RT][NH]) {
#pragma unroll
    for (int hl = 0; hl < NH; ++hl) {
        f32x4 s[RT][4];
#pragma unroll
        for (int nt = 0; nt < 4; ++nt) {
#pragma unroll
            for (int rt = 0; rt < RT; ++rt) s[rt][nt] = (f32x4){0.f, 0.f, 0.f, 0.f};
#pragma unroll
            for (int ks = 0; ks < 2; ++ks) { const bf16x8 a = *(LAS bf16x8*)(Kb + (nt * 16 + lq) * KP + hl * 64 + ks * 32 + g4 * 8);
#pragma unroll
                for (int rt = 0; rt < RT; ++rt) s[rt][nt] = __builtin_amdgcn_mfma_f32_16x16x32_bf16(a, qf[rt][hl][ks], s[rt][nt], 0, 0, 0); } }
        const float bfar = bl[15 * 4 + hl];
        bf16x8 pb[RT][2];
#pragma unroll
        for (int rt = 0; rt < RT; ++rt) {
            float mx = -INFINITY;
#pragma unroll
            for (int nt = 0; nt < 4; ++nt)
#pragma unroll
                for (int i = 0; i < 4; ++i) { float bias = bfar; if (NEAR) { int ri = kt * 64 + nt * 16 + g4 * 4 + i - (rowl + rt * 16 + lq) + 128; ri = ri < 0 ? 0 : (ri > 255 ? 255 : ri); bias = bl[128 + ri * NH + hl]; } const float x = ((bits[rt] >> (nt * 4 + i)) & 1u) ? s[rt][nt][i] * (0.125f * LOG2E) + bias : -INFINITY; s[rt][nt][i] = x; mx = fmaxf(mx, x); }
            mx = fmaxf(mx, __shfl_xor(mx, 16)); mx = fmaxf(mx, __shfl_xor(mx, 32));
            const float mnew = fmaxf(m[rt][hl], mx), msafe = (mnew == -INFINITY) ? 0.f : mnew, alpha = __builtin_amdgcn_exp2f(m[rt][hl] - msafe); m[rt][hl] = mnew;
            float ls = 0.f;
#pragma unroll
            for (int nt = 0; nt < 4; ++nt)
#pragma unroll
                for (int i = 0; i < 4; ++i) { const float p = __builtin_amdgcn_exp2f(s[rt][nt][i] - msafe); s[rt][nt][i] = p; ls += p; }
            l[rt][hl] = l[rt][hl] * alpha + ls;
#pragma unroll
            for (int dt = 0; dt < 4; ++dt) O[rt][hl][dt] = O[rt][hl][dt] * alpha;
#pragma unroll
            for (int kk = 0; kk < 2; ++kk) { const u32x4 pw = pack8(s[rt][2 * kk], s[rt][2 * kk + 1]); pb[rt][kk] = __builtin_bit_cast(bf16x8, pw); }
        }
#pragma unroll
        for (int kk = 0; kk < 2; ++kk)
#pragma unroll
            for (int dt = 0; dt < 4; ++dt) { LAS u16* vp = Vb + (hl * 64 + dt * 16 + lq) * VP + kk * 32 + g4 * 4; const u32x2 v0 = *(LAS u32x2*)vp, v1 = *(LAS u32x2*)(vp + 16);
                u32x4 vw; vw.x = v0.x; vw.y = v0.y; vw.z = v1.x; vw.w = v1.y; const bf16x8 vf = __builtin_bit_cast(bf16x8, vw);
#pragma unroll
                for (int rt = 0; rt < RT; ++rt) O[rt][hl][dt] = __builtin_amdgcn_mfma_f32_16x16x32_bf16(vf, pb[rt][kk], O[rt][hl][dt], 0, 0, 0); }
    }
}
DI void att_tile_far(LAS u16* Kb, LAS u16* Vb, LAS float* bl, const unsigned (&bits)[RT], const bf16x8 (&qf)[RT][NH][2], f32x4 (&O)[RT][NH][4], float (&m)[RT][NH], float (&l)[RT][NH], int lq, int g4) {
#pragma unroll
    for (int hl = 0; hl < NH; ++hl) {
        bf16x8 kf[4][2], vf[2][4];
#pragma unroll
        for (int nt = 0; nt < 4; ++nt)
#pragma unroll
            for (int ks = 0; ks < 2; ++ks) kf[nt][ks] = *(LAS bf16x8*)(Kb + (nt * 16 + lq) * KP + hl * 64 + ks * 32 + g4 * 8);
#pragma unroll
        for (int kk = 0; kk < 2; ++kk)
#pragma unroll
            for (int dt = 0; dt < 4; ++dt) { LAS u16* vp = Vb + (hl * 64 + dt * 16 + lq) * VP + kk * 32 + g4 * 4; const u32x2 v0 = *(LAS u32x2*)vp, v1 = *(LAS u32x2*)(vp + 16);
                u32x4 vw; vw.x = v0.x; vw.y = v0.y; vw.z = v1.x; vw.w = v1.y; vf[kk][dt] = __builtin_bit_cast(bf16x8, vw); }
        const float bfar = bl[15 * 4 + hl];
        f32x4 s[RT][4];
#pragma unroll
        for (int nt = 0; nt < 4; ++nt) {
#pragma unroll
            for (int rt = 0; rt < RT; ++rt) s[rt][nt] = (f32x4){0.f, 0.f, 0.f, 0.f};
#pragma unroll
            for (int ks = 0; ks < 2; ++ks)
#pragma unroll
                for (int rt = 0; rt < RT; ++rt) s[rt][nt] = __builtin_amdgcn_mfma_f32_16x16x32_bf16(kf[nt][ks], qf[rt][hl][ks], s[rt][nt], 0, 0, 0); }
        bf16x8 pb[RT][2];
#pragma unroll
        for (int rt = 0; rt < RT; ++rt) {
            float mx = -INFINITY;
#pragma unroll
            for (int nt = 0; nt < 4; ++nt)
#pragma unroll
                for (int i = 0; i < 4; ++i) { const int sel = __builtin_amdgcn_sbfe((int)bits[rt], nt * 4 + i, 1);
                    const float x = __int_as_float((__float_as_int(s[rt][nt][i]) & sel) | (int)(0xff800000u & ~(unsigned)sel)); s[rt][nt][i] = x; mx = fmaxf(mx, x); }
            mx = fmaxf(mx, __shfl_xor(mx, 16)); mx = fmaxf(mx, __shfl_xor(mx, 32));
            const float mxl = mx * (0.125f * LOG2E) + bfar;
            const float mnew = fmaxf(m[rt][hl], mxl), msafe = (mnew == -INFINITY) ? 0.f : mnew, alpha = __builtin_amdgcn_exp2f(m[rt][hl] - msafe); m[rt][hl] = mnew;
            const float boff = bfar - msafe; float ls = 0.f;
#pragma unroll
            for (int nt = 0; nt < 4; ++nt)
#pragma unroll
                for (int i = 0; i < 4; ++i) { const float p = __builtin_amdgcn_exp2f(s[rt][nt][i] * (0.125f * LOG2E) + boff); s[rt][nt][i] = p; ls += p; }
            l[rt][hl] = l[rt][hl] * alpha + ls;
#pragma unroll
            for (int dt = 0; dt < 4; ++dt) O[rt][hl][dt] = O[rt][hl][dt] * alpha;
#pragma unroll
            for (int kk = 0; kk < 2; ++kk) { const u32x4 pw = pack8(s[rt][2 * kk], s[rt][2 * kk + 1]); pb[rt][kk] = __builtin_bit_cast(bf16x8, pw); }
        }
#pragma unroll
        for (int kk = 0; kk < 2; ++kk)
#pragma unroll
            for (int dt = 0; dt < 4; ++dt)
#pragma unroll
                for (int rt = 0; rt < RT; ++rt) O[rt][hl][dt] = __builtin_amdgcn_mfma_f32_16x16x32_bf16(vf[kk][dt], pb[rt][kk], O[rt][hl][dt], 0, 0, 0);
    }
}
DI void att_tile_near(LAS u16* Kb, LAS u16* Vb, LAS float* bl, const unsigned (&bits)[RT], int kt, int rowl, const bf16x8 (&qf)[RT][NH][2], f32x4 (&O)[RT][NH][4], float (&m)[RT][NH], float (&l)[RT][NH], int lq, int g4) {
#pragma unroll
    for (int hl = 0; hl < NH; ++hl) {
        bf16x8 vf[2][4];
        f32x4 s[RT][4];
#pragma unroll
        for (int nt = 0; nt < 4; ++nt) {
#pragma unroll
            for (int rt = 0; rt < RT; ++rt) s[rt][nt] = (f32x4){0.f, 0.f, 0.f, 0.f};
#pragma unroll
            for (int ks = 0; ks < 2; ++ks) { const bf16x8 kfr = *(LAS bf16x8*)(Kb + (nt * 16 + lq) * KP + hl * 64 + ks * 32 + g4 * 8);
#pragma unroll
                for (int rt = 0; rt < RT; ++rt) s[rt][nt] = __builtin_amdgcn_mfma_f32_16x16x32_bf16(kfr, qf[rt][hl][ks], s[rt][nt], 0, 0, 0); } }
        bf16x8 pb[RT][2];
#pragma unroll
        for (int rt = 0; rt < RT; ++rt) {
            float bia[16];
#pragma unroll
            for (int nt = 0; nt < 4; ++nt)
#pragma unroll
                for (int i = 0; i < 4; ++i) { int ri = kt * 64 + nt * 16 + g4 * 4 + i - (rowl + rt * 16 + lq) + 128; ri = ri < 0 ? 0 : (ri > 255 ? 255 : ri); bia[nt * 4 + i] = bl[128 + ri * NH + hl]; }
            float mx = -INFINITY;
#pragma unroll
            for (int nt = 0; nt < 4; ++nt)
#pragma unroll
                for (int i = 0; i < 4; ++i) { const float xb = s[rt][nt][i] * (0.125f * LOG2E) + bia[nt * 4 + i];
                    const int sel = __builtin_amdgcn_sbfe((int)bits[rt], nt * 4 + i, 1);
                    const float x = __int_as_float((__float_as_int(xb) & sel) | (int)(0xff800000u & ~(unsigned)sel)); s[rt][nt][i] = x; mx = fmaxf(mx, x); }
            mx = fmaxf(mx, __shfl_xor(mx, 16)); mx = fmaxf(mx, __shfl_xor(mx, 32));
            const float mnew = fmaxf(m[rt][hl], mx), msafe = (mnew == -INFINITY) ? 0.f : mnew, alpha = __builtin_amdgcn_exp2f(m[rt][hl] - msafe); m[rt][hl] = mnew;
            float ls = 0.f;
#pragma unroll
            for (int nt = 0; nt < 4; ++nt)
#pragma unroll
                for (int i = 0; i < 4; ++i) { const float p = __builtin_amdgcn_exp2f(s[rt][nt][i] - msafe); s[rt][nt][i] = p; ls += p; }
            l[rt][hl] = l[rt][hl] * alpha + ls;
#pragma unroll
            for (int dt = 0; dt < 4; ++dt) O[rt][hl][dt] = O[rt][hl][dt] * alpha;
#pragma unroll
            for (int kk = 0; kk < 2; ++kk) { const u32x4 pw = pack8(s[rt][2 * kk], s[rt][2 * kk + 1]); pb[rt][kk] = __builtin_bit_cast(bf16x8, pw); }
        }
#pragma unroll
        for (int kk = 0; kk < 2; ++kk)
#pragma unroll
            for (int dt = 0; dt < 4; ++dt) { LAS u16* vp = Vb + (hl * 64 + dt * 16 + lq) * VP + kk * 32 + g4 * 4; const u32x2 v0 = *(LAS u32x2*)vp, v1 = *(LAS u32x2*)(vp + 16);
                u32x4 vw; vw.x = v0.x; vw.y = v0.y; vw.z = v1.x; vw.w = v1.y; vf[kk][dt] = __builtin_bit_cast(bf16x8, vw); }
#pragma unroll
        for (int kk = 0; kk < 2; ++kk)
#pragma unroll
            for (int dt = 0; dt < 4; ++dt)
#pragma unroll
                for (int rt = 0; rt < RT; ++rt) O[rt][hl][dt] = __builtin_amdgcn_mfma_f32_16x16x32_bf16(vf[kk][dt], pb[rt][kk], O[rt][hl][dt], 0, 0, 0);
    }
}
DI void att_phase(const Frame& F, LAS unsigned char* lds) {
    constexpr int KT = 64 * KP, VTS = NH * 64 * VP;
    LAS u16* Kbuf = (LAS u16*)lds;
    LAS u16* Vbuf = (LAS u16*)(lds + 4 * KT * 2);
    LAS float* bl = (LAS float*)(lds + 4 * KT * 2 + 4 * VTS * 2);
    const int tid = F.tid, lane = F.lane, wave = F.wave, lq = lane & 15, g4 = lane >> 4;
    constexpr int NQ = 8 / NH;
    constexpr int BR = 8 * 16 * RT, NBT = SEQ / BR;
    for (int pp = blockIdx.x; pp < 4 * NQ * (NBT / 2); pp += gridDim.x) {
        const int x = pp & 7, y = pp >> 3, b = x >> 1, hq = (x & 1) * (NQ / 2) + (y % (NQ / 2)), ii = y / (NQ / 2);
        __syncthreads();
        if (tid < 128) bl[tid] = ((tid & 3) < NH) ? F.in[23][(tid >> 2) * 8 + hq * NH + (tid & 3)] * LOG2E : 0.f;
        for (int e = tid; e < 256 * NH; e += NTHR) bl[128 + e] = F.in[23][t5_bucket(e / NH - 128) * 8 + hq * NH + (e % NH)] * LOG2E;
        __syncthreads();
        for (int which = 0; which < 2; ++which) {
            const int i = which ? NBT - 1 - ii : ii, npair = (BR / 128) * (i + 1), rowl = i * BR + wave * (16 * RT);
            const int c = rowl >> 6, my_ntile = c + 1;
            u16* qbase = F_Q(F) + ((size_t)b * SEQ + rowl + lq) * 512 + hq * (NH * 64);
            bf16x8 qf[RT][NH][2];
#pragma unroll
            for (int rt = 0; rt < RT; ++rt)
#pragma unroll
                for (int hl = 0; hl < NH; ++hl)
#pragma unroll
                    for (int ks = 0; ks < 2; ++ks) qf[rt][hl][ks] = *(const bf16x8*)(qbase + rt * 16 * 512 + hl * 64 + ks * 32 + g4 * 8);
            f32x4 O[RT][NH][4]; float m[RT][NH], l[RT][NH];
#pragma unroll
            for (int rt = 0; rt < RT; ++rt)
#pragma unroll
                for (int hl = 0; hl < NH; ++hl) { m[rt][hl] = -INFINITY; l[rt][hl] = 0.f;
#pragma unroll
                    for (int dt = 0; dt < 4; ++dt) O[rt][hl][dt] = (f32x4){0.f, 0.f, 0.f, 0.f}; }
            const size_t mb0 = (size_t)b * MASK_PER_B + (size_t)(c + 1) * (2 * c + ((rowl >> 4) & 3));
            const char* mp = (const char*)(F_MASK(F) + mb0 * 64) + (unsigned)(lane * 2);
            const int mrt = (c + 1) * 128;
            const u16* kg = F_K(F) + ((size_t)b * SEQ) * 512 + hq * (NH * 64); const u16* vg = F_VT(F) + ((size_t)(b * 512 + hq * (NH * 64))) * SEQ;
            constexpr int NE = NH, KCH = NH * 8, KR = 512 / KCH;
            u32x4 kr[2][NE], vr[2][NE];
            const unsigned voffK = (unsigned)(((tid / KCH) * 512 + (tid % KCH) * 8) * 2), voffV = (unsigned)(((tid >> 3) * SEQ + (tid & 7) * 8) * 2);
            const int krow = tid / KCH, kck = tid % KCH, vrow = tid >> 3, vck = tid & 7;
#pragma unroll
            for (int t = 0; t < 2; ++t)
#pragma unroll
                for (int e = 0; e < NE; ++e) { kr[t][e] = ldg16(kg + (size_t)(t * 64 + e * KR) * 512, voffK); vr[t][e] = ldg16(vg + (size_t)e * 64 * SEQ + t * 64, voffV); }
#pragma unroll
            for (int t = 0; t < 2; ++t)
#pragma unroll
                for (int e = 0; e < NE; ++e) { *(LAS u32x4*)(Kbuf + t * KT + (krow + e * KR) * KP + kck * 8) = kr[t][e]; *(LAS u32x4*)(Vbuf + t * VTS + (vrow + e * 64) * VP + vck * 8) = vr[t][e]; }
            unsigned bc[2][RT], bn[2][RT];
#pragma unroll
            for (int t = 0; t < 2; ++t)
#pragma unroll
                for (int rt = 0; rt < RT; ++rt) { const int kq = t < my_ntile ? t : my_ntile - 1; bc[t][rt] = *(const u16*)(mp + rt * mrt + kq * 128); }
            __builtin_amdgcn_s_waitcnt(0x0F70);
            __syncthreads();
#pragma unroll 1
            for (int kp = 0; kp < npair; ++kp) {
                const bool more = kp + 1 < npair; const int kt0 = 2 * kp, st = kp & 1;
                if (more) {
#pragma unroll
                    for (int t = 0; t < 2; ++t)
#pragma unroll
                        for (int rt = 0; rt < RT; ++rt) { const int kq = kt0 + 2 + t < my_ntile ? kt0 + 2 + t : my_ntile - 1; bn[t][rt] = *(const u16*)(mp + rt * mrt + kq * 128); }
#pragma unroll
                    for (int t = 0; t < 2; ++t)
#pragma unroll
                        for (int e = 0; e < NE; ++e) { kr[t][e] = ldg16(kg + (size_t)((kt0 + 2 + t) * 64 + e * KR) * 512, voffK); vr[t][e] = ldg16(vg + (size_t)e * 64 * SEQ + (kt0 + 2 + t) * 64, voffV); }
                }
#pragma unroll
                for (int t = 0; t < 2; ++t) { const int kt = kt0 + t;
                    if (kt < my_ntile) {
                        LAS u16* Kb = Kbuf + (st * 2 + t) * KT; LAS u16* Vb = Vbuf + (st * 2 + t) * VTS;
                        if (kt * 64 + 63 - rowl <= -91) att_tile_far(Kb, Vb, bl, bc[t], qf, O, m, l, lq, g4);
                        else att_tile_near(Kb, Vb, bl, bc[t], kt, rowl, qf, O, m, l, lq, g4);
                    } }
                if (more) {
#pragma unroll
                    for (int t = 0; t < 2; ++t)
#pragma unroll
                        for (int e = 0; e < NE; ++e) { *(LAS u32x4*)(Kbuf + ((st ^ 1) * 2 + t) * KT + (krow + e * KR) * KP + kck * 8) = kr[t][e]; *(LAS u32x4*)(Vbuf + ((st ^ 1) * 2 + t) * VTS + (vrow + e * 64) * VP + vck * 8) = vr[t][e]; }
#pragma unroll
                    for (int t = 0; t < 2; ++t)
#pragma unroll
                        for (int rt = 0; rt < RT; ++rt) bc[t][rt] = bn[t][rt];
                }
                __syncthreads();
            }
#pragma unroll
            for (int rt = 0; rt < RT; ++rt)
#pragma unroll
                for (int hl = 0; hl < NH; ++hl) { float lt = l[rt][hl]; lt += __shfl_xor(lt, 16); lt += __shfl_xor(lt, 32); const float inv = 1.0f / lt;
#pragma unroll
                    for (int dt = 0; dt < 4; ++dt) { const f32x4 o = O[rt][hl][dt] * inv; u32x2 w; w.x = cvt_pk_bf16(o[0], o[1]); w.y = cvt_pk_bf16(o[2], o[3]);
                        *(u32x2*)(qbase + rt * 16 * 512 + hl * 64 + dt * 16 + g4 * 4) = w; } }
        }
    }
}

#define XB_TMO      128
#define XB_XCNT(j)  (256  + 64 * (j))
#define XB_XSUB(j)  (1280 + 64 * (j))
#define XB_XGEN(j)  (2304 + 64 * (j))
#define XB_TOP      3328
#define XB_TOPGEN   3392
#define XCD_BAR_WORDS 3456
#define XB_SPIN_CAP (1u << 18)
DI unsigned xb_ld(unsigned* p)              { return __hip_atomic_load(p, __ATOMIC_RELAXED, __HIP_MEMORY_SCOPE_AGENT); }
DI unsigned xb_add(unsigned* p, unsigned v) { return __hip_atomic_fetch_add(p, v, __ATOMIC_RELAXED, __HIP_MEMORY_SCOPE_AGENT); }
DI unsigned xb_xcc_id() { return (unsigned)__builtin_amdgcn_s_getreg((3 << 11) | 20) & 0xFu; }
#define XB_SPIN(cond, bar) do { unsigned _sp = 0; while (cond) { __builtin_amdgcn_s_sleep(1); \
    if ((++_sp & 255u) == 0u) { if (xb_ld(&(bar)[XB_TMO])) break; if (_sp > XB_SPIN_CAP) { (void)xb_add(&(bar)[XB_TMO], 1u); break; } } } } while (0)
struct XcdBarrier { unsigned* bar; unsigned x; volatile LAS unsigned* st; };
DI XcdBarrier xcd_barrier_post(unsigned* bar, volatile LAS unsigned* st) {
    XcdBarrier b; b.bar = bar; b.x = xb_xcc_id(); b.st = st;
    if (threadIdx.x == 0) (void)xb_add(&bar[XB_XCNT(b.x)], 1u);
    return b;
}
DI void xcd_barrier_complete(unsigned* bar, unsigned x, unsigned& nloc, unsigned& nx) {
    const unsigned G = gridDim.x * gridDim.y * gridDim.z;
    unsigned sum, cnt, mine, sp = 0u;
    for (;;) {
        sum = 0u; cnt = 0u; mine = 0u;
#pragma unroll
        for (unsigned j = 0; j < 16; ++j) { const unsigned c = xb_ld(&bar[XB_XCNT(j)]); sum += c; cnt += (c > 0u) ? 1u : 0u; mine = (j == x) ? c : mine; }
        if (sum == G) break;
        __builtin_amdgcn_s_sleep(1);
        if ((++sp & 255u) == 0u) { if (xb_ld(&bar[XB_TMO])) break; if (sp > XB_SPIN_CAP) { (void)xb_add(&bar[XB_TMO], 1u); break; } }
    }
    nloc = mine > 0u ? mine : 1u; nx = cnt > 0u ? cnt : 1u;
}
DI unsigned xb_uadd(unsigned* p, unsigned v) { unsigned r = 0u; if ((threadIdx.x & 63) == 0) r = xb_add(p, v); return (unsigned)__builtin_amdgcn_readfirstlane((int)r); }
DI unsigned xb_uld(unsigned* p) { return (unsigned)__builtin_amdgcn_readfirstlane((int)xb_ld(p)); }
DI void xcd_barrier(unsigned* bar, unsigned bx, volatile LAS unsigned* bst) {
    asm volatile("s_waitcnt vmcnt(0)" ::: "memory");
    __syncthreads();
    if (__builtin_amdgcn_readfirstlane((int)(threadIdx.x >> 6)) == 0) {
        asm volatile("s_waitcnt vmcnt(0) lgkmcnt(0)" ::: "memory");
        unsigned nloc = (unsigned)__builtin_amdgcn_readfirstlane((int)bst[0]), nx = (unsigned)__builtin_amdgcn_readfirstlane((int)bst[1]);
        if (nloc == 0u) {
            const unsigned G = gridDim.x; unsigned sp = 0u;
            for (;;) {
                unsigned sum = 0u, cnt = 0u, mine = 0u;
#pragma unroll
                for (unsigned j = 0; j < 16; ++j) { const unsigned c = xb_uld(&bar[XB_XCNT(j)]); sum += c; cnt += (c > 0u) ? 1u : 0u; mine = (j == bx) ? c : mine; }
                nloc = mine > 0u ? mine : 1u; nx = cnt > 0u ? cnt : 1u;
                if (sum == G) break;
                __builtin_amdgcn_s_sleep(1);
                if (++sp > XB_SPIN_CAP) { (void)xb_uadd(&bar[XB_TMO], 1u); break; }
            }
            if ((threadIdx.x & 63) == 0) { bst[0] = nloc; bst[1] = nx; }
        }
        const unsigned old = xb_uadd(&bar[XB_XSUB(bx)], 1u);
        const unsigned gen = old / nloc;
        if (old + 1u == (gen + 1u) * nloc) {
            __builtin_amdgcn_fence(__ATOMIC_RELEASE, "agent");
            asm volatile("s_waitcnt vmcnt(0)" ::: "memory");
            const unsigned og = xb_uadd(&bar[XB_TOP], 1u);
            const unsigned tg = og / nx;
            if (og + 1u == (tg + 1u) * nx) (void)xb_uadd(&bar[XB_TOPGEN], 1u);
            else { unsigned sp = 0u; while (xb_uld(&bar[XB_TOPGEN]) == tg) { __builtin_amdgcn_s_sleep(1); if (++sp > XB_SPIN_CAP) { (void)xb_uadd(&bar[XB_TMO], 1u); break; } } }
            __builtin_amdgcn_fence(__ATOMIC_ACQUIRE, "agent");
            (void)xb_uadd(&bar[XB_XGEN(bx)], 1u);
            asm volatile("s_waitcnt vmcnt(0)" ::: "memory");
        } else {
            unsigned sp = 0u; while (xb_uld(&bar[XB_XGEN(bx)]) == gen) { __builtin_amdgcn_s_sleep(1); if (++sp > XB_SPIN_CAP) { (void)xb_uadd(&bar[XB_TMO], 1u); break; } }
            __builtin_amdgcn_fence(__ATOMIC_ACQUIRE, "agent");
            asm volatile("s_waitcnt vmcnt(0)" ::: "memory");
        }
    }
    __syncthreads();
}

constexpr int NPH = 33;
#define PHON(k) ((PHM >> (k)) & 1)
DI void fresh(Frame& F, const Args& args) {
    int t = threadIdx.x; asm volatile("" : "+v"(t)); F.tid = t; F.lane = t & 63; F.wave = __builtin_amdgcn_readfirstlane(t >> 6);
    int z = 0; asm volatile("" : "+s"(z)); F.in = args.in + z;
    F.ws = args.ws + z; F.out = args.out + z;
}
#ifndef RPT
#define RPT 0
#endif
#define PH_BEGIN(k) if (args.lo <= (k) && (k) < args.hi) { fresh(F, args); unsigned char* ws = F.ws; (void)ws;
#define PH_END(k) if ((k) + 1 < args.hi) xcd_barrier(xbar, xx, xst); }
template <int PHM, int L>
DI void layer_phases(Frame& F, const Args& args, LAS unsigned char* lds, cg::grid_group& grid, unsigned* xbar, unsigned xx, volatile LAS unsigned* xst) {
    constexpr int P = 1 + 16 * L;
#define WL (ws + WS_W + (size_t)L * SZ_LAYERW)
#define TAB (ws + WS_TAB + (size_t)L * SZ_TABL)
#define WLDS (lds + F.wave * 19456)
    PH_BEGIN(P + 0) if (PHON(0)) { EpiUp E{F_H(F)}; run_gemm(lds, F_XB(F), (const u16*)(WL + OFF_UP1), NUP, D_, E); } if ((RPT >> 0) & 1) { xcd_barrier(xbar, xx, xst); fresh(F, args); if (PHON(0)) { EpiUp E{F_H(F)}; run_gemm(lds, F_XB(F), (const u16*)(WL + OFF_UP1), NUP, D_, E); } } PH_END(P + 0)
    PH_BEGIN(P + 1) if (PHON(1)) { EpiRes E{L == 0 ? F.in[0] : (const float*)F.out, F.out, 0.5f, L == 0 ? (const f32x2_t*)nullptr : (const f32x2_t*)(ws + WS_STATS), F.in[21], F.in[22]};     run_gemm(lds, F_H(F), (const u16*)(WL + OFF_DN1), D_, DFF, E); } if ((RPT >> 1) & 1) { xcd_barrier(xbar, xx, xst); fresh(F, args); if (PHON(1)) { EpiRes E{L == 0 ? F.in[0] : (const float*)F.out, F.out, 0.5f, L == 0 ? (const f32x2_t*)nullptr : (const f32x2_t*)(ws + WS_STATS), F.in[21], F.in[22]};     run_gemm(lds, F_H(F), (const u16*)(WL + OFF_DN1), D_, DFF, E); } } PH_END(P + 1)
    PH_BEGIN(P + 2) if (PHON(2)) ln_phase(F, F.in[3] + L * D_, F.in[4] + L * D_, false); if ((RPT >> 2) & 1) { xcd_barrier(xbar, xx, xst); fresh(F, args); if (PHON(2)) ln_phase(F, F.in[3] + L * D_, F.in[4] + L * D_, false); } PH_END(P + 2)
    PH_BEGIN(P + 3) if (PHON(3)) { EpiIn E{ws}; run_gemm(lds, F_XB(F), (const u16*)(WL + OFF_WIN), NIN, D_, E); } if ((RPT >> 3) & 1) { xcd_barrier(xbar, xx, xst); fresh(F, args); if (PHON(3)) { EpiIn E{ws}; run_gemm(lds, F_XB(F), (const u16*)(WL + OFF_WIN), NIN, D_, E); } } PH_END(P + 3)
    PH_BEGIN(P + 4) if (PHON(4)) { idx_phase(F, lds); __syncthreads(); fresh(F, args); { for (int t = blockIdx.x * 8 + F.wave; t < 4096; t += gridDim.x * 8) vt_tile(F, WLDS, t);
        { int gcur = -1; float ar = 0.f, ai = 0.f, cr = 0.f, ci = 0.f; bf16x8 af[8], cf[4]; f32x4 dv = {0.f, 0.f, 0.f, 0.f};
          for (int it = blockIdx.x * 8 + F.wave; it < 16384; it += gridDim.x * 8) { const int g = it & 31; if (g != gcur) { ssm_load_g(TAB, F.in[13] + L * 512, g, F.lane, ar, ai, cr, ci, af, cf, dv); gcur = g; } ssmA_item(F, WLDS, it, ar, ai, af); } } } } PH_END(P + 4)
    PH_BEGIN(P + 5) if (PHON(5)) { att_phase(F, lds); __syncthreads(); fresh(F, args); { int gcur = -1; float ar = 0.f, ai = 0.f, cr = 0.f, ci = 0.f; bf16x8 af[8], cf[4]; f32x4 dv = {0.f, 0.f, 0.f, 0.f};
          for (int sw = blockIdx.x * 8 + F.wave; sw < 2048; sw += gridDim.x * 8) { const int g = sw & 31, seg = (sw >> 5) & 15, bb_ = sw >> 9;
              if (g != gcur) { ssm_load_g(TAB, F.in[13] + L * 512, g, F.lane, ar, ai, cr, ci, af, cf, dv); gcur = g; }
              float sr = 0.f, si = 0.f;
#pragma unroll 1
              for (int cc = 0; cc < 8; ++cc) ssmC_item(F, WLDS, ((bb_ * 128 + seg * 8 + cc) << 5) | g, ar, ai, cr, ci, af, cf, dv, sr, si, cc == 0); } } } PH_END(P + 5)
    PH_BEGIN(P + 6) if (PHON(6)) { EpiMix<0> E{F_U(F), nullptr, F_YS(F), 512}; run_gemm(lds, F_U(F), (const u16*)(WL + OFF_GLU), 512, 512, E); } if ((RPT >> 6) & 1) { xcd_barrier(xbar, xx, xst); fresh(F, args); if (PHON(6)) { EpiMix<0> E{F_U(F), nullptr, F_YS(F), 512}; run_gemm(lds, F_U(F), (const u16*)(WL + OFF_GLU), 512, 512, E); } } PH_END(P + 6)
    PH_BEGIN(P + 7) if (PHON(7)) { EpiMix<1> E{F_GS(F), nullptr, F_GS(F), 1024}; run_gemm(lds, F_YS(F), (const u16*)(WL + OFF_WB0), D_, 512, E); } if ((RPT >> 7) & 1) { xcd_barrier(xbar, xx, xst); fresh(F, args); if (PHON(7)) { EpiMix<1> E{F_GS(F), nullptr, F_GS(F), 1024}; run_gemm(lds, F_YS(F), (const u16*)(WL + OFF_WB0), D_, 512, E); } } PH_END(P + 7)
    PH_BEGIN(P + 10) if (PHON(10)) { EpiMix<2> E{F_GA(F), F_GS(F), F_GA(F), 1024}; run_gemm(lds, F_Q(F), (const u16*)(WL + OFF_WB1), D_, 512, E); } if ((RPT >> 10) & 1) { xcd_barrier(xbar, xx, xst); fresh(F, args); if (PHON(10)) { EpiMix<2> E{F_GA(F), F_GS(F), F_GA(F), 1024}; run_gemm(lds, F_Q(F), (const u16*)(WL + OFF_WB1), D_, 512, E); } } PH_END(P + 10)
    PH_BEGIN(P + 11) if (PHON(11)) { EpiRes E{(const float*)F.out, F.out, 1.0f, (const f32x2_t*)(ws + WS_STATS), F.in[3] + L * D_, F.in[4] + L * D_}; run_gemm(lds, F_GA(F), (const u16*)(WL + OFF_WOUT), D_, D_, E); } if ((RPT >> 11) & 1) { xcd_barrier(xbar, xx, xst); fresh(F, args); if (PHON(11)) { EpiRes E{(const float*)F.out, F.out, 1.0f, (const f32x2_t*)(ws + WS_STATS), F.in[3] + L * D_, F.in[4] + L * D_}; run_gemm(lds, F_GA(F), (const u16*)(WL + OFF_WOUT), D_, D_, E); } } PH_END(P + 11)
    PH_BEGIN(P + 12) if (PHON(12)) ln_phase(F, F.in[17] + L * D_, F.in[18] + L * D_, false); if ((RPT >> 12) & 1) { xcd_barrier(xbar, xx, xst); fresh(F, args); if (PHON(12)) ln_phase(F, F.in[17] + L * D_, F.in[18] + L * D_, false); } PH_END(P + 12)
    PH_BEGIN(P + 13) if (PHON(13)) { EpiUp E{F_H(F)}; run_gemm(lds, F_XB(F), (const u16*)(WL + OFF_UP2), NUP, D_, E); } if ((RPT >> 13) & 1) { xcd_barrier(xbar, xx, xst); fresh(F, args); if (PHON(13)) { EpiUp E{F_H(F)}; run_gemm(lds, F_XB(F), (const u16*)(WL + OFF_UP2), NUP, D_, E); } } PH_END(P + 13)
    PH_BEGIN(P + 14) if (PHON(14)) { EpiRes E{(const float*)F.out, F.out, 0.5f, (const f32x2_t*)(ws + WS_STATS), F.in[17] + L * D_, F.in[18] + L * D_}; run_gemm(lds, F_H(F), (const u16*)(WL + OFF_DN2), D_, DFF, E); } if ((RPT >> 14) & 1) { xcd_barrier(xbar, xx, xst); fresh(F, args); if (PHON(14)) { EpiRes E{(const float*)F.out, F.out, 0.5f, (const f32x2_t*)(ws + WS_STATS), F.in[17] + L * D_, F.in[18] + L * D_}; run_gemm(lds, F_H(F), (const u16*)(WL + OFF_DN2), D_, DFF, E); } } PH_END(P + 14)
    PH_BEGIN(P + 15) if (PHON(15)) ln_phase(F, F.in[21] + L * D_, F.in[22] + L * D_, L == 1); if ((RPT >> 15) & 1) { xcd_barrier(xbar, xx, xst); fresh(F, args); if (PHON(15)) ln_phase(F, F.in[21] + L * D_, F.in[22] + L * D_, L == 1); } PH_END(P + 15)
#undef WL
#undef TAB
#undef WLDS
}
template <int PHM>
__global__ void __launch_bounds__(NTHR, 2) mega(Args args) {
    extern __shared__ __attribute__((aligned(16))) unsigned char lds_raw[];
    LAS unsigned char* lds = (LAS unsigned char*)lds_raw;
    Frame F;
    cg::grid_group grid = cg::this_grid();
    volatile LAS unsigned* xst = (volatile LAS unsigned*)(lds + LDS_MAIN);
    if (threadIdx.x < 4) xst[threadIdx.x] = 0u;
    __syncthreads();
    unsigned* bar = (unsigned*)(args.ws + WS_BAR);
    if (args.lo <= 0 && 0 < args.hi) { fresh(F, args);
        if (blockIdx.x == 0) { for (int i = F.tid; i < XCD_BAR_WORDS; i += NTHR) bar[i] = 0u; }
        if (PHON(16)) p0_phase(F, lds);
        if (1 < args.hi) grid.sync(); }
    const unsigned xx = xb_xcc_id();
    if (threadIdx.x == 0) (void)xb_add(&bar[XB_XCNT(xx)], 1u);
    layer_phases<PHM, 0>(F, args, lds, grid, bar, xx, xst);
    layer_phases<PHM, 1>(F, args, lds, grid, bar, xx, xst);
}

typedef void (*kern_t)(Args);
#if !ONE_LAUNCH
static kern_t phase_kernel(int ph) {
    if (ph == 0) return mega<(1 << 16)>;
    switch ((ph - 1) & 15) {
    case 0: return mega<(1 << 0)>; case 1: return mega<(1 << 1)>; case 2: return mega<(1 << 2)>; case 3: return mega<(1 << 3)>;
    case 4: return mega<(1 << 4)>; case 5: return mega<(1 << 5)>; case 6: return mega<(1 << 6)>; case 7: return mega<(1 << 7)>;
    case 8: return mega<(1 << 8)>; case 9: return mega<(1 << 9)>; case 10: return mega<(1 << 10)>; case 11: return mega<(1 << 11)>;
    case 12: return mega<(1 << 12)>; case 13: return mega<(1 << 13)>; case 14: return mega<(1 << 14)>; default: return mega<(1 << 15)>;
    }
}
#endif
extern "C" void kernel_launch(void* const* d_in, const int* in_sizes, int n_in, void* d_out, int out_size, void* d_ws, size_t ws_size, hipStream_t stream) {
    static int grid = 0;
    if (grid == 0) {
        int dev = 0, cus = 0;
        if (n_in != 24 || out_size != T_ * D_ || ws_size < WS_END) { fprintf(stderr, "kernel_launch: unexpected problem (n_in %d out %d ws %zu need %zu)\n", n_in, out_size, ws_size, (size_t)WS_END); grid = -1; return; }
        (void)hipGetDevice(&dev); (void)hipDeviceGetAttribute(&cus, hipDeviceAttributeMultiprocessorCount, dev);
#if ONE_LAUNCH
        if (hipFuncSetAttribute((const void*)mega<0x1ffff>, hipFuncAttributeMaxDynamicSharedMemorySize, LDS_BYTES) != hipSuccess) fprintf(stderr, "kernel_launch: hipFuncSetAttribute failed\n");
#else
        for (int ph = 0; ph < 17; ++ph) if (hipFuncSetAttribute((const void*)phase_kernel(ph), hipFuncAttributeMaxDynamicSharedMemorySize, LDS_BYTES) != hipSuccess) fprintf(stderr, "kernel_launch: hipFuncSetAttribute failed\n");
#endif
        (void)hipGetLastError();
        grid = cus > 0 ? cus : 256;
    }
    if (grid < 0) return;
    Args a{};
    for (int i = 0; i < 24; ++i) a.in[i] = (const float*)d_in[i];
    a.out = (float*)d_out; a.ws = (unsigned char*)d_ws;
#if ONE_LAUNCH
    a.lo = 0; a.hi = NPH;
    void* kargs[] = {&a};
    hipError_t e = hipLaunchCooperativeKernel((const void*)mega<0x1ffff>, dim3(grid), dim3(NTHR), kargs, LDS_BYTES, stream);
    if (e != hipSuccess) fprintf(stderr, "cooperative launch failed: %s (grid %d)\n", hipGetErrorString(e), grid);
#else
    for (int ph = 0; ph < NPH; ++ph) { a.lo = ph; a.hi = ph + 1; hipLaunchKernelGGL(phase_kernel(ph), dim3(grid), dim3(NTHR), LDS_BYTES, stream, a); }
#endif
}
```

```cpp
#include <hip/hip_runtime.h>
#include <hip/hip_cooperative_groups.h>
#include <cstdio>
namespace cg = cooperative_groups;
#ifndef ONE_LAUNCH
#define ONE_LAUNCH 1
#endif
namespace pg8 {
#define PG8_LAS __attribute__((address_space(3)))
typedef unsigned short bf16_t;
typedef short bf16x8 __attribute__((ext_vector_type(8)));
typedef float f32x4 __attribute__((ext_vector_type(4)));
typedef unsigned u32x4 __attribute__((ext_vector_type(4)));
constexpr int BM = 256, BK = 64, HALF = 128, HTB = HALF * BK * 2  , STAGE_BYTES = 8 * HTB, NXCD = 8, WGM = 8;

__host__ __device__ __forceinline__ int lds_byte(int r, int c) { const int st = (r >> 4) * 2 + (c >> 5), rr = r & 15, cc = c & 31, ob = rr * 64 + cc * 2; return st * 1024 + (ob ^ (((ob >> 9) & 1) << 5)); }
__host__ __device__ __forceinline__ void stage_rc(int b, int& R, int& C) { const int st = b / 1024, sb = b % 1024, swz = sb ^ (((sb >> 9) & 1) << 5); R = (st >> 1) * 16 + swz / 64; C = (st & 1) * 32 + (swz % 64) / 2; }
__host__ __device__ __forceinline__ int perm32(int rho) { const int n = rho >> 4, i = rho & 15; return 8 * (i >> 2) + 4 * n + (i & 3); }

struct Unit { int pm, pn; };
struct Gemm { const bf16_t* A; const bf16_t* Bt; int M, N, K; };

struct StaticOrder {
    int nM, nN, nwg, G, c;
    __host__ __device__ void init(int M, int N, int G_, int c_) { nM = M / BM; nN = N / BM; nwg = nM * nN; G = G_; c = c_; }
    __host__ __device__ bool next(int i, Unit& u) const {
        const long L = (long)i * G + c; if (L >= nwg) return false;
        int wgid = (int)L; { const int q = nwg / NXCD, r = nwg % NXCD, xcd = wgid % NXCD, off = wgid / NXCD; wgid = (xcd < r ? xcd * (q + 1) : r * (q + 1) + (xcd - r) * q) + off; }
        const int nig = WGM * nN, gid = wgid / nig, fm = gid * WGM, gsz = (nM - fm) < WGM ? (nM - fm) : WGM;
        u.pm = fm + ((wgid % nig) % gsz); u.pn = (wgid % nig) / gsz; return true;
    }
    __device__ __forceinline__ void a_ready(const Unit&) const {}
    __device__ __forceinline__ void done(const Unit&) const {}
};
__device__ __forceinline__ unsigned cvt_pk_bf16(float lo, float hi) { unsigned r; asm volatile("v_cvt_pk_bf16_f32 %0, %1, %2" : "=v"(r) : "v"(lo), "v"(hi)); return r; }
template <class Epi, class Sched, bool STAMP = false>
__device__ __forceinline__ void gemm_phase(PG8_LAS unsigned char* lds, const Gemm g, const Sched& S, const Epi& E, unsigned long long* stamps) {
    const int tid = threadIdx.x, wid = __builtin_amdgcn_readfirstlane(tid >> 6), lane = tid & 63, wr = wid >> 2, wc = wid & 3, fr = lane & 15, fq = lane >> 4;
    const int K = g.K, nt = K / BK;
    int ts_lo = 0, ts_hi = 0, nts = 0; const unsigned long long rt_entry = STAMP ? (unsigned long long)wall_clock64() : 0ull;
#define PG8_STAMP() do { if (STAMP && wid == 0 && nts < 64) { const unsigned long long _c = (unsigned long long)clock64(); \
        ts_lo = (lane == nts) ? (int)(unsigned)_c : ts_lo; ts_hi = (lane == nts) ? (int)(unsigned)(_c >> 32) : ts_hi; ++nts; } } while (0)
    PG8_STAMP();
    unsigned voffA[2], voffB[2];
#pragma unroll
    for (int i = 0; i < 2; ++i) { int R, C; stage_rc(tid * 16 + i * 8192, R, C); const int Rb = Epi::PERM ? ((R & ~31) + perm32(R & 31)) : R;
        voffA[i] = (unsigned)(R * K + C) * 2u; voffB[i] = (unsigned)(Rb * K + C) * 2u; }
    const size_t kstep = (size_t)(BK * 2);
    const size_t hstep = (size_t)HALF * K * 2;
    const size_t tstep = 2 * hstep;
    const unsigned ldsw = (unsigned)wid * 1024u;
    const int aoff = lds_byte(wr * 64 + fr, fq * 8), boff = lds_byte(wc * 32 + fr, fq * 8);
#define PG8_SA(b, h) (((b) * 2 + (h)) * HTB)
#define PG8_SB(b, h) ((4 + (b) * 2 + (h)) * HTB)
#define PG8_STAGE(bufoff, gbase, voff) do { _Pragma("unroll") for (int _i = 0; _i < 2; ++_i) \
        __builtin_amdgcn_global_load_lds((const unsigned*)((const char*)(gbase) + (voff)[_i]), (PG8_LAS unsigned*)(lds + (bufoff) + ldsw + _i * 8192), 16, 0, 0); } while (0)
#define PG8_LDA(dst, b, h) do { _Pragma("unroll") for (int m = 0; m < 4; ++m) _Pragma("unroll") for (int k = 0; k < 2; ++k) dst[m][k] = *(const PG8_LAS bf16x8*)(lds + PG8_SA(b, h) + aoff + m * 2048 + k * 1024); } while (0)
#define PG8_LDB(dst, b, h) do { _Pragma("unroll") for (int n = 0; n < 2; ++n) _Pragma("unroll") for (int k = 0; k < 2; ++k) dst[n][k] = *(const PG8_LAS bf16x8*)(lds + PG8_SB(b, h) + boff + n * 2048 + k * 1024); } while (0)
#define PG8_MMA(ai, bj, At, Bt) do { __builtin_amdgcn_s_setprio(1); _Pragma("unroll") for (int m = 0; m < 4; ++m) _Pragma("unroll") for (int n = 0; n < 2; ++n) _Pragma("unroll") for (int k = 0; k < 2; ++k) \
        acc[ai][bj][m][n] = __builtin_amdgcn_mfma_f32_16x16x32_bf16(Bt[n][k], At[m][k], acc[ai][bj][m][n], 0, 0, 0); __builtin_amdgcn_s_setprio(0); } while (0)
#define PG8_WAIT_V(n) asm volatile("s_waitcnt vmcnt(" #n ")" ::: "memory")
#define PG8_WAIT_L(n) asm volatile("s_waitcnt lgkmcnt(" #n ")" ::: "memory")
#define PG8_BAR __builtin_amdgcn_s_barrier()
#define PG8_SCHED __builtin_amdgcn_sched_barrier(0)
    Unit cur, nxt; int ui = 0;
    if (!S.next(0, cur)) return;
    f32x4 acc[2][2][4][2];
#pragma unroll
    for (int a = 0; a < 2; ++a)
#pragma unroll
        for (int b = 0; b < 2; ++b)
#pragma unroll
            for (int m = 0; m < 4; ++m)
#pragma unroll
                for (int n = 0; n < 2; ++n) acc[a][b][m][n] = (f32x4){0.f, 0.f, 0.f, 0.f};
    bf16x8 At[4][2], B0[2][2], B1[2][2];
    const char* cA = (const char*)g.A + (size_t)cur.pm * tstep; const char* cB = (const char*)g.Bt + (size_t)cur.pn * tstep;
    S.a_ready(cur);
    PG8_STAGE(PG8_SB(0, 0), cB, voffB); PG8_STAGE(PG8_SA(0, 0), cA, voffA); PG8_STAGE(PG8_SB(0, 1), cB + hstep, voffB); PG8_STAGE(PG8_SA(0, 1), cA + hstep, voffA);
    if (wr == 1) PG8_BAR;
    PG8_WAIT_V(4); PG8_BAR;
    PG8_STAGE(PG8_SB(1, 0), cB + kstep, voffB); PG8_STAGE(PG8_SA(1, 0), cA + kstep, voffA); PG8_STAGE(PG8_SB(1, 1), cB + hstep + kstep, voffB);
    PG8_WAIT_V(6); PG8_BAR;
    PG8_STAMP();
    for (;;) {
        const bool has_next = S.next(ui + 1, nxt);
        const char* nA = has_next ? (const char*)g.A + (size_t)nxt.pm * tstep : cA; const char* nB = has_next ? (const char*)g.Bt + (size_t)nxt.pn * tstep : cB;
        for (int t = 0; t < nt; t += 2) {
            const bool last = (t == nt - 2);
            const char* a1 = cA + (size_t)(t + 1) * kstep;
            const char* a2 = last ? nA : cA + (size_t)(t + 2) * kstep; const char* b2 = last ? nB : cB + (size_t)(t + 2) * kstep;
            const char* a3 = a2 + kstep; const char* b3 = b2 + kstep;
            if (last && has_next) S.a_ready(nxt);
            PG8_LDB(B0, 0, 0); PG8_SCHED; PG8_LDA(At, 0, 0); PG8_STAGE(PG8_SA(1, 1), a1 + hstep, voffA);
            PG8_WAIT_L(8); PG8_BAR; PG8_WAIT_L(0); PG8_MMA(0, 0, At, B0); PG8_BAR; PG8_SCHED;
            PG8_LDB(B1, 0, 1); PG8_STAGE(PG8_SB(0, 0), b2, voffB);
            PG8_BAR; PG8_WAIT_L(0); PG8_MMA(0, 1, At, B1); PG8_BAR;
            PG8_LDA(At, 0, 1); PG8_STAGE(PG8_SA(0, 0), a2, voffA);
            PG8_BAR; PG8_WAIT_L(0); PG8_MMA(1, 0, At, B0); PG8_BAR; PG8_SCHED;
            PG8_STAGE(PG8_SB(0, 1), b2 + hstep, voffB);
            PG8_WAIT_V(6); PG8_BAR; PG8_MMA(1, 1, At, B1); PG8_BAR;
            PG8_LDB(B0, 1, 0); PG8_SCHED; PG8_LDA(At, 1, 0); PG8_STAGE(PG8_SA(0, 1), a2 + hstep, voffA);
            PG8_WAIT_L(8); PG8_BAR; PG8_WAIT_L(0); PG8_MMA(0, 0, At, B0); PG8_BAR; PG8_SCHED;
            PG8_LDB(B1, 1, 1); PG8_STAGE(PG8_SB(1, 0), b3, voffB);
            PG8_BAR; PG8_WAIT_L(0); PG8_MMA(0, 1, At, B1); PG8_BAR;
            PG8_LDA(At, 1, 1); PG8_STAGE(PG8_SA(1, 0), a3, voffA);
            PG8_BAR; PG8_WAIT_L(0); PG8_MMA(1, 0, At, B0); PG8_BAR; PG8_SCHED;
            PG8_STAGE(PG8_SB(1, 1), b3 + hstep, voffB);
            PG8_WAIT_V(6); PG8_BAR; PG8_MMA(1, 1, At, B1); PG8_BAR;
        }
        PG8_STAMP();
        if constexpr (!Epi::AFTER_DRAIN) { E(acc, cur, wr, wc, fr, fq); S.done(cur); }
        PG8_STAMP();
        if (!has_next) break;
#pragma unroll
        for (int a = 0; a < 2; ++a)
#pragma unroll
            for (int b = 0; b < 2; ++b)
#pragma unroll
                for (int m = 0; m < 4; ++m)
#pragma unroll
                    for (int n = 0; n < 2; ++n) acc[a][b][m][n] = (f32x4){0.f, 0.f, 0.f, 0.f};
        cur = nxt; cA = nA; cB = nB; ++ui;
    }
    PG8_WAIT_V(0);
    if (wr == 0) PG8_BAR;
    PG8_BAR;
    if constexpr (Epi::AFTER_DRAIN) { E.fused(acc, cur, wr, wc, fr, fq, lds, wid, lane); S.done(cur); }
    PG8_STAMP();
    if (STAMP && wid == 0) { stamps[lane] = lane < nts ? (((unsigned long long)(unsigned)ts_hi << 32) | (unsigned)ts_lo) : 0ull;
        if (lane == 62) stamps[62] = rt_entry; if (lane == 63) stamps[63] = (unsigned long long)wall_clock64(); }
#undef PG8_STAMP
#undef PG8_SA
#undef PG8_SB
#undef PG8_STAGE
#undef PG8_LDA
#undef PG8_LDB
#undef PG8_MMA
#undef PG8_WAIT_V
#undef PG8_WAIT_L
#undef PG8_BAR
#undef PG8_SCHED
}
}

using pg8::bf16x8; using pg8::f32x4; using pg8::u32x4;
typedef __bf16 bf16x2_t __attribute__((ext_vector_type(2)));
typedef float f32x2_t __attribute__((ext_vector_type(2)));
__device__ __forceinline__ unsigned cvt_pk_bf16(float lo, float hi) { f32x2_t f = {lo, hi}; bf16x2_t b = __builtin_convertvector(f, bf16x2_t); return __builtin_bit_cast(unsigned, b); }
typedef unsigned short u16;
typedef unsigned long long u64;
typedef unsigned u32x2 __attribute__((ext_vector_type(2)));
#define LAS __attribute__((address_space(3)))
#define DI __device__ __forceinline__

constexpr int T_ = 32768, D_ = 1024, DFF = 2816, NUP = 5632, NIN = 4608, SEQ = 8192;
constexpr float ALPHA = 1.41421356237309515f, LN_EPS = 1e-5f, LOG2E = 1.44269504088896f;
constexpr int NTHR = 512;
constexpr int LDS_MAIN = 155648, LDS_BYTES = LDS_MAIN + 16;

constexpr size_t SZ_WUP = (size_t)NUP * D_ * 2, SZ_WDN = (size_t)D_ * DFF * 2, SZ_WIN = (size_t)NIN * D_ * 2, SZ_WGLU = 512 * 512 * 2, SZ_WB = (size_t)1024 * 512 * 2, SZ_WOUT = (size_t)1024 * 1024 * 2;
constexpr size_t OFF_UP1 = 0, OFF_DN1 = OFF_UP1 + SZ_WUP, OFF_WIN = OFF_DN1 + SZ_WDN, OFF_GLU = OFF_WIN + SZ_WIN, OFF_WB0 = OFF_GLU + SZ_WGLU, OFF_WB1 = OFF_WB0 + SZ_WB,
                 OFF_WOUT = OFF_WB1 + SZ_WB, OFF_UP2 = OFF_WOUT + SZ_WOUT, OFF_DN2 = OFF_UP2 + SZ_WUP, SZ_LAYERW = OFF_DN2 + SZ_WDN;
constexpr size_t MiB = 1048576;
constexpr size_t SZ_TABL = 1024 * 1024;
constexpr size_t TAB_A1 = 0, TAB_A64 = 16384, TAB_BB = 32768, TAB_CT = 32768 + 262144, TAB_BBH = TAB_CT + 131072;
constexpr size_t WS_W = 0, WS_TAB = 2 * SZ_LAYERW, WS_XB = WS_TAB + 2 * SZ_TABL, WS_H = WS_XB + 64 * MiB, WS_GS = WS_H + 176 * MiB, WS_GA = WS_GS + 64 * MiB, WS_BAR = WS_GA + 64 * MiB, WS_STATS = WS_BAR + 65536, WS_END = WS_STATS + 262144;
constexpr size_t H_U = 0, H_Q = 32 * MiB, H_K = 64 * MiB, H_V = 96 * MiB, H_QI = 128 * MiB, H_KIB = 144 * MiB, H_WI = 146 * MiB, H_SLOC = 147 * MiB, H_MASK = 155 * MiB;
constexpr int MASK_PER_B = 33024;

struct Args { const float* in[24]; float* out; unsigned char* ws; int lo, hi; };

struct Frame {
    const float* const* in; float* out; unsigned char* ws;
    int tid, lane, wave;
};
#define FP(F, T, off) ((T*)((F).ws + (off)))
#define F_XB(F) FP(F, u16, WS_XB)
#define F_H(F) FP(F, u16, WS_H)
#define F_U(F) FP(F, u16, WS_H + H_U)
#define F_Q(F) FP(F, u16, WS_H + H_Q)
#define F_K(F) FP(F, u16, WS_H + H_K)
#define F_V(F) FP(F, u16, WS_H + H_V)
#define F_QI(F) FP(F, u16, WS_H + H_QI)
#define F_KIB(F) FP(F, u16, WS_H + H_KIB)
#define F_WI(F) FP(F, float, WS_H + H_WI)
#define F_SLOC(F) FP(F, float, WS_H + H_SLOC)
#define F_MASK(F) FP(F, u16, WS_H + H_MASK)
#define F_GS(F) FP(F, u16, WS_GS)
#define F_GA(F) FP(F, u16, WS_GA)
#define F_YS(F) FP(F, u16, WS_XB)
#define F_VT(F) FP(F, u16, WS_XB + 32 * MiB)

DI float bf_lo(unsigned u) { return __uint_as_float(u << 16); }
DI float bf_hi(unsigned u) { return __uint_as_float(u & 0xffff0000u); }
DI float fsigmoid(float x) { return __builtin_amdgcn_rcpf(1.0f + __expf(-x)); }
DI u32x4 pack8(const f32x4& a, const f32x4& b) { u32x4 w; w.x = cvt_pk_bf16(a[0], a[1]); w.y = cvt_pk_bf16(a[2], a[3]); w.z = cvt_pk_bf16(b[0], b[1]); w.w = cvt_pk_bf16(b[2], b[3]); return w; }
DI void unpack8(const u32x4& w, f32x4& a, f32x4& b) { a[0] = bf_lo(w.x); a[1] = bf_hi(w.x); a[2] = bf_lo(w.y); a[3] = bf_hi(w.y); b[0] = bf_lo(w.z); b[1] = bf_hi(w.z); b[2] = bf_lo(w.w); b[3] = bf_hi(w.w); }

struct EpiUp {
    static constexpr bool PERM = true, AFTER_DRAIN = false;
    u16* H;
    DI void operator()(const f32x4 (&acc)[2][2][4][2], const pg8::Unit& u, int wr, int wc, int fr, int fq) const {
        const int row0 = u.pm * 256 + wr * 64 + fr, col0 = u.pn * 128 + wc * 32 + 8 * fq;
#pragma unroll
        for (int ai = 0; ai < 2; ++ai)
#pragma unroll
            for (int m = 0; m < 4; ++m) {
                f32x4 o0, o1;
#pragma unroll
                for (int j = 0; j < 4; ++j) { const float g0 = acc[ai][0][m][0][j], g1 = acc[ai][0][m][1][j]; o0[j] = g0 * fsigmoid(g0) * acc[ai][1][m][0][j]; o1[j] = g1 * fsigmoid(g1) * acc[ai][1][m][1][j]; }
                *(u32x4*)(H + (size_t)(row0 + ai * 128 + m * 16) * DFF + col0) = pack8(o0, o1);
            }
    }
};
struct EpiRes {
    static constexpr bool PERM = false, AFTER_DRAIN = false;
    const float* R; float* Y; float sc; const f32x2_t* st; const float* g; const float* b;
    DI void operator()(const f32x4 (&acc)[2][2][4][2], const pg8::Unit& u, int wr, int wc, int fr, int fq) const {
        const int row0 = u.pm * 256 + wr * 64 + fr, col0 = u.pn * 256 + wc * 32 + 4 * fq;
        f32x4 gv[2][2], bv[2][2];
#pragma unroll
        for (int bj = 0; bj < 2; ++bj)
#pragma unroll
            for (int n = 0; n < 2; ++n) { gv[bj][n] = (f32x4){ALPHA, ALPHA, ALPHA, ALPHA}; bv[bj][n] = (f32x4){0.f, 0.f, 0.f, 0.f};
                if (st) { gv[bj][n] = *(const f32x4*)(g + col0 + bj * 128 + n * 16) * ALPHA; bv[bj][n] = *(const f32x4*)(b + col0 + bj * 128 + n * 16) * ALPHA; } }
#pragma unroll
        for (int ai = 0; ai < 2; ++ai)
#pragma unroll
            for (int m = 0; m < 4; ++m) { const int row = row0 + ai * 128 + m * 16; const size_t off = (size_t)row * D_ + col0;
                f32x2_t sr = {0.f, 1.f}; if (st) sr = st[row];
#pragma unroll
                for (int bj = 0; bj < 2; ++bj)
#pragma unroll
                    for (int n = 0; n < 2; ++n) { const f32x4 r = *(const f32x4*)(R + off + bj * 128 + n * 16);
                        *(f32x4*)(Y + off + bj * 128 + n * 16) = (r - sr.x) * sr.y * gv[bj][n] + bv[bj][n] + acc[ai][bj][m][n] * sc; }
                asm volatile("" ::: "memory"); }
    }
};
struct EpiIn {
    static constexpr bool PERM = true, AFTER_DRAIN = false;
    unsigned char* ws;
    DI void operator()(const f32x4 (&acc)[2][2][4][2], const pg8::Unit& u, int wr, int wc, int fr, int fq) const {
        const int row0 = u.pm * 256 + wr * 64 + fr, cl = wc * 32 + 8 * fq, pn = u.pn;
        size_t boff; int ld, c0;
        if (pn < 8) { boff = WS_H + (size_t)(pn >> 1) * (32 * MiB); ld = 512; c0 = (pn & 1) * 256; }
        else if (pn == 8) { boff = WS_H + H_QI; ld = 256; c0 = 0; }
        else if (pn == 9) { boff = WS_H + H_KIB; ld = 32; c0 = 0; }
        else { boff = WS_GS + (size_t)((pn - 10) >> 2) * (64 * MiB); ld = 1024; c0 = ((pn - 10) & 3) * 256; }
        u16* base = (u16*)(ws + boff); float* WI = (float*)(ws + WS_H + H_WI);
#pragma unroll
        for (int ai = 0; ai < 2; ++ai)
#pragma unroll
            for (int m = 0; m < 4; ++m) { const size_t row = (size_t)(row0 + ai * 128 + m * 16);
#pragma unroll
                for (int bj = 0; bj < 2; ++bj) { const int c = bj * 128 + cl; f32x4 v0 = acc[ai][bj][m][0], v1 = acc[ai][bj][m][1];
                    if (pn == 9) { if (c < 32) *(u32x4*)(base + row * 32 + c) = pack8(v0, v1); else if (c == 32) { *(f32x4*)(WI + row * 8) = v0; *(f32x4*)(WI + row * 8 + 4) = v1; } }
                    else { if (pn >= 10) {
#pragma unroll
                            for (int j = 0; j < 4; ++j) { v0[j] = fsigmoid(v0[j]); v1[j] = fsigmoid(v1[j]); } }
                        *(u32x4*)(base + row * ld + c0 + c) = pack8(v0, v1); } } }
    }
};
template <int MODE> struct EpiMix {
    static constexpr bool PERM = true, AFTER_DRAIN = false;
    const u16* A; const u16* Bsrc; u16* O; int ldc;
    DI void operator()(const f32x4 (&acc)[2][2][4][2], const pg8::Unit& u, int wr, int wc, int fr, int fq) const {
        const int row0 = u.pm * 256 + wr * 64 + fr, col0 = u.pn * 256 + wc * 32 + 8 * fq;
#pragma unroll
        for (int ai = 0; ai < 2; ++ai)
#pragma unroll
            for (int m = 0; m < 4; ++m) { const size_t off = (size_t)(row0 + ai * 128 + m * 16) * ldc + col0;
#pragma unroll
                for (int bj = 0; bj < 2; ++bj) { f32x4 v0 = acc[ai][bj][m][0], v1 = acc[ai][bj][m][1], a0, a1;
                    const u32x4 aw = *(const u32x4*)(A + off + bj * 128); unpack8(aw, a0, a1);
                    if (MODE == 0) {
#pragma unroll
                        for (int j = 0; j < 4; ++j) { v0[j] = a0[j] * fsigmoid(v0[j]); v1[j] = a1[j] * fsigmoid(v1[j]); } }
                    else if (MODE == 1) { v0 = a0 * v0; v1 = a1 * v1; }
                    else { f32x4 b0, b1; const u32x4 bw = *(const u32x4*)(Bsrc + off + bj * 128); unpack8(bw, b0, b1); v0 = b0 + a0 * v0; v1 = b1 + a1 * v1; }
                    *(u32x4*)(O + off + bj * 128) = pack8(v0, v1); } }
    }
};

template <class Epi> DI void run_gemm(LAS unsigned char* lds, const u16* A, const u16* Bt, int N, int K, const Epi& E) {
    pg8::Gemm g{A, Bt, T_, N, K}; pg8::StaticOrder S; S.init(T_, N, (int)gridDim.x, (int)blockIdx.x);
    pg8::gemm_phase<Epi, pg8::StaticOrder, false>(lds, g, S, E, nullptr);
    __syncthreads();
}

DI int srccol(int map, int n) {
    if (map == 0) return n;
    if (map == 1) { const int pn = n >> 8, r = n & 255; return r < 128 ? 128 * pn + r : DFF + 128 * pn + (r - 128); }
    return n < 2344 ? n : (n < 2560 ? -1 : n - 216);
}
DI void tconv(LAS float* tl  , const float* src, int Nsrc, int K, u16* dst, int Np, int map, int tid) {
    const int tilesN = Np >> 6, tilesK = K >> 6, ntile = tilesN * tilesK;
    for (int t0 = blockIdx.x * 2; t0 < ntile; t0 += gridDim.x * 2) {
        const bool hb = t0 + 1 < ntile; float va[8], vb[8];
        const int c = tid & 63, r0 = tid >> 6;
        { const int tn = t0 % tilesN, tk = t0 / tilesN; const int sc = srccol(map, tn * 64 + c);
#pragma unroll
          for (int rr = 0; rr < 8; ++rr) va[rr] = sc >= 0 ? src[(size_t)(tk * 64 + r0 + 8 * rr) * Nsrc + sc] : 0.f; }
        if (hb) { const int tn = (t0 + 1) % tilesN, tk = (t0 + 1) / tilesN; const int sc = srccol(map, tn * 64 + c);
#pragma unroll
          for (int rr = 0; rr < 8; ++rr) vb[rr] = sc >= 0 ? src[(size_t)(tk * 64 + r0 + 8 * rr) * Nsrc + sc] : 0.f; }
#pragma unroll
        for (int rr = 0; rr < 8; ++rr) { tl[(r0 + 8 * rr) * 65 + c] = va[rr]; if (hb) tl[64 * 65 + (r0 + 8 * rr) * 65 + c] = vb[rr]; }
        __syncthreads();
        { const int kk2 = (tid & 31) * 2, n0 = tid >> 5;
#pragma unroll
          for (int h = 0; h < 2; ++h) { if (h == 1 && !hb) break; const int t = t0 + h, tn = t % tilesN, tk = t / tilesN; LAS float* tt = tl + h * 64 * 65;
#pragma unroll
            for (int rr = 0; rr < 4; ++rr) { const int n = n0 + 16 * rr; *(unsigned*)(dst + (size_t)(tn * 64 + n) * K + tk * 64 + kk2) = cvt_pk_bf16(tt[kk2 * 65 + n], tt[(kk2 + 1) * 65 + n]); } } }
        __syncthreads();
    }
}
DI void ssm_tables(const Frame& F, int l, int g, int p) {
    unsigned char* tab = F.ws + WS_TAB + (size_t)l * SZ_TABL;
    const int lg = l * 32 + g;
    const double lr = fmin((double)F.in[6][lg * 64 + p], -1e-4), li = (double)F.in[7][lg * 64 + p], dt = exp((double)F.in[8][lg]);
    const double zr = lr * dt, zi = li * dt, ea = exp(zr);
    double ar = ea * cos(zi), ai = ea * sin(zi);
    const double nr = ar - 1.0, ni = ai, den = lr * lr + li * li, fr_ = (nr * lr + ni * li) / den, fi_ = (ni * lr - nr * li) / den;
    ((float*)(tab + TAB_A1))[(g * 64 + p) * 2] = (float)ar; ((float*)(tab + TAB_A1))[(g * 64 + p) * 2 + 1] = (float)ai;
    double pr = ar, pi = ai;
#pragma unroll 1
    for (int s = 0; s < 6; ++s) { const double t = pr * pr - pi * pi; pi = 2.0 * pr * pi; pr = t; }
    ((float*)(tab + TAB_A64))[(g * 64 + p) * 2] = (float)pr; ((float*)(tab + TAB_A64))[(g * 64 + p) * 2 + 1] = (float)pi;
    float* BB = (float*)(tab + TAB_BB) + (size_t)g * 32 * 64;
    const float* bre = F.in[9] + ((size_t)lg * 64 + p) * 16; const float* bim = F.in[10] + ((size_t)lg * 64 + p) * 16;
    u16* BBH = (u16*)(tab + TAB_BBH) + (size_t)g * 128 * 16;
#pragma unroll 1
    for (int h = 0; h < 16; ++h) { const double br = bre[h], bi = bim[h]; const float vr = (float)(fr_ * br - fi_ * bi), vi = (float)(fr_ * bi + fi_ * br); BB[(2 * h) * 64 + p] = vr; BB[(2 * h + 1) * 64 + p] = vi;
        const unsigned pk = cvt_pk_bf16(vr, vi); BBH[(2 * p) * 16 + h] = (u16)(pk & 0xffffu); BBH[(2 * p + 1) * 16 + h] = (u16)(pk >> 16); }
    u16* CT = (u16*)(tab + TAB_CT) + (size_t)g * 16 * 128;
    const float* cre = F.in[11] + (size_t)lg * 16 * 64; const float* cim = F.in[12] + (size_t)lg * 16 * 64;
#pragma unroll 1
    for (int h = 0; h < 16; ++h) { *(unsigned*)(CT + h * 128 + 2 * p) = cvt_pk_bf16(cre[h * 64 + p], -cim[h * 64 + p]); }
}
DI void p0_phase(const Frame& F, LAS unsigned char* lds) {
    LAS float* tl = (LAS float*)lds;
    for (int l = 0; l < 2; ++l) {
        unsigned char* wl = F.ws + WS_W + (size_t)l * SZ_LAYERW;
        tconv(tl, F.in[1] + (size_t)l * D_ * NUP, NUP, D_, (u16*)(wl + OFF_UP1), NUP, 1, F.tid);
        tconv(tl, F.in[2] + (size_t)l * DFF * D_, D_, DFF, (u16*)(wl + OFF_DN1), D_, 0, F.tid);
        tconv(tl, F.in[5] + (size_t)l * D_ * 4392, 4392, D_, (u16*)(wl + OFF_WIN), NIN, 2, F.tid);
        tconv(tl, F.in[14] + (size_t)l * 512 * 512, 512, 512, (u16*)(wl + OFF_GLU), 512, 0, F.tid);
        tconv(tl, F.in[15] + (size_t)(l * 2 + 0) * 512 * 1024, 1024, 512, (u16*)(wl + OFF_WB0), 1024, 0, F.tid);
        tconv(tl, F.in[15] + (size_t)(l * 2 + 1) * 512 * 1024, 1024, 512, (u16*)(wl + OFF_WB1), 1024, 0, F.tid);
        tconv(tl, F.in[16] + (size_t)l * 1024 * 1024, 1024, 1024, (u16*)(wl + OFF_WOUT), 1024, 0, F.tid);
        tconv(tl, F.in[19] + (size_t)l * D_ * NUP, NUP, D_, (u16*)(wl + OFF_UP2), NUP, 1, F.tid);
        tconv(tl, F.in[20] + (size_t)l * DFF * D_, D_, DFF, (u16*)(wl + OFF_DN2), D_, 0, F.tid);
    }
    { const size_t n4 = (size_t)T_ * D_ / 4, step = (size_t)gridDim.x * NTHR; const f32x4* x4 = (const f32x4*)F.in[0]; u32x2* o = (u32x2*)F_XB(F);
      for (size_t i = (size_t)blockIdx.x * NTHR + F.tid; i < n4; i += 4 * step) { f32x4 v[4];
#pragma unroll
          for (int j = 0; j < 4; ++j) if (i + j * step < n4) v[j] = x4[i + j * step];
#pragma unroll
          for (int j = 0; j < 4; ++j) if (i + j * step < n4) { u32x2 w; w.x = cvt_pk_bf16(v[j][0], v[j][1]); w.y = cvt_pk_bf16(v[j][2], v[j][3]); o[i + j * step] = w; } } }
    { const int gw = blockIdx.x * 8 + F.wave; if (gw < 64) ssm_tables(F, gw >> 5, gw & 31, F.lane); }
}

DI float wave_sum(float v) {
#pragma unroll
    for (int o = 32; o >= 1; o >>= 1) v += __shfl_xor(v, o);
    return v;
}
DI void ln_phase(const Frame& F, const float* g, const float* b, bool final) {
    const int lane = F.lane; f32x4 gv[4], bv[4];
#pragma unroll
    for (int i = 0; i < 4; ++i) { gv[i] = *(const f32x4*)(g + i * 256 + lane * 4); bv[i] = *(const f32x4*)(b + i * 256 + lane * 4); }
    const int stride = gridDim.x * 8; f32x2_t* stats = (f32x2_t*)(F.ws + WS_STATS);
    for (int row0 = blockIdx.x * 8 + F.wave; row0 < T_; row0 += 2 * stride) {
        const int row1 = row0 + stride < T_ ? row0 + stride : row0;
        float* p0 = F.out + (size_t)row0 * D_; float* p1 = F.out + (size_t)row1 * D_; f32x4 v[4], u[4]; float s0 = 0.f, s1 = 0.f;
#pragma unroll
        for (int i = 0; i < 4; ++i) { v[i] = *(const f32x4*)(p0 + i * 256 + lane * 4); u[i] = *(const f32x4*)(p1 + i * 256 + lane * 4); }
#pragma unroll
        for (int i = 0; i < 4; ++i) { s0 += (v[i][0] + v[i][1]) + (v[i][2] + v[i][3]); s1 += (u[i][0] + u[i][1]) + (u[i][2] + u[i][3]); }
        const float mean0 = wave_sum(s0) * (1.0f / 1024.0f), mean1 = wave_sum(s1) * (1.0f / 1024.0f); float q0 = 0.f, q1 = 0.f;
#pragma unroll
        for (int i = 0; i < 4; ++i) { v[i] = v[i] - mean0; u[i] = u[i] - mean1; q0 += (v[i][0] * v[i][0] + v[i][1] * v[i][1]) + (v[i][2] * v[i][2] + v[i][3] * v[i][3]); q1 += (u[i][0] * u[i][0] + u[i][1] * u[i][1]) + (u[i][2] * u[i][2] + u[i][3] * u[i][3]); }
        const float rstd0 = rsqrtf(wave_sum(q0) * (1.0f / 1024.0f) + LN_EPS), rstd1 = rsqrtf(wave_sum(q1) * (1.0f / 1024.0f) + LN_EPS);
        if (!final && lane == 0) { stats[row0] = (f32x2_t){mean0, rstd0}; if (row1 != row0) stats[row1] = (f32x2_t){mean1, rstd1}; }
#pragma unroll
        for (int i = 0; i < 4; ++i) { const f32x4 y = v[i] * rstd0 * gv[i] + bv[i]; if (final) *(f32x4*)(p0 + i * 256 + lane * 4) = y;
            else { u32x2 w; w.x = cvt_pk_bf16(y[0], y[1]); w.y = cvt_pk_bf16(y[2], y[3]); *(u32x2*)(F_XB(F) + (size_t)row0 * D_ + i * 256 + lane * 4) = w; } }
        if (row1 != row0) {
#pragma unroll
            for (int i = 0; i < 4; ++i) { const f32x4 y = u[i] * rstd1 * gv[i] + bv[i]; if (final) *(f32x4*)(p1 + i * 256 + lane * 4) = y;
                else { u32x2 w; w.x = cvt_pk_bf16(y[0], y[1]); w.y = cvt_pk_bf16(y[2], y[3]); *(u32x2*)(F_XB(F) + (size_t)row1 * D_ + i * 256 + lane * 4) = w; } } }
    }
}

DI void wave_lds_fence() { asm volatile("s_waitcnt lgkmcnt(0)" ::: "memory"); __builtin_amdgcn_wave_barrier(); }
DI float gelu_tanh(float x) { const float z = 0.7978845608028654f * (x + 0.044715f * x * x * x); return x * __builtin_amdgcn_rcpf(1.0f + __expf(-2.0f * z)); }

DI void vt_tile(const Frame& F, LAS unsigned char* wl, int tile) {
    LAS u16* tb = (LAS u16*)wl;
    const int tt = tile >> 3, hb = tile & 7, lane = F.lane; const int t0 = tt * 64;
    const u16* src = F_V(F) + (size_t)(t0 + lane) * 512 + hb * 64;
#pragma unroll
    for (int c = 0; c < 8; ++c) *(LAS u32x4*)(tb + lane * 72 + c * 8) = *(const u32x4*)(src + c * 8);
    wave_lds_fence();
    const int b = t0 >> 13, tl = t0 & 8191;
    u16* dst = F_VT(F) + ((size_t)(b * 512 + hb * 64 + lane)) * SEQ + tl;
#pragma unroll
    for (int c = 0; c < 8; ++c) { u32x4 w; unsigned e[8];
#pragma unroll
        for (int j = 0; j < 8; ++j) e[j] = tb[(c * 8 + j) * 72 + lane];
        w.x = e[0] | (e[1] << 16); w.y = e[2] | (e[3] << 16); w.z = e[4] | (e[5] << 16); w.w = e[6] | (e[7] << 16);
        *(u32x4*)(dst + c * 8) = w; }
    wave_lds_fence();
}
struct SsmP { float ar, ai, cr, ci; };
DI void ssm_load_g(const unsigned char* tab, const float* dskip, int g, int lane, float& ar, float& ai, float& cr, float& ci, bf16x8 (&af)[8], bf16x8 (&cf)[4], f32x4& dv) {
    ar = ((const float*)(tab + TAB_A1))[(g * 64 + lane) * 2]; ai = ((const float*)(tab + TAB_A1))[(g * 64 + lane) * 2 + 1];
    cr = ((const float*)(tab + TAB_A64))[(g * 64 + lane) * 2]; ci = ((const float*)(tab + TAB_A64))[(g * 64 + lane) * 2 + 1];
    const int lq = lane & 15, g4 = lane >> 4;
    const u16* BBH = (const u16*)(tab + TAB_BBH) + (size_t)g * 128 * 16;
#pragma unroll
    for (int mt = 0; mt < 8; ++mt) { const u32x4 z = {0u, 0u, 0u, 0u}; af[mt] = g4 < 2 ? *(const bf16x8*)(BBH + (mt * 16 + lq) * 16 + g4 * 8) : __builtin_bit_cast(bf16x8, z); }
    const u16* CT = (const u16*)(tab + TAB_CT) + (size_t)g * 16 * 128;
#pragma unroll
    for (int ks = 0; ks < 4; ++ks) cf[ks] = *(const bf16x8*)(CT + lq * 128 + ks * 32 + g4 * 8);
    dv = *(const f32x4*)(dskip + g * 16 + g4 * 4);
}
DI void ssm_bu_tile(const Frame& F, LAS unsigned* bt  , int t0, int g, const bf16x8 (&af)[8], int lq, int g4) {
    bf16x8 bf[4];
#pragma unroll
    for (int nt = 0; nt < 4; ++nt) { const u32x4 z = {0u, 0u, 0u, 0u}; bf[nt] = g4 < 2 ? *(const bf16x8*)(F_U(F) + (size_t)(t0 + nt * 16 + lq) * 512 + g * 16 + g4 * 8) : __builtin_bit_cast(bf16x8, z); }
#pragma unroll
    for (int nt = 0; nt < 4; ++nt)
#pragma unroll
        for (int mt = 0; mt < 8; ++mt) { const f32x4 z = {0.f, 0.f, 0.f, 0.f}; const f32x4 acc = __builtin_amdgcn_mfma_f32_16x16x32_bf16(af[mt], bf[nt], z, 0, 0, 0);
            u32x2 w; w.x = cvt_pk_bf16(acc[0], acc[1]); w.y = cvt_pk_bf16(acc[2], acc[3]);
            *(LAS u32x2*)(bt + (nt * 16 + lq) * 68 + mt * 8 + g4 * 2) = w; }
}
DI void ssmA_item(const Frame& F, LAS unsigned char* wl, int item, const float ar, const float ai, const bf16x8 (&af)[8]) {
    LAS unsigned* bt = (LAS unsigned*)wl;
    const int chunk = item >> 5, g = item & 31, lane = F.lane; const int t0 = chunk * 64;
    ssm_bu_tile(F, bt, t0, g, af, lane & 15, lane >> 4);
    wave_lds_fence();
    float sr = 0.f, si = 0.f;
#pragma unroll 8
    for (int j = 0; j < 64; ++j) { const unsigned w = bt[j * 68 + lane]; const float br = bf_lo(w), bi = bf_hi(w);
        const float nr = ar * sr - ai * si + br, ni = ar * si + ai * sr + bi; sr = nr; si = ni; }
    *(float2*)(F_SLOC(F) + ((size_t)item * 64 + lane) * 2) = make_float2(sr, si);
    wave_lds_fence();
}
DI void ssmC_item(const Frame& F, LAS unsigned char* wl, int item, const float ar, const float ai, const float cr, const float ci, const bf16x8 (&af)[8], const bf16x8 (&cf)[4], const f32x4 dv, float& sr, float& si, bool first) {
    LAS u16* ut = (LAS u16*)wl;
    LAS unsigned* st = (LAS unsigned*)(wl + 2048);
    const int chunk = item >> 5, g = item & 31, lane = F.lane, lq = lane & 15, g4 = lane >> 4; const int t0 = chunk * 64;
    { const u16* up = F_U(F) + (size_t)(t0 + lane) * 512 + g * 16; const u32x4 a = *(const u32x4*)up, b = *(const u32x4*)(up + 8);
      *(LAS u32x4*)(ut + lane * 16) = a; *(LAS u32x4*)(ut + lane * 16 + 8) = b; }
    if (first) { sr = 0.f; si = 0.f;
      const int cin = chunk & 127, c0 = chunk - cin; const float2* sl = (const float2*)F_SLOC(F) + ((size_t)c0 * 32 + g) * 64 + lane;
#pragma unroll 8
      for (int c = 0; c < cin; ++c) { const float2 v = sl[(size_t)c * 32 * 64]; const float nr = cr * sr - ci * si + v.x, ni = cr * si + ci * sr + v.y; sr = nr; si = ni; } }
    ssm_bu_tile(F, st, t0, g, af, lq, g4);
    wave_lds_fence();
#pragma unroll 8
    for (int j = 0; j < 64; ++j) { const unsigned w = st[j * 68 + lane]; const float br = bf_lo(w), bi = bf_hi(w);
        const float nr = ar * sr - ai * si + br, ni = ar * si + ai * sr + bi; sr = nr; si = ni;
        st[j * 68 + lane] = cvt_pk_bf16(sr, si); }
    wave_lds_fence();
#pragma unroll
    for (int mt = 0; mt < 4; ++mt) {
        f32x4 acc = {0.f, 0.f, 0.f, 0.f};
#pragma unroll
        for (int ks = 0; ks < 4; ++ks) { const bf16x8 sf = *(LAS bf16x8*)(st + (mt * 16 + lq) * 68 + ks * 16 + g4 * 4); acc = __builtin_amdgcn_mfma_f32_16x16x32_bf16(cf[ks], sf, acc, 0, 0, 0); }
        const int l = mt * 16 + lq; const u32x2 uw = *(LAS u32x2*)(ut + l * 16 + g4 * 4);
        const float u0 = bf_lo(uw.x), u1 = bf_hi(uw.x), u2 = bf_lo(uw.y), u3 = bf_hi(uw.y);
        u32x2 o; o.x = cvt_pk_bf16(gelu_tanh(acc[0] + dv[0] * u0), gelu_tanh(acc[1] + dv[1] * u1)); o.y = cvt_pk_bf16(gelu_tanh(acc[2] + dv[2] * u2), gelu_tanh(acc[3] + dv[3] * u3));
        *(u32x2*)(F_U(F) + (size_t)(t0 + l) * 512 + g * 16 + g4 * 4) = o;
    }
    wave_lds_fence();
}

DI unsigned fkey(float x) { const int u = __float_as_int(x); return (unsigned)u ^ ((unsigned)(u >> 31) | 0x80000000u); }
DI f32x4 idx_scores(const bf16x8 af, const bf16x8 (&qf)[8], const float (&w)[8]) {
    f32x4 a[8];
#pragma unroll
    for (int h = 0; h < 8; ++h) { const f32x4 z = {0.f, 0.f, 0.f, 0.f}; a[h] = __builtin_amdgcn_mfma_f32_16x16x32_bf16(af, qf[h], z, 0, 0, 0); }
    f32x2_t s01 = {0.f, 0.f}, s23 = {0.f, 0.f};
#pragma unroll
    for (int h = 0; h < 8; ++h) {
        const float r0 = __int_as_float(max(__float_as_int(a[h][0]), 0)), r1 = __int_as_float(max(__float_as_int(a[h][1]), 0));
        const float r2 = __int_as_float(max(__float_as_int(a[h][2]), 0)), r3 = __int_as_float(max(__float_as_int(a[h][3]), 0));
        const f32x2_t ww = {w[h], w[h]}; s01 = __builtin_elementwise_fma(ww, (f32x2_t){r0, r1}, s01); s23 = __builtin_elementwise_fma(ww, (f32x2_t){r2, r3}, s23);
    }
    return (f32x4){s01[0], s01[1], s23[0], s23[1]};
}
DI void idx_load4(bf16x8 (&af)[4], const u16* kib, int kb, unsigned voff) {
    const char* p = (const char*)(kib + (size_t)kb * 64 * 32);
#pragma unroll
    for (int st = 0; st < 4; ++st) af[st] = __builtin_bit_cast(bf16x8, *(const u32x4*)(p + st * 1024 + voff));
}
DI unsigned wave_usum(unsigned v) {
#pragma unroll
    for (int o = 32; o >= 1; o >>= 1) v += (unsigned)__shfl_xor((int)v, o);
    return v;
}
DI unsigned wave_suffix(unsigned c, int lane) {
    unsigned s = c;
#pragma unroll
    for (int off = 1; off < 64; off <<= 1) { const unsigned t = __shfl_down(s, off); if (lane + off < 64) s += t; }
    return s;
}
constexpr int HS = 2052;
DI bool idx_select(LAS unsigned* hist, LAS unsigned* rpre, LAS unsigned* rneed, int row, int lane, int dbits, unsigned& ne_out) {
    LAS unsigned* h = hist + row * HS; unsigned c = 0;
#pragma unroll
    for (int j = 0; j < 8; ++j) { const u32x4 v = *(LAS u32x4*)(h + lane * 32 + j * 4); c += (v.x & 0xffffu) + (v.x >> 16) + (v.y & 0xffffu) + (v.y >> 16) + (v.z & 0xffffu) + (v.z >> 16) + (v.w & 0xffffu) + (v.w >> 16); }
    const unsigned s = wave_suffix(c, lane), need = rneed[row];
    const u64 bal = __ballot(s >= need); const int L = 63 - __clzll(bal);
    const unsigned cum_hi = __shfl(s - c, L);
    const unsigned v = ((LAS u16*)h)[L * 64 + lane];
    const unsigned s2 = wave_suffix(v, lane);
    const u64 bal2 = __ballot(cum_hi + s2 >= need); const int l2 = 63 - __clzll(bal2);
    const unsigned cum = __shfl(cum_hi + s2 - v, l2), ne = __shfl(v, l2), nn = need - cum;
    if (lane == 0) { rpre[row] = (rpre[row] << dbits) | (unsigned)(L * 64 + l2); rneed[row] = nn; }
    ne_out = ne;
    return nn < ne;
}
#ifndef REPM
#define REPM 0
#endif
DI void idx_phase(const Frame& F, LAS unsigned char* lds) {
    LAS unsigned* hist = (LAS unsigned*)lds;
    LAS unsigned* rpre = (LAS unsigned*)(lds + 16 * HS * 4);
    LAS unsigned* rneed = rpre + 16; LAS unsigned* rcut = rpre + 32; LAS unsigned* rp3 = rpre + 48; LAS unsigned* flags = rpre + 64;
    LAS unsigned* lcnt = rpre + 80; LAS unsigned* lkey = hist; LAS unsigned* lidx = hist + 4096;
    constexpr unsigned CAP6 = 512u; LAS unsigned* lkey6 = hist; LAS unsigned* lidx6 = hist + 8192; LAS u16* lmask = (LAS u16*)(hist + 16384);
    const int tid = F.tid, lane = F.lane, wave = F.wave, lq = lane & 15, g4 = lane >> 4;
    const unsigned voff = (unsigned)(lq * 64 + g4 * 16);
    for (int pair = blockIdx.x; pair < 256; pair += gridDim.x) {
        const int b = pair >> 6, jj = pair & 63;
        const u16* kib = F_KIB(F) + (size_t)b * SEQ * 32;
#pragma unroll 1
        for (int it = 0; it < 8; ++it) {
            const int which = it >> 2, sub = it & 3, tile = which ? 127 - jj : jj, nkb = tile + 1;
            const size_t tq = (size_t)b * SEQ + tile * 64 + sub * 16 + lq;
            bf16x8 qf[8]; float w[8];
#pragma unroll
            for (int h = 0; h < 8; ++h) qf[h] = *(const bf16x8*)(F_QI(F) + tq * 256 + h * 32 + g4 * 8);
            { const f32x4 w0 = *(const f32x4*)(F_WI(F) + tq * 8), w1 = *(const f32x4*)(F_WI(F) + tq * 8 + 4);
#pragma unroll
              for (int i = 0; i < 4; ++i) { w[i] = w0[i]; w[4 + i] = w1[i]; } }
            const size_t mbase = (size_t)b * MASK_PER_B + (size_t)(tile + 1) * (2 * tile + sub);
            if (tid < 16) { rpre[tid] = 0u; rneed[tid] = 256u; rcut[tid] = 0x7fffffffu; rp3[tid] = 0u; }
            if (tid == 0) { flags[0] = 0u; flags[1] = 0u; flags[2] = 0u; }
            int mode = nkb > 4 ? 1 : 4; bool rep_done = false; (void)rep_done;
#pragma unroll 1
            while (true) {
                if (mode < 3) { for (int i = tid; i < 4 * HS; i += NTHR) ((LAS u32x4*)hist)[i] = (u32x4){0u, 0u, 0u, 0u}; }
                if ((mode == 3 || mode == 6) && tid < 16) lcnt[tid] = 0u;
                __syncthreads();
                unsigned thr = 0u, cut = 0x7fffffffu, pre = rpre[lq], rem = rneed[lq], mycut = 0x7fffffffu; const bool p3 = rp3[lq] != 0u, need_res = rcut[lq] == 0xffffffffu;
                const unsigned st3 = rp3[lq]; unsigned tsh = 8u;
                if (mode == 4 && nkb > 4) { thr = pre; if (st3 != 0u) cut = rcut[lq]; if (st3 == 1u) tsh = 0u; }
                const u64 tcomp = ((u64)thr << 32) | (u64)(~cut);
                const int kb0 = mode == 5 ? 0 : wave, kstep = mode == 5 ? 1 : 8;
                const unsigned dsh = mode == 1 ? 20u : 8u, psh = mode == 1 ? 32u : 20u;
                if (kb0 < nkb && (mode != 5 || wave == 0)) {
                    bf16x8 af[4], nf[4];
                    idx_load4(af, kib, kb0, voff);
                    __builtin_amdgcn_s_waitcnt(0x0F70);
#pragma unroll 1
                    for (int kb = kb0; kb < nkb; kb += kstep) {
                        if (kb + kstep < nkb) idx_load4(nf, kib, kb + kstep, voff);
                        unsigned bits = 0u;
#pragma unroll
                        for (int st = 0; st < 4; ++st) {
                            const f32x4 sc = idx_scores(af[st], qf, w);
                            unsigned key[4];
#pragma unroll
                            for (int i = 0; i < 4; ++i) key[i] = fkey(sc[i]);
                            if (mode == 4) {
#pragma unroll
                                for (int i = 0; i < 4; ++i) { const unsigned idx = (unsigned)(kb * 64 + st * 16 + g4 * 4 + i); const u64 comp = ((u64)(key[i] >> tsh) << 32) | (u64)(~idx); bits |= (comp >= tcomp ? 1u : 0u) << (st * 4 + i); }
                            } else if (mode == 5) {
                                int tie[4]; int any = 0;
#pragma unroll
                                for (int i = 0; i < 4; ++i) { tie[i] = (need_res && (key[i] >> 8) == pre) ? 1 : 0; any |= tie[i]; }
                                if (__any(any)) {
#pragma unroll
                                    for (int gg = 0; gg < 4; ++gg)
#pragma unroll
                                        for (int i = 0; i < 4; ++i) { const int f = (g4 == gg) ? tie[i] : 0; const int c = __shfl(f, gg * 16 + lq);
                                            if (c && rem > 0u) { --rem; if (rem == 0u) mycut = (unsigned)(kb * 64 + st * 16 + gg * 4 + i); } }
                                }
                            } else if (mode == 6) {
                                int m4 = 0;
#pragma unroll
                                for (int i = 0; i < 4; ++i) { const unsigned k12 = key[i] >> 20; bits |= (k12 > pre ? 1u : 0u) << (st * 4 + i); m4 |= (k12 == pre) ? (1 << i) : 0; }
                                if (__any(m4)) {
#pragma unroll
                                    for (int i = 0; i < 4; ++i) if ((m4 >> i) & 1) { const unsigned slot = __hip_atomic_fetch_add(lcnt + lq, 1u, __ATOMIC_RELAXED, __HIP_MEMORY_SCOPE_WORKGROUP);
                                        if (slot < CAP6) { lkey6[lq * CAP6 + slot] = key[i]; lidx6[lq * CAP6 + slot] = (unsigned)(kb * 64 + st * 16 + g4 * 4 + i); } }
                                }
                            } else if (mode == 3) {
                                int m4 = 0;
#pragma unroll
                                for (int i = 0; i < 4; ++i) m4 |= (p3 && (key[i] >> 8) == pre) ? (1 << i) : 0;
                                if (__any(m4)) {
#pragma unroll
                                    for (int i = 0; i < 4; ++i) if ((m4 >> i) & 1) { const unsigned slot = __hip_atomic_fetch_add(lcnt + lq, 1u, __ATOMIC_RELAXED, __HIP_MEMORY_SCOPE_WORKGROUP);
                                        if (slot < 256u) { lkey[lq * 256 + slot] = key[i]; lidx[lq * 256 + slot] = (unsigned)(kb * 64 + st * 16 + g4 * 4 + i); } }
                                }
                            } else if (mode == 1) {
#pragma unroll
                                for (int i = 0; i < 4; ++i) { const unsigned digit = key[i] >> 20;
                                    __hip_atomic_fetch_add(hist + lq * HS + (digit >> 1), 1u << ((digit & 1u) * 16), __ATOMIC_RELAXED, __HIP_MEMORY_SCOPE_WORKGROUP); }
                            } else {
#pragma unroll
                                for (int i = 0; i < 4; ++i) { const unsigned digit = (key[i] >> dsh) & 4095u; const bool ok = (unsigned)((u64)key[i] >> psh) == pre;
                                    __hip_atomic_fetch_add(hist + lq * HS + (digit >> 1), ok ? (1u << ((digit & 1u) * 16)) : 0u, __ATOMIC_RELAXED, __HIP_MEMORY_SCOPE_WORKGROUP); }
                            }
                            __builtin_amdgcn_sched_barrier(0);
                        }
                        if (mode == 4) F_MASK(F)[(mbase + kb) * 64 + lane] = (u16)(nkb > 4 ? bits : 0xffffu);
                        if (mode == 6) lmask[kb * 64 + lane] = (u16)bits;
#pragma unroll
                        for (int st = 0; st < 4; ++st) af[st] = nf[st];
                    }
                    if (mode == 5 && need_res && g4 == 0) rcut[lq] = mycut;
                }
                __syncthreads();
#if REPM
                if (mode == REPM && !rep_done) { rep_done = true; continue; }
#endif
                if (mode == 6) {
#pragma unroll 1
                    for (int r = 0; r < 2; ++r) { const int row = wave * 2 + r; const unsigned n = lcnt[row], need = rneed[row];
                        unsigned low[8], xi[8];
#pragma unroll
                        for (int c = 0; c < 8; ++c) { const unsigned e = (unsigned)(c * 64 + lane); const bool valid = e < n; low[c] = valid ? (lkey6[row * CAP6 + e] & 0xfffffu) + 1u : 0u; xi[c] = valid ? lidx6[row * CAP6 + e] : 0xffffffffu; }
                        unsigned t20 = 0u;
#pragma unroll 1
                        for (int bb = 20; bb >= 0; --bb) { const unsigned t = t20 | (1u << bb); unsigned cnt = 0u;
#pragma unroll
                            for (int c = 0; c < 8; ++c) cnt += (unsigned)__popcll(__ballot(low[c] >= t));
                            if (cnt >= need) t20 = t; }
                        unsigned cgt = 0u, ceq = 0u;
#pragma unroll
                        for (int c = 0; c < 8; ++c) { cgt += (unsigned)__popcll(__ballot(low[c] > t20)); ceq += (unsigned)__popcll(__ballot(low[c] == t20)); }
                        const unsigned need_eq = need - cgt; unsigned cut6 = 0x7fffffffu;
                        if (ceq > need_eq) {
                            unsigned cc = 0u;
#pragma unroll 1
                            for (int bb = 12; bb >= 0; --bb) { const unsigned t = cc | (1u << bb); unsigned cnt = 0u;
#pragma unroll
                                for (int c = 0; c < 8; ++c) cnt += (unsigned)__popcll(__ballot(low[c] == t20 && xi[c] < t));
                                if (cnt < need_eq) cc = t; }
                            cut6 = cc; }
#pragma unroll
                        for (int c = 0; c < 8; ++c) { if (low[c] != 0u && (low[c] > t20 || (low[c] == t20 && xi[c] <= cut6))) { const unsigned idx = xi[c];
                                const unsigned hw = (idx >> 6) * 64u + ((idx >> 2) & 3u) * 16u + (unsigned)row, bit = ((idx >> 4) & 3u) * 4u + (idx & 3u);
                                __hip_atomic_fetch_or((LAS unsigned*)lmask + (hw >> 1), 1u << (16u * (hw & 1u) + bit), __ATOMIC_RELAXED, __HIP_MEMORY_SCOPE_WORKGROUP); } }
                    }
                    __syncthreads();
#pragma unroll 1
                    for (int kb = wave; kb < nkb; kb += 8) F_MASK(F)[(mbase + kb) * 64 + lane] = lmask[kb * 64 + lane];
                    __syncthreads();
                    break;
                }
                if (mode == 4) break;
                if (mode == 5) { mode = 4; continue; }
#pragma unroll 1
                for (int r = 0; r < 2; ++r) { const int row = wave * 2 + r;
                    if (mode == 3) {
                        if (rp3[row] == 0u) continue;
                        const unsigned n = lcnt[row];
                        if (n > 256u) { if (lane == 0) { rcut[row] = 0xffffffffu; rp3[row] = 2u; flags[1] = 1u; } continue; }
                        unsigned ki[4], xi[4], rank[4];
#pragma unroll
                        for (int c = 0; c < 4; ++c) { const unsigned e = (unsigned)(c * 64 + lane); ki[c] = e < n ? lkey[row * 256 + e] : 0u; xi[c] = e < n ? lidx[row * 256 + e] : 0xffffffffu; rank[c] = 0u; }
#pragma unroll 1
                        for (unsigned j = 0; j < n; ++j) { const unsigned kj = lkey[row * 256 + j], xj = lidx[row * 256 + j];
#pragma unroll
                            for (int c = 0; c < 4; ++c) rank[c] += (kj > ki[c] || (kj == ki[c] && xj < xi[c])) ? 1u : 0u; }
                        const unsigned want = rneed[row];
#pragma unroll
                        for (int c = 0; c < 4; ++c) if ((unsigned)(c * 64 + lane) < n && rank[c] + 1u == want) { rpre[row] = ki[c]; rcut[row] = xi[c]; }
                        continue;
                    }
                    unsigned ne; const bool over = idx_select(hist, rpre, rneed, row, lane, 12, ne);
                    if (mode == 1 && ne > CAP6 && lane == 0) flags[2] = 1u;
                    if (over && lane == 0 && mode == 2) { rp3[row] = 1u; flags[0] = 1u; } }
                __syncthreads();
                if (mode == 1) mode = flags[2] == 0u ? 6 : 2; else if (mode == 2) mode = flags[0] != 0u ? 3 : 4; else mode = flags[1] != 0u ? 5 : 4;
            }
        }
    }
}

DI int t5_bucket(int rel) {
    const int n = rel < 0 ? -rel : rel;
    const int lg = 8 + (n >= 12) + (n >= 16) + (n >= 23) + (n >= 32) + (n >= 46) + (n >= 64) + (n >= 91);
    return (rel > 0 ? 16 : 0) + (n < 8 ? n : lg);
}
DI u32x4 ldg16(const void* sbase, unsigned voff) { return *(const u32x4*)((const char*)sbase + voff); }
constexpr int NH = 1;
constexpr int RT = 2;
constexpr int KP = NH * 64 + 8, VP = 72;
template <bool NEAR>
DI void att_tile_old(LAS u16* Kb, LAS u16* Vb, LAS float* bl, const unsigned (&bits)[RT], int kt, int rowl, int lq, int g4, const bf16x8 (&qf)[RT][NH][2], f32x4 (&O)[RT][NH][4], float (&m)[RT][NH], float (&l)[RT][NH]) {
#pragma unroll
    for (int hl = 0; hl < NH; ++hl) {
        f32x4 s[RT][4];
#pragma unroll
        for (int nt = 0; nt < 4; ++nt) {
#pragma unroll
            for (int rt = 0; rt < RT; ++rt) s[rt][nt] = (f32x4){0.f, 0.f, 0.f, 0.f};
#pragma unroll
            for (int ks = 0; ks < 2; ++ks) { const bf16x8 a = *(LAS bf16x8*)(Kb + (nt * 16 + lq) * KP + hl * 64 + ks * 32 + g4 * 8);
#pragma unroll
                for (int rt = 0; rt < RT; ++rt) s[rt][nt] = __builtin_amdgcn_mfma_f32_16x16x32_bf16(a, qf[rt][hl][ks], s[rt][nt], 0, 0, 0); } }
        const float bfar = bl[15 * 4 + hl];
        bf16x8 pb[RT][2];
#pragma unroll
        for (int rt = 0; rt < RT; ++rt) {
            float mx = -INFINITY;
#pragma unroll
            for (int nt = 0; nt < 4; ++nt)
#pragma unroll
                for (int i = 0; i < 4; ++i) { float bias = bfar; if (NEAR) { int ri = kt * 64 + nt * 16 + g4 * 4 + i - (rowl + rt * 16 + lq) + 128; ri = ri < 0 ? 0 : (ri > 255 ? 255 : ri); bias = bl[128 + ri * NH + hl]; } const float x = ((bits[rt] >> (nt * 4 + i)) & 1u) ? s[rt][nt][i] * (0.125f * LOG2E) + bias : -INFINITY; s[rt][nt][i] = x; mx = fmaxf(mx, x); }
            mx = fmaxf(mx, __shfl_xor(mx, 16)); mx = fmaxf(mx, __shfl_xor(mx, 32));
            const float mnew = fmaxf(m[rt][hl], mx), msafe = (mnew == -INFINITY) ? 0.f : mnew, alpha = __builtin_amdgcn_exp2f(m[rt][hl] - msafe); m[rt][hl] = mnew;
            float ls = 0.f;
#pragma unroll
            for (int nt = 0; nt < 4; ++nt)
#pragma unroll
                for (int i = 0; i < 4; ++i) { const float p = __builtin_amdgcn_exp2f(s[rt][nt][i] - msafe); s[rt][nt][i] = p; ls += p; }
            l[rt][hl] = l[rt][hl] * alpha + ls;
#pragma unroll
            for (int dt = 0; dt < 4; ++dt) O[rt][hl][dt] = O[rt][hl][dt] * alpha;
#pragma unroll
            for (int kk = 0; kk < 2; ++kk) { const u32x4 pw = pack8(s[rt][2 * kk], s[rt][2 * kk + 1]); pb[rt][kk] = __builtin_bit_cast(bf16x8, pw); }
        }
#pragma unroll
        for (int kk = 0; kk < 2; ++kk)
#pragma unroll
            for (int dt = 0; dt < 4; ++dt) { LAS u16* vp = Vb + (hl * 64 + dt * 16 + lq) * VP + kk * 32 + g4 * 4; const u32x2 v0 = *(LAS u32x2*)vp, v1 = *(LAS u32x2*)(vp + 16);
                u32x4 vw; vw.x = v0.x; vw.y = v0.y; vw.z = v1.x; vw.w = v1.y; const bf16x8 vf = __builtin_bit_cast(bf16x8, vw);
#pragma unroll
                for (int rt = 0; rt < RT; ++rt) O[rt][hl][dt] = __builtin_amdgcn_mfma_f32_16x16x32_bf16(vf, pb[rt][kk], O[rt][hl][dt], 0, 0, 0); }
    }
}
DI void att_tile_far(LAS u16* Kb, LAS u16* Vb, LAS float* bl, const unsigned (&bits)[RT], const bf16x8 (&qf)[RT][NH][2], f32x4 (&O)[RT][NH][4], float (&m)[RT][NH], float (&l)[RT][NH], int lq, int g4) {
#pragma unroll
    for (int hl = 0; hl < NH; ++hl) {
        bf16x8 kf[4][2], vf[2][4];
#pragma unroll
        for (int nt = 0; nt < 4; ++nt)
#pragma unroll
            for (int ks = 0; ks < 2; ++ks) kf[nt][ks] = *(LAS bf16x8*)(Kb + (nt * 16 + lq) * KP + hl * 64 + ks * 32 + g4 * 8);
#pragma unroll
        for (int kk = 0; kk < 2; ++kk)
#pragma unroll
            for (int dt = 0; dt < 4; ++dt) { LAS u16* vp = Vb + (hl * 64 + dt * 16 + lq) * VP + kk * 32 + g4 * 4; const u32x2 v0 = *(LAS u32x2*)vp, v1 = *(LAS u32x2*)(vp + 16);
                u32x4 vw; vw.x = v0.x; vw.y = v0.y; vw.z = v1.x; vw.w = v1.y; vf[kk][dt] = __builtin_bit_cast(bf16x8, vw); }
        const float bfar = bl[15 * 4 + hl];
        f32x4 s[RT][4];
#pragma unroll
        for (int nt = 0; nt < 4; ++nt) {
#pragma unroll
            for (int rt = 0; rt < RT; ++rt) s[rt][nt] = (f32x4){0.f, 0.f, 0.f, 0.f};
#pragma unroll
            for (int ks = 0; ks < 2; ++ks)
#pragma unroll
                for (int rt = 0; rt < RT; ++rt) s[rt][nt] = __builtin_amdgcn_mfma_f32_16x16x32_bf16(kf[nt][ks], qf[rt][hl][ks], s[rt][nt], 0, 0, 0); }
        bf16x8 pb[RT][2];
#pragma unroll
        for (int rt = 0; rt < RT; ++rt) {
            float mx = -INFINITY;
#pragma unroll
            for (int nt = 0; nt < 4; ++nt)
#pragma unroll
                for (int i = 0; i < 4; ++i) { const int sel = __builtin_amdgcn_sbfe((int)bits[rt], nt * 4 + i, 1);
                    const float x = __int_as_float((__float_as_int(s[rt][nt][i]) & sel) | (int)(0xff800000u & ~(unsigned)sel)); s[rt][nt][i] = x; mx = fmaxf(mx, x); }
            mx = fmaxf(mx, __shfl_xor(mx, 16)); mx = fmaxf(mx, __shfl_xor(mx, 32));
            const float mxl = mx * (0.125f * LOG2E) + bfar;
            const float mnew = fmaxf(m[rt][hl], mxl), msafe = (mnew == -INFINITY) ? 0.f : mnew, alpha = __builtin_amdgcn_exp2f(m[rt][hl] - msafe); m[rt][hl] = mnew;
            const float boff = bfar - msafe; float ls = 0.f;
#pragma unroll
            for (int nt = 0; nt < 4; ++nt)
#pragma unroll
                for (int i = 0; i < 4; ++i) { const float p = __builtin_amdgcn_exp2f(s[rt][nt][i] * (0.125f * LOG2E) + boff); s[rt][nt][i] = p; ls += p; }
            l[rt][hl] = l[rt][hl] * alpha + ls;
#pragma unroll
            for (int dt = 0; dt < 4; ++dt) O[rt][hl][dt] = O[rt][hl][dt] * alpha;
#pragma unroll
            for (int kk = 0; kk < 2; ++kk) { const u32x4 pw = pack8(s[rt][2 * kk], s[rt][2 * kk + 1]); pb[rt][kk] = __builtin_bit_cast(bf16x8, pw); }
        }
#pragma unroll
        for (int kk = 0; kk < 2; ++kk)
#pragma unroll
            for (int dt = 0; dt < 4; ++dt)
#pragma unroll
                for (int rt = 0; rt < RT; ++rt) O[rt][hl][dt] = __builtin_amdgcn_mfma_f32_16x16x32_bf16(vf[kk][dt], pb[rt][kk], O[rt][hl][dt], 0, 0, 0);
    }
}
DI void att_tile_near(LAS u16* Kb, LAS u16* Vb, LAS float* bl, const unsigned (&bits)[RT], int kt, int rowl, const bf16x8 (&qf)[RT][NH][2], f32x4 (&O)[RT][NH][4], float (&m)[RT][NH], float (&l)[RT][NH], int lq, int g4) {
#pragma unroll
    for (int hl = 0; hl < NH; ++hl) {
        bf16x8 vf[2][4];
        f32x4 s[RT][4];
#pragma unroll
        for (int nt = 0; nt < 4; ++nt) {
#pragma unroll
            for (int rt = 0; rt < RT; ++rt) s[rt][nt] = (f32x4){0.f, 0.f, 0.f, 0.f};
#pragma unroll
            for (int ks = 0; ks < 2; ++ks) { const bf16x8 kfr = *(LAS bf16x8*)(Kb + (nt * 16 + lq) * KP + hl * 64 + ks * 32 + g4 * 8);
#pragma unroll
                for (int rt = 0; rt < RT; ++rt) s[rt][nt] = __builtin_amdgcn_mfma_f32_16x16x32_bf16(kfr, qf[rt][hl][ks], s[rt][nt], 0, 0, 0); } }
        bf16x8 pb[RT][2];
#pragma unroll
        for (int rt = 0; rt < RT; ++rt) {
            float bia[16];
#pragma unroll
            for (int nt = 0; nt < 4; ++nt)
#pragma unroll
                for (int i = 0; i < 4; ++i) { int ri = kt * 64 + nt * 16 + g4 * 4 + i - (rowl + rt * 16 + lq) + 128; ri = ri < 0 ? 0 : (ri > 255 ? 255 : ri); bia[nt * 4 + i] = bl[128 + ri * NH + hl]; }
            float mx = -INFINITY;
#pragma unroll
            for (int nt = 0; nt < 4; ++nt)
#pragma unroll
                for (int i = 0; i < 4; ++i) { const float xb = s[rt][nt][i] * (0.125f * LOG2E) + bia[nt * 4 + i];
                    const int sel = __builtin_amdgcn_sbfe((int)bits[rt], nt * 4 + i, 1);
                    const float x = __int_as_float((__float_as_int(xb) & sel) | (int)(0xff800000u & ~(unsigned)sel)); s[rt][nt][i] = x; mx = fmaxf(mx, x); }
            mx = fmaxf(mx, __shfl_xor(mx, 16)); mx = fmaxf(mx, __shfl_xor(mx, 32));
            const float mnew = fmaxf(m[rt][hl], mx), msafe = (mnew == -INFINITY) ? 0.f : mnew, alpha = __builtin_amdgcn_exp2f(m[rt][hl] - msafe); m[rt][hl] = mnew;
            float ls = 0.f;
#pragma unroll
            for (int nt = 0; nt < 4; ++nt)
#pragma unroll
                for (int i = 0; i < 4; ++i) { const float p = __builtin_amdgcn_exp2f(s[rt][nt][i] - msafe); s[rt][nt][i] = p; ls += p; }
            l[rt][hl] = l[rt][hl] * alpha + ls;
#pragma unroll
            for (int dt = 0; dt < 4; ++dt) O[rt][hl][dt] = O[rt][hl][dt] * alpha;
#pragma unroll
            for (int kk = 0; kk < 2; ++kk) { const u32x4 pw = pack8(s[rt][2 * kk], s[rt][2 * kk + 1]); pb[rt][kk] = __builtin_bit_cast(bf16x8, pw); }
        }
#pragma unroll
        for (int kk = 0; kk < 2; ++kk)
#pragma unroll
            for (int dt = 0; dt < 4; ++dt) { LAS u16* vp = Vb + (hl * 64 + dt * 16 + lq) * VP + kk * 32 + g4 * 4; const u32x2 v0 = *(LAS u32x2*)vp, v1 = *(LAS u32x2*)(vp + 16);
                u32x4 vw; vw.x = v0.x; vw.y = v0.y; vw.z = v1.x; vw.w = v1.y; vf[kk][dt] = __builtin_bit_cast(bf16x8, vw); }
#pragma unroll
        for (int kk = 0; kk < 2; ++kk)
#pragma unroll
            for (int dt = 0; dt < 4; ++dt)
#pragma unroll
                for (int rt = 0; rt < RT; ++rt) O[rt][hl][dt] = __builtin_amdgcn_mfma_f32_16x16x32_bf16(vf[kk][dt], pb[rt][kk], O[rt][hl][dt], 0, 0, 0);
    }
}
DI void att_phase(const Frame& F, LAS unsigned char* lds) {
    constexpr int KT = 64 * KP, VTS = NH * 64 * VP;
    LAS u16* Kbuf = (LAS u16*)lds;
    LAS u16* Vbuf = (LAS u16*)(lds + 4 * KT * 2);
    LAS float* bl = (LAS float*)(lds + 4 * KT * 2 + 4 * VTS * 2);
    const int tid = F.tid, lane = F.lane, wave = F.wave, lq = lane & 15, g4 = lane >> 4;
    constexpr int NQ = 8 / NH;
    constexpr int BR = 8 * 16 * RT, NBT = SEQ / BR;
    for (int pp = blockIdx.x; pp < 4 * NQ * (NBT / 2); pp += gridDim.x) {
        const int x = pp & 7, y = pp >> 3, b = x >> 1, hq = (x & 1) * (NQ / 2) + (y % (NQ / 2)), ii = y / (NQ / 2);
        __syncthreads();
        if (tid < 128) bl[tid] = ((tid & 3) < NH) ? F.in[23][(tid >> 2) * 8 + hq * NH + (tid & 3)] * LOG2E : 0.f;
        for (int e = tid; e < 256 * NH; e += NTHR) bl[128 + e] = F.in[23][t5_bucket(e / NH - 128) * 8 + hq * NH + (e % NH)] * LOG2E;
        __syncthreads();
        for (int which = 0; which < 2; ++which) {
            const int i = which ? NBT - 1 - ii : ii, npair = (BR / 128) * (i + 1), rowl = i * BR + wave * (16 * RT);
            const int c = rowl >> 6, my_ntile = c + 1;
            u16* qbase = F_Q(F) + ((size_t)b * SEQ + rowl + lq) * 512 + hq * (NH * 64);
            bf16x8 qf[RT][NH][2];
#pragma unroll
            for (int rt = 0; rt < RT; ++rt)
#pragma unroll
                for (int hl = 0; hl < NH; ++hl)
#pragma unroll
                    for (int ks = 0; ks < 2; ++ks) qf[rt][hl][ks] = *(const bf16x8*)(qbase + rt * 16 * 512 + hl * 64 + ks * 32 + g4 * 8);
            f32x4 O[RT][NH][4]; float m[RT][NH], l[RT][NH];
#pragma unroll
            for (int rt = 0; rt < RT; ++rt)
#pragma unroll
                for (int hl = 0; hl < NH; ++hl) { m[rt][hl] = -INFINITY; l[rt][hl] = 0.f;
#pragma unroll
                    for (int dt = 0; dt < 4; ++dt) O[rt][hl][dt] = (f32x4){0.f, 0.f, 0.f, 0.f}; }
            const size_t mb0 = (size_t)b * MASK_PER_B + (size_t)(c + 1) * (2 * c + ((rowl >> 4) & 3));
            const char* mp = (const char*)(F_MASK(F) + mb0 * 64) + (unsigned)(lane * 2);
            const int mrt = (c + 1) * 128;
            const u16* kg = F_K(F) + ((size_t)b * SEQ) * 512 + hq * (NH * 64); const u16* vg = F_VT(F) + ((size_t)(b * 512 + hq * (NH * 64))) * SEQ;
            constexpr int NE = NH, KCH = NH * 8, KR = 512 / KCH;
            u32x4 kr[2][NE], vr[2][NE];
            const unsigned voffK = (unsigned)(((tid / KCH) * 512 + (tid % KCH) * 8) * 2), voffV = (unsigned)(((tid >> 3) * SEQ + (tid & 7) * 8) * 2);
            const int krow = tid / KCH, kck = tid % KCH, vrow = tid >> 3, vck = tid & 7;
#pragma unroll
            for (int t = 0; t < 2; ++t)
#pragma unroll
                for (int e = 0; e < NE; ++e) { kr[t][e] = ldg16(kg + (size_t)(t * 64 + e * KR) * 512, voffK); vr[t][e] = ldg16(vg + (size_t)e * 64 * SEQ + t * 64, voffV); }
#pragma unroll
            for (int t = 0; t < 2; ++t)
#pragma unroll
                for (int e = 0; e < NE; ++e) { *(LAS u32x4*)(Kbuf + t * KT + (krow + e * KR) * KP + kck * 8) = kr[t][e]; *(LAS u32x4*)(Vbuf + t * VTS + (vrow + e * 64) * VP + vck * 8) = vr[t][e]; }
            unsigned bc[2][RT], bn[2][RT];
#pragma unroll
            for (int t = 0; t < 2; ++t)
#pragma unroll
                for (int rt = 0; rt < RT; ++rt) { const int kq = t < my_ntile ? t : my_ntile - 1; bc[t][rt] = *(const u16*)(mp + rt * mrt + kq * 128); }
            __builtin_amdgcn_s_waitcnt(0x0F70);
            __syncthreads();
#pragma unroll 1
            for (int kp = 0; kp < npair; ++kp) {
                const bool more = kp + 1 < npair; const int kt0 = 2 * kp, st = kp & 1;
                if (more) {
#pragma unroll
                    for (int t = 0; t < 2; ++t)
#pragma unroll
                        for (int rt = 0; rt < RT; ++rt) { const int kq = kt0 + 2 + t < my_ntile ? kt0 + 2 + t : my_ntile - 1; bn[t][rt] = *(const u16*)(mp + rt * mrt + kq * 128); }
#pragma unroll
                    for (int t = 0; t < 2; ++t)
#pragma unroll
                        for (int e = 0; e < NE; ++e) { kr[t][e] = ldg16(kg + (size_t)((kt0 + 2 + t) * 64 + e * KR) * 512, voffK); vr[t][e] = ldg16(vg + (size_t)e * 64 * SEQ + (kt0 + 2 + t) * 64, voffV); }
                }
#pragma unroll
                for (int t = 0; t < 2; ++t) { const int kt = kt0 + t;
                    if (kt < my_ntile) {
                        LAS u16* Kb = Kbuf + (st * 2 + t) * KT; LAS u16* Vb = Vbuf + (st * 2 + t) * VTS;
                        if (kt * 64 + 63 - rowl <= -91) att_tile_far(Kb, Vb, bl, bc[t], qf, O, m, l, lq, g4);
                        else att_tile_near(Kb, Vb, bl, bc[t], kt, rowl, qf, O, m, l, lq, g4);
                    } }
                if (more) {
#pragma unroll
                    for (int t = 0; t < 2; ++t)
#pragma unroll
                        for (int e = 0; e < NE; ++e) { *(LAS u32x4*)(Kbuf + ((st ^ 1) * 2 + t) * KT + (krow + e * KR) * KP + kck * 8) = kr[t][e]; *(LAS u32x4*)(Vbuf + ((st ^ 1) * 2 + t) * VTS + (vrow + e * 64) * VP + vck * 8) = vr[t][e]; }
#pragma unroll
                    for (int t = 0; t < 2; ++t)
#pragma unroll
                        for (int rt = 0; rt < RT; ++rt) bc[t][rt] = bn[t][rt];
                }
                __syncthreads();
            }
#pragma unroll
            for (int rt = 0; rt < RT; ++rt)
#pragma unroll
                for (int hl = 0; hl < NH; ++hl) { float lt = l[rt][hl]; lt += __shfl_xor(lt, 16); lt += __shfl_xor(lt, 32); const float inv = 1.0f / lt;
#pragma unroll
                    for (int dt = 0; dt < 4; ++dt) { const f32x4 o = O[rt][hl][dt] * inv; u32x2 w; w.x = cvt_pk_bf16(o[0], o[1]); w.y = cvt_pk_bf16(o[2], o[3]);
                        *(u32x2*)(qbase + rt * 16 * 512 + hl * 64 + dt * 16 + g4 * 4) = w; } }
        }
    }
}

#define XB_TMO      128
#define XB_XCNT(j)  (256  + 64 * (j))
#define XB_XSUB(j)  (1280 + 64 * (j))
#define XB_XGEN(j)  (2304 + 64 * (j))
#define XB_TOP      3328
#define XB_TOPGEN   3392
#define XCD_BAR_WORDS 3456
#define XB_SPIN_CAP (1u << 18)
DI unsigned xb_ld(unsigned* p)              { return __hip_atomic_load(p, __ATOMIC_RELAXED, __HIP_MEMORY_SCOPE_AGENT); }
DI unsigned xb_add(unsigned* p, unsigned v) { return __hip_atomic_fetch_add(p, v, __ATOMIC_RELAXED, __HIP_MEMORY_SCOPE_AGENT); }
DI unsigned xb_xcc_id() { return (unsigned)__builtin_amdgcn_s_getreg((3 << 11) | 20) & 0xFu; }
#define XB_SPIN(cond, bar) do { unsigned _sp = 0; while (cond) { __builtin_amdgcn_s_sleep(1); \
    if ((++_sp & 255u) == 0u) { if (xb_ld(&(bar)[XB_TMO])) break; if (_sp > XB_SPIN_CAP) { (void)xb_add(&(bar)[XB_TMO], 1u); break; } } } } while (0)
struct XcdBarrier { unsigned* bar; unsigned x; volatile LAS unsigned* st; };
DI XcdBarrier xcd_barrier_post(unsigned* bar, volatile LAS unsigned* st) {
    XcdBarrier b; b.bar = bar; b.x = xb_xcc_id(); b.st = st;
    if (threadIdx.x == 0) (void)xb_add(&bar[XB_XCNT(b.x)], 1u);
    return b;
}
DI void xcd_barrier_complete(unsigned* bar, unsigned x, unsigned& nloc, unsigned& nx) {
    const unsigned G = gridDim.x * gridDim.y * gridDim.z;
    unsigned sum, cnt, mine, sp = 0u;
    for (;;) {
        sum = 0u; cnt = 0u; mine = 0u;
#pragma unroll
        for (unsigned j = 0; j < 16; ++j) { const unsigned c = xb_ld(&bar[XB_XCNT(j)]); sum += c; cnt += (c > 0u) ? 1u : 0u; mine = (j == x) ? c : mine; }
        if (sum == G) break;
        __builtin_amdgcn_s_sleep(1);
        if ((++sp & 255u) == 0u) { if (xb_ld(&bar[XB_TMO])) break; if (sp > XB_SPIN_CAP) { (void)xb_add(&bar[XB_TMO], 1u); break; } }
    }
    nloc = mine > 0u ? mine : 1u; nx = cnt > 0u ? cnt : 1u;
}
DI unsigned xb_uadd(unsigned* p, unsigned v) { unsigned r = 0u; if ((threadIdx.x & 63) == 0) r = xb_add(p, v); return (unsigned)__builtin_amdgcn_readfirstlane((int)r); }
DI unsigned xb_uld(unsigned* p) { return (unsigned)__builtin_amdgcn_readfirstlane((int)xb_ld(p)); }
DI void xcd_barrier(unsigned* bar, unsigned bx, volatile LAS unsigned* bst) {
    asm volatile("s_waitcnt vmcnt(0)" ::: "memory");
    __syncthreads();
    if (__builtin_amdgcn_readfirstlane((int)(threadIdx.x >> 6)) == 0) {
        asm volatile("s_waitcnt vmcnt(0) lgkmcnt(0)" ::: "memory");
        unsigned nloc = (unsigned)__builtin_amdgcn_readfirstlane((int)bst[0]), nx = (unsigned)__builtin_amdgcn_readfirstlane((int)bst[1]);
        if (nloc == 0u) {
            const unsigned G = gridDim.x; unsigned sp = 0u;
            for (;;) {
                unsigned sum = 0u, cnt = 0u, mine = 0u;
#pragma unroll
                for (unsigned j = 0; j < 16; ++j) { const unsigned c = xb_uld(&bar[XB_XCNT(j)]); sum += c; cnt += (c > 0u) ? 1u : 0u; mine = (j == bx) ? c : mine; }
                nloc = mine > 0u ? mine : 1u; nx = cnt > 0u ? cnt : 1u;
                if (sum == G) break;
                __builtin_amdgcn_s_sleep(1);
                if (++sp > XB_SPIN_CAP) { (void)xb_uadd(&bar[XB_TMO], 1u); break; }
            }
            if ((threadIdx.x & 63) == 0) { bst[0] = nloc; bst[1] = nx; }
        }
        const unsigned old = xb_uadd(&bar[XB_XSUB(bx)], 1u);
        const unsigned gen = old / nloc;
        if (old + 1u == (gen + 1u) * nloc) {
            __builtin_amdgcn_fence(__ATOMIC_RELEASE, "agent");
            asm volatile("s_waitcnt vmcnt(0)" ::: "memory");
            const unsigned og = xb_uadd(&bar[XB_TOP], 1u);
            const unsigned tg = og / nx;
            if (og + 1u == (tg + 1u) * nx) (void)xb_uadd(&bar[XB_TOPGEN], 1u);
            else { unsigned sp = 0u; while (xb_uld(&bar[XB_TOPGEN]) == tg) { __builtin_amdgcn_s_sleep(1); if (++sp > XB_SPIN_CAP) { (void)xb_uadd(&bar[XB_TMO], 1u); break; } } }
            __builtin_amdgcn_fence(__ATOMIC_ACQUIRE, "agent");
            (void)xb_uadd(&bar[XB_XGEN(bx)], 1u);
            asm volatile("s_waitcnt vmcnt(0)" ::: "memory");
        } else {
            unsigned sp = 0u; while (xb_uld(&bar[XB_XGEN(bx)]) == gen) { __builtin_amdgcn_s_sleep(1); if (++sp > XB_SPIN_CAP) { (void)xb_uadd(&bar[XB_TMO], 1u); break; } }
            __builtin_amdgcn_fence(__ATOMIC_ACQUIRE, "agent");
            asm volatile("s_waitcnt vmcnt(0)" ::: "memory");
        }
    }
    __syncthreads();
}

constexpr int NPH = 33;
#define PHON(k) ((PHM >> (k)) & 1)
DI void fresh(Frame& F, const Args& args) {
    int t = threadIdx.x; asm volatile("" : "+v"(t)); F.tid = t; F.lane = t & 63; F.wave = __builtin_amdgcn_readfirstlane(t >> 6);
    int z = 0; asm volatile("" : "+s"(z)); F.in = args.in + z;
    F.ws = args.ws + z; F.out = args.out + z;
}
#ifndef RPT
#define RPT 0
#endif
#define PH_BEGIN(k) if (args.lo <= (k) && (k) < args.hi) { fresh(F, args); unsigned char* ws = F.ws; (void)ws;
#define PH_END(k) if ((k) + 1 < args.hi) xcd_barrier(xbar, xx, xst); }
template <int PHM, int L>
DI void layer_phases(Frame& F, const Args& args, LAS unsigned char* lds, cg::grid_group& grid, unsigned* xbar, unsigned xx, volatile LAS unsigned* xst) {
    constexpr int P = 1 + 16 * L;
#define WL (ws + WS_W + (size_t)L * SZ_LAYERW)
#define TAB (ws + WS_TAB + (size_t)L * SZ_TABL)
#define WLDS (lds + F.wave * 19456)
    PH_BEGIN(P + 0) if (PHON(0)) { EpiUp E{F_H(F)}; run_gemm(lds, F_XB(F), (const u16*)(WL + OFF_UP1), NUP, D_, E); } if ((RPT >> 0) & 1) { xcd_barrier(xbar, xx, xst); fresh(F, args); if (PHON(0)) { EpiUp E{F_H(F)}; run_gemm(lds, F_XB(F), (const u16*)(WL + OFF_UP1), NUP, D_, E); } } PH_END(P + 0)
    PH_BEGIN(P + 1) if (PHON(1)) { EpiRes E{L == 0 ? F.in[0] : (const float*)F.out, F.out, 0.5f, L == 0 ? (const f32x2_t*)nullptr : (const f32x2_t*)(ws + WS_STATS), F.in[21], F.in[22]};     run_gemm(lds, F_H(F), (const u16*)(WL + OFF_DN1), D_, DFF, E); } if ((RPT >> 1) & 1) { xcd_barrier(xbar, xx, xst); fresh(F, args); if (PHON(1)) { EpiRes E{L == 0 ? F.in[0] : (const float*)F.out, F.out, 0.5f, L == 0 ? (const f32x2_t*)nullptr : (const f32x2_t*)(ws + WS_STATS), F.in[21], F.in[22]};     run_gemm(lds, F_H(F), (const u16*)(WL + OFF_DN1), D_, DFF, E); } } PH_END(P + 1)
    PH_BEGIN(P + 2) if (PHON(2)) ln_phase(F, F.in[3] + L * D_, F.in[4] + L * D_, false); if ((RPT >> 2) & 1) { xcd_barrier(xbar, xx, xst); fresh(F, args); if (PHON(2)) ln_phase(F, F.in[3] + L * D_, F.in[4] + L * D_, false); } PH_END(P + 2)
    PH_BEGIN(P + 3) if (PHON(3)) { EpiIn E{ws}; run_gemm(lds, F_XB(F), (const u16*)(WL + OFF_WIN), NIN, D_, E); } if ((RPT >> 3) & 1) { xcd_barrier(xbar, xx, xst); fresh(F, args); if (PHON(3)) { EpiIn E{ws}; run_gemm(lds, F_XB(F), (const u16*)(WL + OFF_WIN), NIN, D_, E); } } PH_END(P + 3)
    PH_BEGIN(P + 4) if (PHON(4)) { idx_phase(F, lds); __syncthreads(); fresh(F, args); { for (int t = blockIdx.x * 8 + F.wave; t < 4096; t += gridDim.x * 8) vt_tile(F, WLDS, t);
        { int gcur = -1; float ar = 0.f, ai = 0.f, cr = 0.f, ci = 0.f; bf16x8 af[8], cf[4]; f32x4 dv = {0.f, 0.f, 0.f, 0.f};
          for (int it = blockIdx.x * 8 + F.wave; it < 16384; it += gridDim.x * 8) { const int g = it & 31; if (g != gcur) { ssm_load_g(TAB, F.in[13] + L * 512, g, F.lane, ar, ai, cr, ci, af, cf, dv); gcur = g; } ssmA_item(F, WLDS, it, ar, ai, af); } } } } PH_END(P + 4)
    PH_BEGIN(P + 5) if (PHON(5)) { att_phase(F, lds); __syncthreads(); fresh(F, args); { int gcur = -1; float ar = 0.f, ai = 0.f, cr = 0.f, ci = 0.f; bf16x8 af[8], cf[4]; f32x4 dv = {0.f, 0.f, 0.f, 0.f};
          for (int sw = blockIdx.x * 8 + F.wave; sw < 2048; sw += gridDim.x * 8) { const int g = sw & 31, seg = (sw >> 5) & 15, bb_ = sw >> 9;
              if (g != gcur) { ssm_load_g(TAB, F.in[13] + L * 512, g, F.lane, ar, ai, cr, ci, af, cf, dv); gcur = g; }
              float sr = 0.f, si = 0.f;
#pragma unroll 1
              for (int cc = 0; cc < 8; ++cc) ssmC_item(F, WLDS, ((bb_ * 128 + seg * 8 + cc) << 5) | g, ar, ai, cr, ci, af, cf, dv, sr, si, cc == 0); } } } PH_END(P + 5)
    PH_BEGIN(P + 6) if (PHON(6)) { EpiMix<0> E{F_U(F), nullptr, F_YS(F), 512}; run_gemm(lds, F_U(F), (const u16*)(WL + OFF_GLU), 512, 512, E); } if ((RPT >> 6) & 1) { xcd_barrier(xbar, xx, xst); fresh(F, args); if (PHON(6)) { EpiMix<0> E{F_U(F), nullptr, F_YS(F), 512}; run_gemm(lds, F_U(F), (const u16*)(WL + OFF_GLU), 512, 512, E); } } PH_END(P + 6)
    PH_BEGIN(P + 7) if (PHON(7)) { EpiMix<1> E{F_GS(F), nullptr, F_GS(F), 1024}; run_gemm(lds, F_YS(F), (const u16*)(WL + OFF_WB0), D_, 512, E); } if ((RPT >> 7) & 1) { xcd_barrier(xbar, xx, xst); fresh(F, args); if (PHON(7)) { EpiMix<1> E{F_GS(F), nullptr, F_GS(F), 1024}; run_gemm(lds, F_YS(F), (const u16*)(WL + OFF_WB0), D_, 512, E); } } PH_END(P + 7)
    PH_BEGIN(P + 10) if (PHON(10)) { EpiMix<2> E{F_GA(F), F_GS(F), F_GA(F), 1024}; run_gemm(lds, F_Q(F), (const u16*)(WL + OFF_WB1), D_, 512, E); } if ((RPT >> 10) & 1) { xcd_barrier(xbar, xx, xst); fresh(F, args); if (PHON(10)) { EpiMix<2> E{F_GA(F), F_GS(F), F_GA(F), 1024}; run_gemm(lds, F_Q(F), (const u16*)(WL + OFF_WB1), D_, 512, E); } } PH_END(P + 10)
    PH_BEGIN(P + 11) if (PHON(11)) { EpiRes E{(const float*)F.out, F.out, 1.0f, (const f32x2_t*)(ws + WS_STATS), F.in[3] + L * D_, F.in[4] + L * D_}; run_gemm(lds, F_GA(F), (const u16*)(WL + OFF_WOUT), D_, D_, E); } if ((RPT >> 11) & 1) { xcd_barrier(xbar, xx, xst); fresh(F, args); if (PHON(11)) { EpiRes E{(const float*)F.out, F.out, 1.0f, (const f32x2_t*)(ws + WS_STATS), F.in[3] + L * D_, F.in[4] + L * D_}; run_gemm(lds, F_GA(F), (const u16*)(WL + OFF_WOUT), D_, D_, E); } } PH_END(P + 11)
    PH_BEGIN(P + 12) if (PHON(12)) ln_phase(F, F.in[17] + L * D_, F.in[18] + L * D_, false); if ((RPT >> 12) & 1) { xcd_barrier(xbar, xx, xst); fresh(F, args); if (PHON(12)) ln_phase(F, F.in[17] + L * D_, F.in[18] + L * D_, false); } PH_END(P + 12)
    PH_BEGIN(P + 13) if (PHON(13)) { EpiUp E{F_H(F)}; run_gemm(lds, F_XB(F), (const u16*)(WL + OFF_UP2), NUP, D_, E); } if ((RPT >> 13) & 1) { xcd_barrier(xbar, xx, xst); fresh(F, args); if (PHON(13)) { EpiUp E{F_H(F)}; run_gemm(lds, F_XB(F), (const u16*)(WL + OFF_UP2), NUP, D_, E); } } PH_END(P + 13)
    PH_BEGIN(P + 14) if (PHON(14)) { EpiRes E{(const float*)F.out, F.out, 0.5f, (const f32x2_t*)(ws + WS_STATS), F.in[17] + L * D_, F.in[18] + L * D_}; run_gemm(lds, F_H(F), (const u16*)(WL + OFF_DN2), D_, DFF, E); } if ((RPT >> 14) & 1) { xcd_barrier(xbar, xx, xst); fresh(F, args); if (PHON(14)) { EpiRes E{(const float*)F.out, F.out, 0.5f, (const f32x2_t*)(ws + WS_STATS), F.in[17] + L * D_, F.in[18] + L * D_}; run_gemm(lds, F_H(F), (const u16*)(WL + OFF_DN2), D_, DFF, E); } } PH_END(P + 14)
    PH_BEGIN(P + 15) if (PHON(15)) ln_phase(F, F.in[21] + L * D_, F.in[22] + L * D_, L == 1); if ((RPT >> 15) & 1) { xcd_barrier(xbar, xx, xst); fresh(F, args); if (PHON(15)) ln_phase(F, F.in[21] + L * D_, F.in[22] + L * D_, L == 1); } PH_END(P + 15)
#undef WL
#undef TAB
#undef WLDS
}
template <int PHM>
__global__ void __launch_bounds__(NTHR, 2) mega(Args args) {
    extern __shared__ __attribute__((aligned(16))) unsigned char lds_raw[];
    LAS unsigned char* lds = (LAS unsigned char*)lds_raw;
    Frame F;
    cg::grid_group grid = cg::this_grid();
    volatile LAS unsigned* xst = (volatile LAS unsigned*)(lds + LDS_MAIN);
    if (threadIdx.x < 4) xst[threadIdx.x] = 0u;
    __syncthreads();
    unsigned* bar = (unsigned*)(args.ws + WS_BAR);
    if (args.lo <= 0 && 0 < args.hi) { fresh(F, args);
        if (blockIdx.x == 0) { for (int i = F.tid; i < XCD_BAR_WORDS; i += NTHR) bar[i] = 0u; }
        if (PHON(16)) p0_phase(F, lds);
        if (1 < args.hi) grid.sync(); }
    const unsigned xx = xb_xcc_id();
    if (threadIdx.x == 0) (void)xb_add(&bar[XB_XCNT(xx)], 1u);
    layer_phases<PHM, 0>(F, args, lds, grid, bar, xx, xst);
    layer_phases<PHM, 1>(F, args, lds, grid, bar, xx, xst);
}

typedef void (*kern_t)(Args);
#if !ONE_LAUNCH
static kern_t phase_kernel(int ph) {
    if (ph == 0) return mega<(1 << 16)>;
    switch ((ph - 1) & 15) {
    case 0: return mega<(1 << 0)>; case 1: return mega<(1 << 1)>; case 2: return mega<(1 << 2)>; case 3: return mega<(1 << 3)>;
    case 4: return mega<(1 << 4)>; case 5: return mega<(1 << 5)>; case 6: return mega<(1 << 6)>; case 7: return mega<(1 << 7)>;
    case 8: return mega<(1 << 8)>; case 9: return mega<(1 << 9)>; case 10: return mega<(1 << 10)>; case 11: return mega<(1 << 11)>;
    case 12: return mega<(1 << 12)>; case 13: return mega<(1 << 13)>; case 14: return mega<(1 << 14)>; default: return mega<(1 << 15)>;
    }
}
#endif
extern "C" void kernel_launch(void* const* d_in, const int* in_sizes, int n_in, void* d_out, int out_size, void* d_ws, size_t ws_size, hipStream_t stream) {
    static int grid = 0;
    if (grid == 0) {
        int dev = 0, cus = 0;
        if (n_in != 24 || out_size != T_ * D_ || ws_size < WS_END) { fprintf(stderr, "kernel_launch: unexpected problem (n_in %d out %d ws %zu need %zu)\n", n_in, out_size, ws_size, (size_t)WS_END); grid = -1; return; }
        (void)hipGetDevice(&dev); (void)hipDeviceGetAttribute(&cus, hipDeviceAttributeMultiprocessorCount, dev);
#if ONE_LAUNCH
        if (hipFuncSetAttribute((const void*)mega<0x1ffff>, hipFuncAttributeMaxDynamicSharedMemorySize, LDS_BYTES) != hipSuccess) fprintf(stderr, "kernel_launch: hipFuncSetAttribute failed\n");
#else
        for (int ph = 0; ph < 17; ++ph) if (hipFuncSetAttribute((const void*)phase_kernel(ph), hipFuncAttributeMaxDynamicSharedMemorySize, LDS_BYTES) != hipSuccess) fprintf(stderr, "kernel_launch: hipFuncSetAttribute failed\n");
#endif
        (void)hipGetLastError();
        grid = cus > 0 ? cus : 256;
    }
    if (grid < 0) return;
    Args a{};
    for (int i = 0; i < 24; ++i) a.in[i] = (const float*)d_in[i];
    a.out = (float*)d_out; a.ws = (unsigned char*)d_ws;
#if ONE_LAUNCH
    a.lo = 0; a.hi = NPH;
    void* kargs[] = {&a};
    hipError_t e = hipLaunchCooperativeKernel((const void*)mega<0x1ffff>, dim3(grid), dim3(NTHR), kargs, LDS_BYTES, stream);
    if (e != hipSuccess) fprintf(stderr, "cooperative launch failed: %s (grid %d)\n", hipGetErrorString(e), grid);
#else
    for (int ph = 0; ph < NPH; ++ph) { a.lo = ph; a.hi = ph + 1; hipLaunchKernelGGL(phase_kernel(ph), dim3(grid), dim3(NTHR), LDS_BYTES, stream, a); }
#endif
}
```
